# Optimizing an MI355X kernel written in HIP

```python
import math
import jax, jax.numpy as jnp
from jax import lax
import numpy as np

D_MODEL = 1024
BATCH = 2
SEQ = 8192
DEPTH = 2

M_MLSTM = 512
MLSTM_HEADS = 4
MLSTM_HEAD_DIM = M_MLSTM // MLSTM_HEADS
CHUNK = 128
CONV_WIDTH = 5
FORGET_BIAS_LO = 3.0
FORGET_BIAS_HI = 6.0
M_FOURIER = 256
FOURIER_GROUPS = 4
FOURIER_GROUP_DIM = M_FOURIER // FOURIER_GROUPS
M_S5 = 256
S5_GROUP = 16
S5_GROUPS = M_S5 // S5_GROUP
S5_STATE = 64
DT_MIN = 1e-3
DT_MAX = 1e-1
N_BRANCHES = 3
D_FF = 4 * D_MODEL
EPS = 1e-6

OFF_Q = 0
OFF_K = OFF_Q + M_MLSTM
OFF_V = OFF_K + M_MLSTM
OFF_O = OFF_V + M_MLSTM
OFF_IG = OFF_O + M_MLSTM
OFF_FG = OFF_IG + 2 * MLSTM_HEADS
OFF_FOURIER = OFF_FG + 2 * MLSTM_HEADS
OFF_S5 = OFF_FOURIER + M_FOURIER
OFF_GATE = OFF_S5 + M_S5
N_IN = OFF_GATE + N_BRANCHES * D_MODEL

kernel_name = 'hybrid_mlstm_fnet_s5_encoder'

F32 = jnp.float32


def rmsnorm(x, g):
    xf = x.astype(F32)
    y = xf * lax.rsqrt(jnp.mean(xf * xf, axis=-1, keepdims=True) + EPS)
    return y * g.astype(F32)


def centred_dwconv(x, w, b):
    xf = x.astype(F32)
    y = lax.conv_general_dilated(xf, w.astype(F32)[:, None, :], window_strides=(1,), padding='SAME',
                                 dimension_numbers=('NWC', 'WIO', 'NWC'), feature_group_count=xf.shape[-1])
    return y + b.astype(F32)


def mlstm_direction(q, k, v, ig, fg):
    bsz, s, nh, dh = q.shape
    nc = s // CHUNK

    def chunk(t):
        return t.reshape(bsz, nc, CHUNK, nh, -1).transpose(0, 3, 1, 2, 4)

    def chunk_g(t):
        return t.reshape(bsz, nc, CHUNK, nh).transpose(0, 3, 1, 2)

    q = chunk(q) * (dh ** -0.5)
    k = chunk(k)
    v = chunk(v)
    ig = chunk_g(ig)
    logf = jax.nn.log_sigmoid(chunk_g(fg))
    b = jnp.cumsum(logf, axis=-1)
    g = b[..., -1]
    a = g[..., None] - b + ig
    a_max = jnp.max(a, axis=-1)
    w = jnp.exp(a - a_max[..., None])
    c_loc = jnp.einsum('bhcl,bhcle,bhclk->bhcek', w, v, k)
    n_loc = jnp.einsum('bhcl,bhclk->bhck', w, k)

    def step(carry, inp):
        c_st, n_st, m_st = carry
        cl, nl, am, gc = inp
        m_new = jnp.maximum(gc + m_st, am)
        s_old = jnp.exp(gc + m_st - m_new)
        s_new = jnp.exp(am - m_new)
        c_new = s_old[..., None, None] * c_st + s_new[..., None, None] * cl
        n_new = s_old[..., None] * n_st + s_new[..., None] * nl
        return (c_new, n_new, m_new), (c_st, n_st, m_st)

    init = (jnp.zeros((bsz, nh, dh, dh), F32), jnp.zeros((bsz, nh, dh), F32), jnp.zeros((bsz, nh), F32))
    xs = (jnp.moveaxis(c_loc, 2, 0), jnp.moveaxis(n_loc, 2, 0), jnp.moveaxis(a_max, 2, 0), jnp.moveaxis(g, 2, 0))
    _, (c_prev, n_prev, m_prev) = lax.scan(step, init, xs)
    c_prev = jnp.moveaxis(c_prev, 0, 2)
    n_prev = jnp.moveaxis(n_prev, 0, 2)
    m_prev = jnp.moveaxis(m_prev, 0, 2)

    mask = jnp.tril(jnp.ones((CHUNK, CHUNK), dtype=bool))
    d_log = jnp.where(mask, b[..., :, None] - b[..., None, :] + ig[..., None, :], -jnp.inf)
    inter_log = b + m_prev[..., None]
    m_t = jnp.maximum(inter_log, jnp.max(d_log, axis=-1))
    scores = jnp.einsum('bhcld,bhcjd->bhclj', q, k) * jnp.exp(d_log - m_t[..., None])
    inter_w = jnp.exp(inter_log - m_t)
    num = jnp.einsum('bhclj,bhcjd->bhcld', scores, v) + inter_w[..., None] * jnp.einsum('bhcek,bhclk->bhcle', c_prev, q)
    den = jnp.sum(scores, axis=-1) + inter_w * jnp.einsum('bhclk,bhck->bhcl', q, n_prev)
    h = num / jnp.maximum(jnp.abs(den), jnp.exp(-m_t))[..., None]
    return h.transpose(0, 2, 3, 1, 4).reshape(bsz, s, nh, dh)


def mlstm_branch(z_qk, z_v, z_o, z_ig, z_fg, conv_w, conv_b, norm_g):
    bsz, s, _ = z_v.shape
    nh, dh = MLSTM_HEADS, MLSTM_HEAD_DIM
    qk = jax.nn.silu(centred_dwconv(z_qk, conv_w, conv_b))
    q = qk[..., :M_MLSTM].reshape(bsz, s, nh, dh)
    k = qk[..., M_MLSTM:].reshape(bsz, s, nh, dh)
    v = z_v.astype(F32).reshape(bsz, s, nh, dh)
    ig = z_ig.astype(F32)
    fg = z_fg.astype(F32)
    flip = lambda t: jnp.flip(t, axis=1)
    h_fwd = mlstm_direction(q, k, v, ig[..., :nh], fg[..., :nh])
    h_bwd = flip(mlstm_direction(flip(q), flip(k), flip(v), flip(ig[..., nh:]), flip(fg[..., nh:])))
    h = h_fwd + h_bwd
    mu = jnp.mean(h, axis=-1, keepdims=True)
    var = jnp.mean(jnp.square(h - mu), axis=-1, keepdims=True)
    h = ((h - mu) * lax.rsqrt(var + EPS)).reshape(bsz, s, M_MLSTM) * norm_g.astype(F32)
    return h * jax.nn.sigmoid(z_o.astype(F32))


def fourier_branch(z_f):
    bsz, s, _ = z_f.shape
    u = z_f.astype(F32).reshape(bsz, s, FOURIER_GROUPS, FOURIER_GROUP_DIM)
    y = jnp.real(jnp.fft.fft2(u, axes=(1, 3), norm='ortho'))
    return y.reshape(bsz, s, M_FOURIER)


def s5_direction(u, lam_re, lam_im, log_dt, b_re, b_im, c_re, c_im, reverse):
    lam_re = lam_re.astype(F32)
    lam_im = lam_im.astype(F32)
    dt = jnp.exp(log_dt.astype(F32))[:, None]
    mag = jnp.exp(lam_re * dt)
    lb_re = mag * jnp.cos(lam_im * dt)
    lb_im = mag * jnp.sin(lam_im * dt)
    den = lam_re * lam_re + lam_im * lam_im
    f_re = ((lb_re - 1.0) * lam_re + lb_im * lam_im) / den
    f_im = (lb_im * lam_re - (lb_re - 1.0) * lam_im) / den
    b_re = b_re.astype(F32)
    b_im = b_im.astype(F32)
    bb_re = f_re[..., None] * b_re - f_im[..., None] * b_im
    bb_im = f_re[..., None] * b_im + f_im[..., None] * b_re
    bu_re = jnp.einsum('gpc,bsgc->bsgp', bb_re, u)
    bu_im = jnp.einsum('gpc,bsgc->bsgp', bb_im, u)
    a_re = jnp.broadcast_to(lb_re, bu_re.shape)
    a_im = jnp.broadcast_to(lb_im, bu_im.shape)

    def combine(e1, e2):
        a1r, a1i, x1r, x1i = e1
        a2r, a2i, x2r, x2i = e2
        return (a1r * a2r - a1i * a2i, a1r * a2i + a1i * a2r,
                a2r * x1r - a2i * x1i + x2r, a2r * x1i + a2i * x1r + x2i)

    _, _, x_re, x_im = lax.associative_scan(combine, (a_re, a_im, bu_re, bu_im), axis=1, reverse=reverse)
    return jnp.einsum('gcp,bsgp->bsgc', c_re.astype(F32), x_re) - jnp.einsum('gcp,bsgp->bsgc', c_im.astype(F32), x_im)


def s5_branch(z_s, lam_re, lam_im, log_dt, b_re, b_im, c_re, c_im, d_skip, w_glu, b_glu):
    bsz, s, _ = z_s.shape
    u = z_s.astype(F32).reshape(bsz, s, S5_GROUPS, S5_GROUP)
    y = (d_skip.astype(F32) * u
         + s5_direction(u, lam_re[0], lam_im[0], log_dt[0], b_re[0], b_im[0], c_re[0], c_im[0], False)
         + s5_direction(u, lam_re[1], lam_im[1], log_dt[1], b_re[1], b_im[1], c_re[1], c_im[1], True))
    y = jax.nn.gelu(y).reshape(bsz, s, M_S5)
    zz = y @ w_glu.astype(F32) + b_glu.astype(F32)
    return zz[..., :D_MODEL] * jax.nn.sigmoid(zz[..., D_MODEL:])


def setup_inputs(seed: int = 0) -> dict:
    key = jax.random.key(seed)
    ks = jax.random.split(key, 32)

    def nrm(k, shape, scale):
        return jax.random.normal(k, shape, F32) * scale

    fg_bias = jnp.tile(jnp.linspace(FORGET_BIAS_LO, FORGET_BIAS_HI, MLSTM_HEADS, dtype=F32), 2)[None, :]
    b_in = jnp.concatenate([
        nrm(ks[6], (DEPTH, OFF_FG), 0.02),
        fg_bias + nrm(ks[7], (DEPTH, 2 * MLSTM_HEADS), 0.1),
        nrm(ks[8], (DEPTH, N_IN - OFF_FOURIER), 0.02)], axis=-1)
    lam_im0 = jnp.pi * jnp.arange(S5_STATE, dtype=F32)
    return {
        'x': jax.random.normal(ks[0], (BATCH, SEQ, D_MODEL), F32),
        'g_mix_pre': 1.0 + nrm(ks[1], (DEPTH, D_MODEL), 0.02),
        'g_mix_post': 1.0 + nrm(ks[2], (DEPTH, D_MODEL), 0.02),
        'g_ffn_pre': 1.0 + nrm(ks[3], (DEPTH, D_MODEL), 0.02),
        'g_ffn_post': 1.0 + nrm(ks[4], (DEPTH, D_MODEL), 0.02),
        'w_in': nrm(ks[5], (DEPTH, D_MODEL, N_IN), D_MODEL ** -0.5),
        'b_in': b_in,
        'conv_w': nrm(ks[9], (DEPTH, CONV_WIDTH, 2 * M_MLSTM), CONV_WIDTH ** -0.5),
        'conv_b': nrm(ks[10], (DEPTH, 2 * M_MLSTM), 0.02),
        'mlstm_norm_g': 1.0 + nrm(ks[11], (DEPTH, M_MLSTM), 0.02),
        'w_up_mlstm': nrm(ks[12], (DEPTH, M_MLSTM, D_MODEL), M_MLSTM ** -0.5),
        'w_up_fourier': nrm(ks[13], (DEPTH, M_FOURIER, D_MODEL), M_FOURIER ** -0.5),
        's5_lam_re': -0.5 + nrm(ks[14], (DEPTH, 2, S5_GROUPS, S5_STATE), 0.01),
        's5_lam_im': lam_im0 + nrm(ks[15], (DEPTH, 2, S5_GROUPS, S5_STATE), 0.01),
        's5_log_dt': jax.random.uniform(ks[16], (DEPTH, 2, S5_GROUPS), F32, math.log(DT_MIN), math.log(DT_MAX)),
        's5_b_re': nrm(ks[17], (DEPTH, 2, S5_GROUPS, S5_STATE, S5_GROUP), (2 * S5_GROUP) ** -0.5),
        's5_b_im': nrm(ks[18], (DEPTH, 2, S5_GROUPS, S5_STATE, S5_GROUP), (2 * S5_GROUP) ** -0.5),
        's5_c_re': nrm(ks[19], (DEPTH, 2, S5_GROUPS, S5_GROUP, S5_STATE), S5_STATE ** -0.5),
        's5_c_im': nrm(ks[20], (DEPTH, 2, S5_GROUPS, S5_GROUP, S5_STATE), S5_STATE ** -0.5),
        's5_d': nrm(ks[21], (DEPTH, S5_GROUPS, S5_GROUP), 1.0),
        'w_glu': nrm(ks[22], (DEPTH, M_S5, 2 * D_MODEL), M_S5 ** -0.5),
        'b_glu': nrm(ks[23], (DEPTH, 2 * D_MODEL), 0.02),
        'w_out': nrm(ks[24], (DEPTH, D_MODEL, D_MODEL), D_MODEL ** -0.5),
        'w_ffn1': nrm(ks[25], (DEPTH, D_MODEL, D_FF), D_MODEL ** -0.5),
        'w_ffn2': nrm(ks[26], (DEPTH, D_FF, D_MODEL), D_FF ** -0.5),
    }


def reference(x, g_mix_pre, g_mix_post, g_ffn_pre, g_ffn_post, w_in, b_in, conv_w, conv_b, mlstm_norm_g,
              w_up_mlstm, w_up_fourier, s5_lam_re, s5_lam_im, s5_log_dt, s5_b_re, s5_b_im, s5_c_re, s5_c_im,
              s5_d, w_glu, b_glu, w_out, w_ffn1, w_ffn2):
    bsz, s, _ = x.shape
    for l in range(DEPTH):
        h = rmsnorm(x, g_mix_pre[l])
        z = h @ w_in[l].astype(F32) + b_in[l].astype(F32)
        y_m = mlstm_branch(z[..., OFF_Q:OFF_V], z[..., OFF_V:OFF_O], z[..., OFF_O:OFF_IG],
                           z[..., OFF_IG:OFF_FG], z[..., OFF_FG:OFF_FOURIER],
                           conv_w[l], conv_b[l], mlstm_norm_g[l]) @ w_up_mlstm[l].astype(F32)
        y_f = fourier_branch(z[..., OFF_FOURIER:OFF_S5]) @ w_up_fourier[l].astype(F32)
        y_s = s5_branch(z[..., OFF_S5:OFF_GATE], s5_lam_re[l], s5_lam_im[l], s5_log_dt[l], s5_b_re[l], s5_b_im[l],
                        s5_c_re[l], s5_c_im[l], s5_d[l], w_glu[l], b_glu[l])
        gates = jax.nn.sigmoid(z[..., OFF_GATE:]).reshape(bsz, s, N_BRANCHES, D_MODEL)
        mixed = gates[..., 0, :] * y_m + gates[..., 1, :] * y_f + gates[..., 2, :] * y_s
        x = x + rmsnorm(mixed @ w_out[l].astype(F32), g_mix_post[l]).astype(x.dtype)
        h = rmsnorm(x, g_ffn_pre[l])
        f = jnp.square(jax.nn.relu(h @ w_ffn1[l].astype(F32))) @ w_ffn2[l].astype(F32)
        x = x + rmsnorm(f, g_ffn_post[l]).astype(x.dtype)
    return x
```

```cpp
#include <hip/hip_runtime.h>
#include <hip/hip_cooperative_groups.h>
#include <stdint.h>
#include <stdio.h>
#include <math.h>
namespace cg = cooperative_groups;

#ifndef COOP
#define COOP 1
#endif

typedef unsigned short bf16_t;
typedef __attribute__((ext_vector_type(8))) short bf16x8;
typedef __attribute__((ext_vector_type(4))) float f32x4;

#define NT 512
constexpr int SEQ = 8192, TOK = 16384, DM = 1024, NIN = 5648, ZS = 2576, DFF = 4096;
constexpr int OFF_K = 512, OFF_V = 1024, OFF_O = 1536, OFF_IG = 2048, OFF_F = 2064, OFF_S = 2320, OFF_GATE = 2576;
constexpr float EPS = 1e-6f;

enum { I_X = 0, I_GMPRE, I_GMPOST, I_GFPRE, I_GFPOST, I_WIN, I_BIN, I_CW, I_CB, I_MNG, I_WUPM, I_WUPF, I_LRE, I_LIM, I_LDT,
       I_BRE, I_BIM, I_CRE, I_CIM, I_SD, I_WGLU, I_BGLU, I_WOUT, I_W1, I_W2 };

constexpr size_t W_WIN = 0;
constexpr size_t W_WUPM = W_WIN + (size_t)NIN * 1024 * 2;
constexpr size_t W_WUPF = W_WUPM + 1024 * 512 * 2;
constexpr size_t W_WGLU = W_WUPF + 1024 * 256 * 2;
constexpr size_t W_WOUT = W_WGLU + 2048 * 256 * 2;
constexpr size_t W_W1 = W_WOUT + 1024 * 1024 * 2;
constexpr size_t W_W2 = W_W1 + 4096 * 1024 * 2;
constexpr size_t W_ET = W_W2 + 4096 * 1024 * 2;
constexpr size_t W_TG = W_ET + 16 * 256 * 512 * 2;
constexpr size_t W_F1T = W_TG + 16 * 512 * 768 * 2;
constexpr size_t W_F2T = W_F1T + 128 * 64 * 2;
constexpr size_t W_F3T = W_F2T + 256 * 256 * 2;
constexpr size_t W_TW = W_F3T + 64 * 128 * 2;
constexpr size_t W_LPOW = W_TW + 64 * 128 * 2 * 4;
constexpr size_t W_ZERO = W_LPOW + 2 * 16 * 64 * 2 * 4;
constexpr size_t W_AMAX = W_ZERO + 256;
constexpr size_t W_G = W_AMAX + 4096;
constexpr size_t W_MPREV = W_G + 4096;
constexpr size_t W_NST = W_MPREV + 4096;
constexpr size_t W_ZG = W_NST + 16 * 64 * 128 * 4;
constexpr size_t W_HBF = W_ZG + (size_t)TOK * 16 * 4;
constexpr size_t W_Z = W_HBF + (size_t)TOK * 1024 * 2;
constexpr size_t W_CST = W_Z + (size_t)TOK * ZS * 2;
constexpr size_t W_U1T = W_CST + (size_t)16 * 64 * 16384 * 2;
constexpr size_t W_A2T = W_U1T + (size_t)TOK * 512 * 2;
constexpr size_t W_YF = W_A2T + (size_t)TOK * 512 * 2;
constexpr size_t W_YS = W_YF + (size_t)TOK * 256 * 2;
constexpr size_t W_XEND = W_YS + (size_t)TOK * 256 * 2;
constexpr size_t W_XCAR = W_XEND + (size_t)512 * 16 * 256 * 2;
constexpr size_t W_END = W_XCAR + (size_t)512 * 16 * 256 * 2;
constexpr size_t W_HM = W_U1T;
constexpr size_t W_MIX = W_Z;
constexpr size_t W_O = W_Z + (size_t)TOK * 1024 * 2;
constexpr size_t W_HID = W_Z;
constexpr size_t W_FO = W_A2T;
static_assert(W_U1T + (size_t)TOK * 512 * 2 - W_Z >= (size_t)TOK * 4096 * 2, "hid alias");

constexpr int SMEM_BYTES = 135168;

struct Params { const float* in[25]; float* out; char* ws; };

__device__ __forceinline__ int tidx() { int t = threadIdx.x; asm volatile("" : "+v"(t)); return t; }
__device__ __forceinline__ bf16_t f2bf(float f) {
  uint32_t u = __float_as_uint(f);
  u += 0x7fffu + ((u >> 16) & 1u);
  return (bf16_t)(u >> 16);
}
__device__ __forceinline__ float bf2f(bf16_t h) { return __uint_as_float(((uint32_t)h) << 16); }
__device__ __forceinline__ uint32_t pack2(float a, float b) { return (uint32_t)f2bf(a) | ((uint32_t)f2bf(b) << 16); }
__device__ __forceinline__ uint2 pack4(float a, float b, float c, float d) { uint2 r; r.x = pack2(a, b); r.y = pack2(c, d); return r; }
__device__ __forceinline__ float lo16(uint32_t u) { return __uint_as_float(u << 16); }
__device__ __forceinline__ float hi16(uint32_t u) { return __uint_as_float(u & 0xffff0000u); }
__device__ __forceinline__ float sigm(float x) { return 1.f / (1.f + expf(-x)); }
__device__ __forceinline__ float logsig(float x) { return fminf(x, 0.f) - log1pf(expf(-fabsf(x))); }
__device__ __forceinline__ float gelu_tanh(float x) { float u = 0.7978845608028654f * (x + 0.044715f * x * x * x); return 0.5f * x * (1.f + tanhf(u)); }
__device__ __forceinline__ float wave_sum(float v) {
#pragma unroll
  for (int o = 32; o >= 1; o >>= 1) v += __shfl_xor(v, o);
  return v;
}
__device__ __forceinline__ float wave_max(float v) {
#pragma unroll
  for (int o = 32; o >= 1; o >>= 1) v = fmaxf(v, __shfl_xor(v, o));
  return v;
}
__device__ __forceinline__ float wave_incl_sum(float v, int lane) {
#pragma unroll
  for (int o = 1; o < 64; o <<= 1) { float t = __shfl_up(v, o); if (lane >= o) v += t; }
  return v;
}
__device__ __forceinline__ float wave_incl_max(float v, int lane) {
#pragma unroll
  for (int o = 1; o < 64; o <<= 1) { float t = __shfl_up(v, o); if (lane >= o) v = fmaxf(v, t); }
  return v;
}
__device__ __forceinline__ f32x4 mfma16(bf16x8 a, bf16x8 b, f32x4 c) { return __builtin_amdgcn_mfma_f32_16x16x32_bf16(a, b, c, 0, 0, 0); }

constexpr int BK = 64, LDK = 72;
template <int BM, int BN, int WM, int WN, bool SWAP, class AF, class BF>
__device__ __forceinline__ void gemm_acc(int K, AF aptr, BF bptr, char* smem, f32x4 (&acc)[BM / WM / 16][BN / WN / 16]) {
  constexpr int TM = BM / WM / 16, TN = BN / WN / 16;
  constexpr int CA = BM * 8 / NT, CB = BN * 8 / NT;
  static_assert(CA >= 1 && CB >= 1, "tile too small");
  bf16_t* As = (bf16_t*)smem;
  bf16_t* Bs = As + 2 * BM * LDK;
  const int tid = tidx(), lane = tid & 63, w = tid >> 6;
  const int mb = (w / WN) * (BM / WM), nb = (w % WN) * (BN / WN);
  const int r16 = lane & 15, kq = (lane >> 4) * 8;
  uint4 ra0, ra1, ra2, ra3, rb0, rb1;
  ra0 = ra1 = ra2 = ra3 = rb0 = rb1 = make_uint4(0, 0, 0, 0);
  static_assert(CA <= 4 && CB <= 2, "chunks");
#define GLOAD(K0)                                                                                         \
  {                                                                                                       \
    { int c = tid; ra0 = *(const uint4*)aptr(c >> 3, (K0) + (c & 7) * 8); }                               \
    if (CA > 1) { int c = tid + NT; ra1 = *(const uint4*)aptr(c >> 3, (K0) + (c & 7) * 8); }              \
    if (CA > 2) { int c = tid + 2 * NT; ra2 = *(const uint4*)aptr(c >> 3, (K0) + (c & 7) * 8); }          \
    if (CA > 3) { int c = tid + 3 * NT; ra3 = *(const uint4*)aptr(c >> 3, (K0) + (c & 7) * 8); }          \
    { int c = tid; rb0 = *(const uint4*)bptr(c >> 3, (K0) + (c & 7) * 8); }                               \
    if (CB > 1) { int c = tid + NT; rb1 = *(const uint4*)bptr(c >> 3, (K0) + (c & 7) * 8); }              \
  }
#define SSTORE(AP, BP)                                                                                    \
  {                                                                                                       \
    { int c = tid; *(uint4*)&(AP)[(c >> 3) * LDK + (c & 7) * 8] = ra0; }                                  \
    if (CA > 1) { int c = tid + NT; *(uint4*)&(AP)[(c >> 3) * LDK + (c & 7) * 8] = ra1; }                 \
    if (CA > 2) { int c = tid + 2 * NT; *(uint4*)&(AP)[(c >> 3) * LDK + (c & 7) * 8] = ra2; }             \
    if (CA > 3) { int c = tid + 3 * NT; *(uint4*)&(AP)[(c >> 3) * LDK + (c & 7) * 8] = ra3; }             \
    { int c = tid; *(uint4*)&(BP)[(c >> 3) * LDK + (c & 7) * 8] = rb0; }                                  \
    if (CB > 1) { int c = tid + NT; *(uint4*)&(BP)[(c >> 3) * LDK + (c & 7) * 8] = rb1; }                 \
  }
  GLOAD(0);
  SSTORE(As, Bs);
  __syncthreads();
  const int nk = K / BK;
#pragma unroll 1
  for (int kt = 0; kt < nk; kt++) {
    const int buf = kt & 1;
    if (kt + 1 < nk) { GLOAD((kt + 1) * BK); }
    const bf16_t* Ab = As + buf * BM * LDK;
    const bf16_t* Bb = Bs + buf * BN * LDK;
#pragma unroll
    for (int kk = 0; kk < 2; kk++) {
      bf16x8 af[TM], bfr[TN];
#pragma unroll
      for (int i = 0; i < TM; i++) af[i] = *(const bf16x8*)&Ab[(mb + i * 16 + r16) * LDK + kk * 32 + kq];
#pragma unroll
      for (int j = 0; j < TN; j++) bfr[j] = *(const bf16x8*)&Bb[(nb + j * 16 + r16) * LDK + kk * 32 + kq];
#pragma unroll
      for (int i = 0; i < TM; i++)
#pragma unroll
        for (int j = 0; j < TN; j++) acc[i][j] = SWAP ? mfma16(bfr[j], af[i], acc[i][j]) : mfma16(af[i], bfr[j], acc[i][j]);
    }
    if (kt + 1 < nk) {
      bf16_t* An = As + (buf ^ 1) * BM * LDK;
      bf16_t* Bn = Bs + (buf ^ 1) * BN * LDK;
      SSTORE(An, Bn);
    }
    __syncthreads();
  }
#undef GLOAD
#undef SSTORE
}

template <int TM, int TN>
__device__ __forceinline__ void zero_acc(f32x4 (&acc)[TM][TN]) {
#pragma unroll
  for (int i = 0; i < TM; i++)
#pragma unroll
    for (int j = 0; j < TN; j++) acc[i][j] = f32x4{0.f, 0.f, 0.f, 0.f};
}

constexpr int LDT = 136;
template <int TM, int TN, bool SWAP>
__device__ __forceinline__ void mma_lds(const bf16_t* A, const bf16_t* B, int K, int mb, int nb, f32x4 (&acc)[TM][TN]) {
  const int lane = tidx() & 63, r16 = lane & 15, kq = (lane >> 4) * 8;
  for (int k0 = 0; k0 < K; k0 += 32) {
    bf16x8 af[TM], bfr[TN];
#pragma unroll
    for (int i = 0; i < TM; i++) af[i] = *(const bf16x8*)&A[(mb + i * 16 + r16) * LDT + k0 + kq];
#pragma unroll
    for (int j = 0; j < TN; j++) bfr[j] = *(const bf16x8*)&B[(nb + j * 16 + r16) * LDT + k0 + kq];
#pragma unroll
    for (int i = 0; i < TM; i++)
#pragma unroll
      for (int j = 0; j < TN; j++) acc[i][j] = SWAP ? mfma16(bfr[j], af[i], acc[i][j]) : mfma16(af[i], bfr[j], acc[i][j]);
  }
}

__device__ __forceinline__ void transpose_tile(const float* __restrict__ src, bf16_t* __restrict__ dst, int K, int N, int tile, char* smem) {
  float* sm = (float*)smem;
  const int ntn = (N + 63) >> 6;
  const int k0 = (tile / ntn) * 64, n0 = (tile % ntn) * 64;
  const int tid = tidx();
#pragma unroll
  for (int t = 0; t < 8; t++) {
    int idx = tid + t * NT, r = idx >> 6, c = idx & 63;
    float v = (n0 + c < N) ? src[(size_t)(k0 + r) * N + n0 + c] : 0.f;
    sm[r * 65 + c] = v;
  }
  __syncthreads();
#pragma unroll
  for (int t = 0; t < 8; t++) {
    int idx = tid + t * NT, r = idx >> 6, c = idx & 63;
    if (n0 + r < N) dst[(size_t)(n0 + r) * K + k0 + c] = f2bf(sm[c * 65 + r]);
  }
  __syncthreads();
}

__device__ __forceinline__ void transpose_item(const Params& p, int l, int i, char* smem) {
  char* ws = p.ws;
  if (i < 1424) { transpose_tile(p.in[I_WIN] + (size_t)l * 1024 * NIN, (bf16_t*)(ws + W_WIN), 1024, NIN, i, smem); return; }
  i -= 1424;
  if (i < 128) { transpose_tile(p.in[I_WUPM] + (size_t)l * 512 * 1024, (bf16_t*)(ws + W_WUPM), 512, 1024, i, smem); return; }
  i -= 128;
  if (i < 64) { transpose_tile(p.in[I_WUPF] + (size_t)l * 256 * 1024, (bf16_t*)(ws + W_WUPF), 256, 1024, i, smem); return; }
  i -= 64;
  if (i < 128) { transpose_tile(p.in[I_WGLU] + (size_t)l * 256 * 2048, (bf16_t*)(ws + W_WGLU), 256, 2048, i, smem); return; }
  i -= 128;
  if (i < 256) { transpose_tile(p.in[I_WOUT] + (size_t)l * 1024 * 1024, (bf16_t*)(ws + W_WOUT), 1024, 1024, i, smem); return; }
  i -= 256;
  if (i < 1024) { transpose_tile(p.in[I_W1] + (size_t)l * 1024 * 4096, (bf16_t*)(ws + W_W1), 1024, 4096, i, smem); return; }
  i -= 1024;
  transpose_tile(p.in[I_W2] + (size_t)l * 4096 * 1024, (bf16_t*)(ws + W_W2), 4096, 1024, i, smem);
}
constexpr int N_TR = 1424 + 128 + 64 + 128 + 256 + 1024 + 1024;

__device__ __forceinline__ void gen_tables(const Params& p, int item) {
  char* ws = p.ws;
  bf16_t* F1T = (bf16_t*)(ws + W_F1T);
  bf16_t* F2T = (bf16_t*)(ws + W_F2T);
  bf16_t* F3T = (bf16_t*)(ws + W_F3T);
  float* TW = (float*)(ws + W_TW);
  uint32_t* ZR = (uint32_t*)(ws + W_ZERO);
  constexpr int E1 = 8192, E2 = 65536, E3 = 8192, E4 = 8192, E5 = 64;
  for (int e = item * NT + tidx(); e < E1 + E2 + E3 + E4 + E5; e += 32 * NT) {
    int i = e;
    if (i < E1) {
      int n = i >> 6, d = i & 63, c = n >> 6, j = n & 63;
      float s, co; sincospif((float)((j * d) & 63) / 32.f, &s, &co);
      F1T[i] = f2bf(c == 0 ? co : -s);
      continue;
    }
    i -= E1;
    if (i < E2) {
      int n = i >> 8, k = i & 255;
      int k1 = (n >> 5) * 16 + (n & 15), cp = (n >> 4) & 1, c = k >> 7, s1 = k & 127;
      float s, co; sincospif((float)((s1 * k1) & 127) / 64.f, &s, &co);
      float v = (cp == 0) ? (c == 0 ? co : s) : (c == 0 ? -s : co);
      F2T[i] = f2bf(v);
      continue;
    }
    i -= E2;
    if (i < E3) {
      int k2 = i >> 7, k = i & 127, cp = k >> 6, s2 = k & 63;
      float s, co; sincospif((float)((s2 * k2) & 63) / 32.f, &s, &co);
      const float scale = 0.0013810679320049757f;
      F3T[i] = f2bf((cp == 0 ? co : s) * scale);
      continue;
    }
    i -= E3;
    if (i < E4) {
      int s2 = i >> 7, k1 = i & 127;
      float s, co; sincospif((float)(s2 * k1) / 4096.f, &s, &co);
      TW[2 * i] = co; TW[2 * i + 1] = s;
      continue;
    }
    i -= E4;
    ZR[i] = 0u;
  }
}

__device__ __forceinline__ void s5_gen(const Params& p, int l, int g, char* smem) {
  float* POW = (float*)smem;
  float* BB = POW + 2 * 33 * 64 * 2;
  float* CC = BB + 2 * 64 * 16 * 2;
  float* KT = CC + 2 * 16 * 64 * 2;
  const int tid = tidx();
  char* ws = p.ws;
  if (tid < 128) {
    int d = tid >> 6, pp = tid & 63;
    int gi = ((l * 2 + d) * 16 + g);
    float dt = expf(p.in[I_LDT][gi]);
    float lr = p.in[I_LRE][gi * 64 + pp], li = p.in[I_LIM][gi * 64 + pp];
    float mag = expf(lr * dt);
    float sn, cs; sincosf(li * dt, &sn, &cs);
    float lbr = mag * cs, lbi = mag * sn;
    float den = lr * lr + li * li;
    float fr = ((lbr - 1.f) * lr + lbi * li) / den;
    float fi = (lbi * lr - (lbr - 1.f) * li) / den;
    for (int ci = 0; ci < 16; ci++) {
      float br = p.in[I_BRE][(gi * 64 + pp) * 16 + ci], bi = p.in[I_BIM][(gi * 64 + pp) * 16 + ci];
      BB[((d * 64 + pp) * 16 + ci) * 2] = fr * br - fi * bi;
      BB[((d * 64 + pp) * 16 + ci) * 2 + 1] = fr * bi + fi * br;
    }
    for (int tau = 0; tau <= 32; tau++) {
      float m2 = expf(lr * dt * (float)tau);
      float s2, c2; sincosf(li * dt * (float)tau, &s2, &c2);
      POW[((d * 33 + tau) * 64 + pp) * 2] = m2 * c2;
      POW[((d * 33 + tau) * 64 + pp) * 2 + 1] = m2 * s2;
      if (tau == 32) {
        float* LP = (float*)(ws + W_LPOW);
        LP[((d * 16 + g) * 64 + pp) * 2] = m2 * c2;
        LP[((d * 16 + g) * 64 + pp) * 2 + 1] = m2 * s2;
      }
    }
  }
  for (int e = tid; e < 2048; e += NT) {
    int d = e >> 10, r = e & 1023;
    int gi = ((l * 2 + d) * 16 + g);
    CC[e * 2] = p.in[I_CRE][gi * 1024 + r];
    CC[e * 2 + 1] = p.in[I_CIM][gi * 1024 + r];
  }
  __syncthreads();
  for (int e = tid; e < 16384; e += NT) {
    int d = e >> 13, tau = (e >> 8) & 31, co = (e >> 4) & 15, ci = e & 15;
    float s = 0.f;
    for (int pp = 0; pp < 64; pp++) {
      float cr = CC[((d * 16 + co) * 64 + pp) * 2], cim = CC[((d * 16 + co) * 64 + pp) * 2 + 1];
      float pr = POW[((d * 33 + tau) * 64 + pp) * 2], pi = POW[((d * 33 + tau) * 64 + pp) * 2 + 1];
      float xr = cr * pr - cim * pi, xi = cr * pi + cim * pr;
      float br = BB[((d * 64 + pp) * 16 + ci) * 2], bi = BB[((d * 64 + pp) * 16 + ci) * 2 + 1];
      s += xr * br - xi * bi;
    }
    KT[e] = s;
  }
  __syncthreads();
  bf16_t* TG = (bf16_t*)(ws + W_TG) + (size_t)g * 512 * 768;
  const float* dsk = p.in[I_SD] + (l * 16 + g) * 16;
  for (int e = tid; e < 512 * 768; e += NT) {
    int n = e / 768, k = e - n * 768;
    int t = n >> 4, co = n & 15;
    float v;
    if (k < 512) {
      int s = k >> 4, ci = k & 15;
      if (t > s) v = KT[((0 * 32 + (t - s)) * 16 + co) * 16 + ci];
      else if (t < s) v = KT[((1 * 32 + (s - t)) * 16 + co) * 16 + ci];
      else v = KT[(co)*16 + ci] + KT[((32) * 16 + co) * 16 + ci] + (co == ci ? dsk[co] : 0.f);
    } else {
      int kk = k - 512, d = kk >> 7, pp = (kk & 127) >> 1, c = kk & 1;
      int tau = d == 0 ? t + 1 : 32 - t;
      float cr = CC[((d * 16 + co) * 64 + pp) * 2], cim = CC[((d * 16 + co) * 64 + pp) * 2 + 1];
      float pr = POW[((d * 33 + tau) * 64 + pp) * 2], pi = POW[((d * 33 + tau) * 64 + pp) * 2 + 1];
      float xr = cr * pr - cim * pi, xi = cr * pi + cim * pr;
      v = c == 0 ? xr : -xi;
    }
    TG[e] = f2bf(v);
  }
  bf16_t* ET = (bf16_t*)(ws + W_ET) + (size_t)g * 256 * 512;
  for (int e = tid; e < 256 * 512; e += NT) {
    int n = e >> 9, k = e & 511;
    int d = n >> 7, pp = (n & 127) >> 1, c = n & 1, s = k >> 4, ci = k & 15;
    int tau = d == 0 ? 31 - s : s;
    float pr = POW[((d * 33 + tau) * 64 + pp) * 2], pi = POW[((d * 33 + tau) * 64 + pp) * 2 + 1];
    float br = BB[((d * 64 + pp) * 16 + ci) * 2], bi = BB[((d * 64 + pp) * 16 + ci) * 2 + 1];
    float v = c == 0 ? (pr * br - pi * bi) : (pr * bi + pi * br);
    ET[e] = f2bf(v);
  }
  __syncthreads();
}

__device__ __forceinline__ void rms_item(const Params& p, int mode, int l, int item) {
  const int lane = tidx() & 63, w = tidx() >> 6;
  const int row = item * 8 + w;
  char* ws = p.ws;
  const float* xin = (mode == 2 || l > 0) ? p.out : p.in[I_X];
  float xv[16];
#pragma unroll
  for (int t = 0; t < 4; t++) {
    float4 v = *(const float4*)(xin + (size_t)row * 1024 + t * 256 + lane * 4);
    xv[t * 4] = v.x; xv[t * 4 + 1] = v.y; xv[t * 4 + 2] = v.z; xv[t * 4 + 3] = v.w;
  }
  if (mode >= 1) {
    const bf16_t* y = (const bf16_t*)(ws + (mode == 1 ? W_O : W_FO)) + (size_t)row * 1024;
    const float* gp = (mode == 1 ? p.in[I_GMPOST] : p.in[I_GFPOST]) + l * 1024;
    float yv[16];
    float ss = 0.f;
#pragma unroll
    for (int t = 0; t < 4; t++) {
      uint2 u = *(const uint2*)(y + t * 256 + lane * 4);
      yv[t * 4] = lo16(u.x); yv[t * 4 + 1] = hi16(u.x); yv[t * 4 + 2] = lo16(u.y); yv[t * 4 + 3] = hi16(u.y);
    }
#pragma unroll
    for (int e = 0; e < 16; e++) ss += yv[e] * yv[e];
    ss = wave_sum(ss);
    float r = rsqrtf(ss * (1.f / 1024.f) + EPS);
#pragma unroll
    for (int t = 0; t < 4; t++) {
      float4 gv = *(const float4*)(gp + t * 256 + lane * 4);
      xv[t * 4] += yv[t * 4] * r * gv.x; xv[t * 4 + 1] += yv[t * 4 + 1] * r * gv.y;
      xv[t * 4 + 2] += yv[t * 4 + 2] * r * gv.z; xv[t * 4 + 3] += yv[t * 4 + 3] * r * gv.w;
      *(float4*)(p.out + (size_t)row * 1024 + t * 256 + lane * 4) = make_float4(xv[t * 4], xv[t * 4 + 1], xv[t * 4 + 2], xv[t * 4 + 3]);
    }
  }
  const bool wh = (mode != 2) || (l + 1 < 2);
  if (wh) {
    const float* gh = (mode == 0 ? p.in[I_GMPRE] + l * 1024 : (mode == 1 ? p.in[I_GFPRE] + l * 1024 : p.in[I_GMPRE] + (l + 1) * 1024));
    float ss = 0.f;
#pragma unroll
    for (int e = 0; e < 16; e++) ss += xv[e] * xv[e];
    ss = wave_sum(ss);
    float r = rsqrtf(ss * (1.f / 1024.f) + EPS);
    bf16_t* h = (bf16_t*)(ws + W_HBF) + (size_t)row * 1024;
#pragma unroll
    for (int t = 0; t < 4; t++) {
      float4 gv = *(const float4*)(gh + t * 256 + lane * 4);
      *(uint2*)(h + t * 256 + lane * 4) = pack4(xv[t * 4] * r * gv.x, xv[t * 4 + 1] * r * gv.y, xv[t * 4 + 2] * r * gv.z, xv[t * 4 + 3] * r * gv.w);
    }
  }
}

__device__ __forceinline__ void inproj_item(const Params& p, int l, int item, char* smem) {
  constexpr int NTL = 21;
  const int mt = item / NTL, nt = item % NTL;
  const int m0 = mt * 256, n0 = nt * 128;
  char* ws = p.ws;
  const bf16_t* A = (const bf16_t*)(ws + W_HBF) + (size_t)m0 * 1024;
  const bf16_t* B = (const bf16_t*)(ws + W_WIN);
  f32x4 acc[4][4];
  zero_acc(acc);
  gemm_acc<256, 128, 4, 2, true>(1024,
      [&](int r, int k) { return A + (size_t)r * 1024 + k; },
      [&](int r, int k) { int n = n0 + r; n = n < ZS ? n : ZS - 1; return B + (size_t)n * 1024 + k; }, smem, acc);
  const int lane = tidx() & 63, w = tidx() >> 6;
  const int mb = (w / 2) * 64, nb = (w % 2) * 64;
  bf16_t* Z = (bf16_t*)(ws + W_Z);
  float* ZG = (float*)(ws + W_ZG);
  const float* bin = p.in[I_BIN] + l * NIN;
#pragma unroll
  for (int i = 0; i < 4; i++) {
    const int m = m0 + mb + i * 16 + (lane & 15);
#pragma unroll
    for (int j = 0; j < 4; j++) {
      const int n = n0 + nb + j * 16 + (lane >> 4) * 4;
      if (n < ZS) {
        float4 bv = *(const float4*)(bin + n);
        float v0 = acc[i][j][0] + bv.x, v1 = acc[i][j][1] + bv.y, v2 = acc[i][j][2] + bv.z, v3 = acc[i][j][3] + bv.w;
        *(uint2*)(Z + (size_t)m * ZS + n) = pack4(v0, v1, v2, v3);
        if (n >= OFF_IG && n < OFF_IG + 16) *(float4*)(ZG + (size_t)m * 16 + (n - OFF_IG)) = make_float4(v0, v1, v2, v3);
      }
    }
  }
}

template <int MODE>
__device__ __forceinline__ void plain_gemm_item(const bf16_t* A, const bf16_t* Bt, bf16_t* C, int N, int K, int item, char* smem) {
  const int ntl = N / 128;
  const int mt = item / ntl, nt = item % ntl;
  const int m0 = mt * 256, n0 = nt * 128;
  const bf16_t* Ab = A + (size_t)m0 * K;
  const bf16_t* Bb = Bt + (size_t)n0 * K;
  f32x4 acc[4][4];
  zero_acc(acc);
  gemm_acc<256, 128, 4, 2, true>(K, [&](int r, int k) { return Ab + (size_t)r * K + k; }, [&](int r, int k) { return Bb + (size_t)r * K + k; }, smem, acc);
  const int lane = tidx() & 63, w = tidx() >> 6;
  const int mb = (w / 2) * 64, nb = (w % 2) * 64;
#pragma unroll
  for (int i = 0; i < 4; i++) {
    const int m = m0 + mb + i * 16 + (lane & 15);
#pragma unroll
    for (int j = 0; j < 4; j++) {
      const int n = n0 + nb + j * 16 + (lane >> 4) * 4;
      float v0 = acc[i][j][0], v1 = acc[i][j][1], v2 = acc[i][j][2], v3 = acc[i][j][3];
      if (MODE == 1) {
        v0 = fmaxf(v0, 0.f); v0 *= v0; v1 = fmaxf(v1, 0.f); v1 *= v1; v2 = fmaxf(v2, 0.f); v2 *= v2; v3 = fmaxf(v3, 0.f); v3 *= v3;
      }
      *(uint2*)(C + (size_t)m * N + n) = pack4(v0, v1, v2, v3);
    }
  }
}

__device__ __forceinline__ void merge_item(const Params& p, int l, int item, char* smem) {
  const int mt = item >> 3, nt = item & 7;
  const int m0 = mt * 128, n0 = nt * 128;
  char* ws = p.ws;
  const bf16_t* HB = (const bf16_t*)(ws + W_HBF) + (size_t)m0 * 1024;
  const bf16_t* HM = (const bf16_t*)(ws + W_HM) + (size_t)m0 * 512;
  const bf16_t* YF = (const bf16_t*)(ws + W_YF) + (size_t)m0 * 256;
  const bf16_t* YS = (const bf16_t*)(ws + W_YS) + (size_t)m0 * 256;
  const bf16_t* WG = (const bf16_t*)(ws + W_WIN) + (size_t)(OFF_GATE + n0) * 1024;
  const bf16_t* WUM = (const bf16_t*)(ws + W_WUPM) + (size_t)n0 * 512;
  const bf16_t* WUF = (const bf16_t*)(ws + W_WUPF) + (size_t)n0 * 256;
  const bf16_t* WGL = (const bf16_t*)(ws + W_WGLU) + (size_t)n0 * 256;
  const float* bin = p.in[I_BIN] + l * NIN + OFF_GATE;
  const float* bgl = p.in[I_BGLU] + l * 2048;
  const int lane = tidx() & 63, w = tidx() >> 6;
  const int nb = (w % 2) * 64;
  f32x4 mix[2][4];
  zero_acc(mix);
  bf16_t* MIX = (bf16_t*)(ws + W_MIX);
  const int mb = (w / 2) * 32;
#pragma unroll 1
  for (int br = 0; br < 3; br++) {
    const bf16_t* A = br == 0 ? HM : (br == 1 ? YF : YS);
    const bf16_t* W = br == 0 ? WUM : (br == 1 ? WUF : WGL);
    const int KA = br == 0 ? 512 : 256;
    f32x4 tmp[2][4];
    zero_acc(tmp);
    gemm_acc<128, 128, 4, 2, true>(KA, [&](int r, int k) { return A + (size_t)r * KA + k; }, [&](int r, int k) { return W + (size_t)r * KA + k; }, smem, tmp);
    if (br == 2) {
      f32x4 a2[2][4];
      zero_acc(a2);
      gemm_acc<128, 128, 4, 2, true>(256, [&](int r, int k) { return YS + (size_t)r * 256 + k; }, [&](int r, int k) { return WGL + (size_t)(1024 + r) * 256 + k; }, smem, a2);
#pragma unroll
      for (int j = 0; j < 4; j++) {
        const int n = n0 + nb + j * 16 + (lane >> 4) * 4;
        float4 b1 = *(const float4*)(bgl + n);
        float4 b2 = *(const float4*)(bgl + 1024 + n);
#pragma unroll
        for (int i = 0; i < 2; i++) {
          tmp[i][j][0] = (tmp[i][j][0] + b1.x) * sigm(a2[i][j][0] + b2.x);
          tmp[i][j][1] = (tmp[i][j][1] + b1.y) * sigm(a2[i][j][1] + b2.y);
          tmp[i][j][2] = (tmp[i][j][2] + b1.z) * sigm(a2[i][j][2] + b2.z);
          tmp[i][j][3] = (tmp[i][j][3] + b1.w) * sigm(a2[i][j][3] + b2.w);
        }
      }
    }
    f32x4 acc[2][4];
    zero_acc(acc);
    const bf16_t* WGb = WG + (size_t)br * 1024 * 1024;
    gemm_acc<128, 128, 4, 2, true>(1024, [&](int r, int k) { return HB + (size_t)r * 1024 + k; }, [&](int r, int k) { return WGb + (size_t)r * 1024 + k; }, smem, acc);
#pragma unroll
    for (int j = 0; j < 4; j++) {
      const int n = n0 + nb + j * 16 + (lane >> 4) * 4;
      float4 bv = *(const float4*)(bin + br * 1024 + n);
#pragma unroll
      for (int i = 0; i < 2; i++) {
        mix[i][j][0] += tmp[i][j][0] * sigm(acc[i][j][0] + bv.x);
        mix[i][j][1] += tmp[i][j][1] * sigm(acc[i][j][1] + bv.y);
        mix[i][j][2] += tmp[i][j][2] * sigm(acc[i][j][2] + bv.z);
        mix[i][j][3] += tmp[i][j][3] * sigm(acc[i][j][3] + bv.w);
      }
    }
  }
#pragma unroll
  for (int j = 0; j < 4; j++) {
    const int n = n0 + nb + j * 16 + (lane >> 4) * 4;
#pragma unroll
    for (int i = 0; i < 2; i++) {
      const int m = m0 + mb + i * 16 + (lane & 15);
      *(uint2*)(MIX + (size_t)m * 1024 + n) = pack4(mix[i][j][0], mix[i][j][1], mix[i][j][2], mix[i][j][3]);
    }
  }
}

__device__ __forceinline__ void four_g1(const Params& p, int item, char* smem) {
  const int g = item & 3, s2 = (item >> 2) & 63, b = item >> 8;
  char* ws = p.ws;
  const bf16_t* Z = (const bf16_t*)(ws + W_Z) + ((size_t)b * SEQ + s2) * ZS + OFF_F + g * 64;
  const bf16_t* F1T = (const bf16_t*)(ws + W_F1T);
  f32x4 acc[2][4];
  zero_acc(acc);
  gemm_acc<128, 128, 4, 2, false>(64, [&](int r, int k) { return Z + (size_t)r * 64 * ZS + k; }, [&](int r, int k) { return F1T + r * 64 + k; }, smem, acc);
  const int lane = tidx() & 63, w = tidx() >> 6;
  const int mb = (w / 2) * 32, nb = (w % 2) * 64;
  bf16_t* U1T = (bf16_t*)(ws + W_U1T);
#pragma unroll
  for (int i = 0; i < 2; i++) {
    const int s1 = mb + i * 16 + (lane >> 4) * 4;
#pragma unroll
    for (int j = 0; j < 4; j++) {
      const int n = nb + j * 16 + (lane & 15), c = n >> 6, jj = n & 63;
      size_t off = ((((size_t)(b * 256 + g * 64 + jj) * 64 + s2) * 2 + c) * 128) + s1;
      *(uint2*)(U1T + off) = pack4(acc[i][j][0], acc[i][j][1], acc[i][j][2], acc[i][j][3]);
    }
  }
}
__device__ __forceinline__ void four_g2(const Params& p, int item, char* smem) {
  const int mt = item >> 1, nt = item & 1;
  const int m0 = mt * 128, n0 = nt * 128;
  char* ws = p.ws;
  const bf16_t* A = (const bf16_t*)(ws + W_U1T) + (size_t)m0 * 256;
  const bf16_t* B = (const bf16_t*)(ws + W_F2T) + (size_t)n0 * 256;
  f32x4 acc[2][4];
  zero_acc(acc);
  gemm_acc<128, 128, 4, 2, false>(256, [&](int r, int k) { return A + (size_t)r * 256 + k; }, [&](int r, int k) { return B + (size_t)r * 256 + k; }, smem, acc);
  const int lane = tidx() & 63, w = tidx() >> 6;
  const int mb = (w / 2) * 32, nb = (w % 2) * 64;
  const float* TW = (const float*)(ws + W_TW);
  bf16_t* A2T = (bf16_t*)(ws + W_A2T);
#pragma unroll
  for (int i = 0; i < 2; i++) {
    const int m = m0 + mb + i * 16 + (lane >> 4) * 4;
    const int s2 = m & 63, col = (m >> 6) & 255, b = m >> 14;
#pragma unroll
    for (int jp = 0; jp < 2; jp++) {
      const int nn = n0 + nb + jp * 32;
      const int k1 = (nn >> 5) * 16 + (lane & 15);
      float re[4], im[4];
#pragma unroll
      for (int r = 0; r < 4; r++) {
        float c = TW[((s2 + r) * 128 + k1) * 2], s = TW[((s2 + r) * 128 + k1) * 2 + 1];
        float ar = acc[i][jp * 2][r], ai = acc[i][jp * 2 + 1][r];
        re[r] = ar * c + ai * s;
        im[r] = ai * c - ar * s;
      }
      size_t off = ((size_t)(b * 128 + k1) * 256 + col) * 128 + s2;
      *(uint2*)(A2T + off) = pack4(re[0], re[1], re[2], re[3]);
      *(uint2*)(A2T + off + 64) = pack4(im[0], im[1], im[2], im[3]);
    }
  }
}
__device__ __forceinline__ void four_g3(const Params& p, int item, char* smem) {
  const int m0 = item * 128;
  char* ws = p.ws;
  const bf16_t* A = (const bf16_t*)(ws + W_A2T) + (size_t)m0 * 128;
  const bf16_t* B = (const bf16_t*)(ws + W_F3T);
  f32x4 acc[2][2];
  zero_acc(acc);
  gemm_acc<128, 64, 4, 2, false>(128, [&](int r, int k) { return A + (size_t)r * 128 + k; }, [&](int r, int k) { return B + r * 128 + k; }, smem, acc);
  const int lane = tidx() & 63, w = tidx() >> 6;
  const int mb = (w / 2) * 32, nb = (w % 2) * 32;
  bf16_t* YF = (bf16_t*)(ws + W_YF);
#pragma unroll
  for (int i = 0; i < 2; i++) {
    const int m = m0 + mb + i * 16 + (lane >> 4) * 4;
    const int col = m & 255, k1 = (m >> 8) & 127, b = m >> 15;
#pragma unroll
    for (int j = 0; j < 2; j++) {
      const int k2 = nb + j * 16 + (lane & 15);
      size_t off = ((size_t)b * SEQ + k1 + 128 * k2) * 256 + col;
      *(uint2*)(YF + off) = pack4(acc[i][j][0], acc[i][j][1], acc[i][j][2], acc[i][j][3]);
    }
  }
}

__device__ __forceinline__ void s5_e(const Params& p, int item, char* smem) {
  const int g = item >> 3, mt = (item >> 1) & 3, nt = item & 1;
  const int m0 = mt * 128, n0 = nt * 128;
  char* ws = p.ws;
  const bf16_t* Z = (const bf16_t*)(ws + W_Z) + OFF_S + g * 16;
  const bf16_t* B = (const bf16_t*)(ws + W_ET) + ((size_t)g * 256 + n0) * 512;
  f32x4 acc[2][4];
  zero_acc(acc);
  gemm_acc<128, 128, 4, 2, true>(512,
      [&](int r, int k) { int m = m0 + r; int tok = (m >> 8) * SEQ + (m & 255) * 32 + (k >> 4); return Z + (size_t)tok * ZS + (k & 15); },
      [&](int r, int k) { return B + (size_t)r * 512 + k; }, smem, acc);
  const int lane = tidx() & 63, w = tidx() >> 6;
  const int mb = (w / 2) * 32, nb = (w % 2) * 64;
  bf16_t* XE = (bf16_t*)(ws + W_XEND);
#pragma unroll
  for (int i = 0; i < 2; i++) {
    const int m = m0 + mb + i * 16 + (lane & 15);
#pragma unroll
    for (int j = 0; j < 4; j++) {
      const int n = n0 + nb + j * 16 + (lane >> 4) * 4;
      *(uint2*)(XE + ((size_t)m * 16 + g) * 256 + n) = pack4(acc[i][j][0], acc[i][j][1], acc[i][j][2], acc[i][j][3]);
    }
  }
}
__device__ __forceinline__ void s5_carry(const Params& p, int blk) {
  const int gt = blk * NT + tidx();
  const int b = gt >> 11, g = (gt >> 7) & 15, d = (gt >> 6) & 1, pp = gt & 63;
  char* ws = p.ws;
  const float* LP = (const float*)(ws + W_LPOW) + ((d * 16 + g) * 64 + pp) * 2;
  const float lr = LP[0], li = LP[1];
  const uint32_t* XE = (const uint32_t*)(ws + W_XEND);
  uint32_t* XC = (uint32_t*)(ws + W_XCAR);
  float xr = 0.f, xi = 0.f;
  for (int c0 = 0; c0 < 256; c0 += 8) {
    uint32_t v[8];
#pragma unroll
    for (int u = 0; u < 8; u++) {
      int c = d == 0 ? c0 + u : 255 - (c0 + u);
      v[u] = XE[(((size_t)(b * 256 + c) * 16 + g) * 256 + d * 128 + pp * 2) >> 1];
    }
#pragma unroll
    for (int u = 0; u < 8; u++) {
      int c = d == 0 ? c0 + u : 255 - (c0 + u);
      float nr = lr * xr - li * xi + lo16(v[u]);
      float ni = lr * xi + li * xr + hi16(v[u]);
      xr = nr; xi = ni;
      XC[(((size_t)(b * 256 + c) * 16 + g) * 256 + d * 128 + pp * 2) >> 1] = pack2(xr, xi);
    }
  }
}
__device__ __forceinline__ void s5_tg(const Params& p, int item, char* smem) {
  const int g = item >> 4, mt = (item >> 2) & 3, nt = item & 3;
  const int m0 = mt * 128, n0 = nt * 128;
  char* ws = p.ws;
  const bf16_t* Z = (const bf16_t*)(ws + W_Z) + OFF_S + g * 16;
  const bf16_t* XC = (const bf16_t*)(ws + W_XCAR);
  const bf16_t* ZR = (const bf16_t*)(ws + W_ZERO);
  const bf16_t* B = (const bf16_t*)(ws + W_TG) + ((size_t)g * 512 + n0) * 768;
  f32x4 acc[2][4];
  zero_acc(acc);
  gemm_acc<128, 128, 4, 2, true>(768,
      [&](int r, int k) -> const bf16_t* {
        int m = m0 + r; int b = m >> 8, c = m & 255;
        if (k < 512) { int tok = b * SEQ + c * 32 + (k >> 4); return Z + (size_t)tok * ZS + (k & 15); }
        int kk = k - 512; int d = kk >> 7; int cc = d == 0 ? c - 1 : c + 1;
        if (cc < 0 || cc > 255) return ZR;
        return XC + ((size_t)(b * 256 + cc) * 16 + g) * 256 + kk;
      },
      [&](int r, int k) { return B + (size_t)r * 768 + k; }, smem, acc);
  const int lane = tidx() & 63, w = tidx() >> 6;
  const int mb = (w / 2) * 32, nb = (w % 2) * 64;
  bf16_t* YS = (bf16_t*)(ws + W_YS);
#pragma unroll
  for (int i = 0; i < 2; i++) {
    const int m = m0 + mb + i * 16 + (lane & 15);
    const int b = m >> 8, c = m & 255;
#pragma unroll
    for (int j = 0; j < 4; j++) {
      const int n = n0 + nb + j * 16 + (lane >> 4) * 4;
      const int t = n >> 4, co = n & 15;
      size_t off = ((size_t)b * SEQ + c * 32 + t) * 256 + g * 16 + co;
      *(uint2*)(YS + off) = pack4(gelu_tanh(acc[i][j][0]), gelu_tanh(acc[i][j][1]), gelu_tanh(acc[i][j][2]), gelu_tanh(acc[i][j][3]));
    }
  }
}

__device__ __forceinline__ void conv8(const bf16_t* __restrict__ Z, const float* __restrict__ cw, const float* __restrict__ cb,
                                      int b, int s, int zcol, int ch, float (&o)[8]) {
  float4 b0 = *(const float4*)(cb + ch), b1 = *(const float4*)(cb + ch + 4);
  o[0] = b0.x; o[1] = b0.y; o[2] = b0.z; o[3] = b0.w; o[4] = b1.x; o[5] = b1.y; o[6] = b1.z; o[7] = b1.w;
#pragma unroll
  for (int wq = 0; wq < 5; wq++) {
    int ss = s + wq - 2;
    if (ss >= 0 && ss < SEQ) {
      uint4 v = *(const uint4*)(Z + ((size_t)b * SEQ + ss) * ZS + zcol);
      float4 w0 = *(const float4*)(cw + wq * 1024 + ch), w1 = *(const float4*)(cw + wq * 1024 + ch + 4);
      o[0] += w0.x * lo16(v.x); o[1] += w0.y * hi16(v.x); o[2] += w0.z * lo16(v.y); o[3] += w0.w * hi16(v.y);
      o[4] += w1.x * lo16(v.z); o[5] += w1.y * hi16(v.z); o[6] += w1.z * lo16(v.w); o[7] += w1.w * hi16(v.w);
    }
  }
#pragma unroll
  for (int e = 0; e < 8; e++) o[e] = o[e] / (1.f + expf(-o[e]));
}

__device__ __forceinline__ void mlstm_local(const Params& p, int l, int item, char* smem) {
  const int co = item & 63, h = (item >> 6) & 3, b = item >> 8;
  char* ws = p.ws;
  bf16_t* KTs = (bf16_t*)smem;
  bf16_t* VTs = KTs + 128 * LDT;
  float* WV = (float*)(VTs + 128 * LDT);
  const int tid = tidx(), lane = tid & 63, w = tid >> 6;
  const int tok0 = b * SEQ + co * 128;
  const bf16_t* Z = (const bf16_t*)(ws + W_Z);
  const float* ZG = (const float*)(ws + W_ZG);
  if (w < 2) {
    const int d = w, dbh = d * 8 + b * 4 + h, cp = d ? 63 - co : co;
    const int l0 = 2 * lane, l1 = l0 + 1;
    const int i0 = d ? 127 - l0 : l0, i1 = d ? 127 - l1 : l1;
    float ig0 = ZG[(size_t)(tok0 + i0) * 16 + d * 4 + h], ig1 = ZG[(size_t)(tok0 + i1) * 16 + d * 4 + h];
    float f0 = logsig(ZG[(size_t)(tok0 + i0) * 16 + 8 + d * 4 + h]), f1 = logsig(ZG[(size_t)(tok0 + i1) * 16 + 8 + d * 4 + h]);
    float s1 = f0 + f1;
    float incl = wave_incl_sum(s1, lane);
    float excl = incl - s1;
    float b0 = excl + f0, b1 = incl;
    float gtot = __shfl(incl, 63);
    float a0 = gtot - b0 + ig0, a1 = gtot - b1 + ig1;
    float am = wave_max(fmaxf(a0, a1));
    WV[d * 128 + i0] = expf(a0 - am);
    WV[d * 128 + i1] = expf(a1 - am);
    if (lane == 0) {
      ((float*)(ws + W_AMAX))[dbh * 64 + cp] = am;
      ((float*)(ws + W_G))[dbh * 64 + cp] = gtot;
    }
  }
  const float* cw = p.in[I_CW] + l * 5 * 1024;
  const float* cb = p.in[I_CB] + l * 1024;
#pragma unroll 1
  for (int t = 0; t < 4; t++) {
    int c = tid + t * NT, i = c >> 4, d8 = (c & 15) * 8;
    float o[8];
    conv8(Z, cw, cb, b, co * 128 + i, OFF_K + h * 128 + d8, 512 + h * 128 + d8, o);
#pragma unroll
    for (int e = 0; e < 8; e++) KTs[(d8 + e) * LDT + i] = f2bf(o[e]);
  }
  __syncthreads();
  if (tid < 256) {
    const int d = tid >> 7, k = tid & 127;
    const int dbh = d * 8 + b * 4 + h, cp = d ? 63 - co : co;
    float s = 0.f;
    for (int i = 0; i < 128; i++) s += WV[d * 128 + i] * bf2f(KTs[k * LDT + i]);
    ((float*)(ws + W_NST))[(size_t)(dbh * 64 + cp) * 128 + k] = s;
  }
  bf16_t* CST = (bf16_t*)(ws + W_CST);
  const int mb = (w / 2) * 32, nb = (w % 2) * 64;
#pragma unroll 1
  for (int d = 0; d < 2; d++) {
    const int dbh = d * 8 + b * 4 + h, cp = d ? 63 - co : co;
#pragma unroll 1
    for (int t = 0; t < 4; t++) {
      int c = tid + t * NT, i = c >> 4, e8 = (c & 15) * 8;
      uint4 v = *(const uint4*)(Z + (size_t)(tok0 + i) * ZS + OFF_V + h * 128 + e8);
      float wv = WV[d * 128 + i];
      VTs[(e8 + 0) * LDT + i] = f2bf(lo16(v.x) * wv); VTs[(e8 + 1) * LDT + i] = f2bf(hi16(v.x) * wv);
      VTs[(e8 + 2) * LDT + i] = f2bf(lo16(v.y) * wv); VTs[(e8 + 3) * LDT + i] = f2bf(hi16(v.y) * wv);
      VTs[(e8 + 4) * LDT + i] = f2bf(lo16(v.z) * wv); VTs[(e8 + 5) * LDT + i] = f2bf(hi16(v.z) * wv);
      VTs[(e8 + 6) * LDT + i] = f2bf(lo16(v.w) * wv); VTs[(e8 + 7) * LDT + i] = f2bf(hi16(v.w) * wv);
    }
    __syncthreads();
    f32x4 acc[2][4];
    zero_acc(acc);
    mma_lds<2, 4, false>(KTs, VTs, 128, mb, nb, acc);
    bf16_t* C = CST + (size_t)(dbh * 64 + cp) * 16384;
#pragma unroll
    for (int i = 0; i < 2; i++) {
      const int k = mb + i * 16 + (lane >> 4) * 4;
#pragma unroll
      for (int j = 0; j < 4; j++) {
        const int e = nb + j * 16 + (lane & 15);
        *(uint2*)(C + e * 128 + k) = pack4(acc[i][j][0], acc[i][j][1], acc[i][j][2], acc[i][j][3]);
      }
    }
    __syncthreads();
  }
}

__device__ __forceinline__ void mlstm_scan(const Params& p, int blk) {
  char* ws = p.ws;
  const float* AM = (const float*)(ws + W_AMAX);
  const float* G = (const float*)(ws + W_G);
  if (blk < 128) {
    const int gt = blk * NT + tidx(), dbh = gt >> 12, e4 = gt & 4095;
    uint2* C = (uint2*)(ws + W_CST) + (size_t)dbh * 64 * 4096 + e4;
    float m = 0.f, c0 = 0.f, c1 = 0.f, c2 = 0.f, c3 = 0.f;
    for (int cc0 = 0; cc0 < 64; cc0 += 8) {
      uint2 v[8];
#pragma unroll
      for (int u = 0; u < 8; u++) v[u] = C[(size_t)(cc0 + u) * 4096];
#pragma unroll
      for (int u = 0; u < 8; u++) {
        const int cc = cc0 + u;
        float g = G[dbh * 64 + cc], am = AM[dbh * 64 + cc];
        float mn = fmaxf(g + m, am);
        float so = expf(g + m - mn), sn = expf(am - mn);
        C[(size_t)cc * 4096] = pack4(c0, c1, c2, c3);
        if (e4 == 0) ((float*)(ws + W_MPREV))[dbh * 64 + cc] = m;
        c0 = so * c0 + sn * lo16(v[u].x); c1 = so * c1 + sn * hi16(v[u].x);
        c2 = so * c2 + sn * lo16(v[u].y); c3 = so * c3 + sn * hi16(v[u].y);
        m = mn;
      }
    }
  } else {
    const int gt = (blk - 128) * NT + tidx(), dbh = gt >> 7, k = gt & 127;
    float* N = (float*)(ws + W_NST) + (size_t)dbh * 64 * 128 + k;
    float m = 0.f, n = 0.f;
    for (int cc = 0; cc < 64; cc++) {
      float g = G[dbh * 64 + cc], am = AM[dbh * 64 + cc];
      float mn = fmaxf(g + m, am);
      float so = expf(g + m - mn), sn = expf(am - mn);
      float v = N[cc * 128];
      N[cc * 128] = n;
      n = so * n + sn * v;
      m = mn;
    }
  }
}

__device__ __forceinline__ void mlstm_out(const Params& p, int l, int item, char* smem) {
  const int co = item & 63, h = (item >> 6) & 3, b = item >> 8;
  char* ws = p.ws;
  bf16_t* B0 = (bf16_t*)smem;
  bf16_t* B1 = B0 + 128 * LDT;
  bf16_t* B2 = B1 + 128 * LDT;
  float* FU = (float*)(B2 + 128 * LDT);
  float* FMM = FU + 256;
  float* FIW = FMM + 256;
  float* FEN = FIW + 256;
  float* FNP = FEN + 256;
  const int tid = tidx(), lane = tid & 63, w = tid >> 6;
  const int tok0 = b * SEQ + co * 128;
  const bf16_t* Z = (const bf16_t*)(ws + W_Z);
  const float* ZG = (const float*)(ws + W_ZG);
  if (w < 2) {
    const int d = w, dbh = d * 8 + b * 4 + h, cp = d ? 63 - co : co;
    const float mprev = ((const float*)(ws + W_MPREV))[dbh * 64 + cp];
    const int l0 = 2 * lane, l1 = l0 + 1;
    const int i0 = d ? 127 - l0 : l0, i1 = d ? 127 - l1 : l1;
    float ig0 = ZG[(size_t)(tok0 + i0) * 16 + d * 4 + h], ig1 = ZG[(size_t)(tok0 + i1) * 16 + d * 4 + h];
    float f0 = logsig(ZG[(size_t)(tok0 + i0) * 16 + 8 + d * 4 + h]), f1 = logsig(ZG[(size_t)(tok0 + i1) * 16 + 8 + d * 4 + h]);
    float s1 = f0 + f1;
    float incl = wave_incl_sum(s1, lane);
    float b0 = incl - s1 + f0, b1 = incl;
    float u0 = ig0 - b0, u1 = ig1 - b1;
    float pm1 = fmaxf(u0, u1);
    float inclm = wave_incl_max(pm1, lane);
    float exclm = __shfl_up(inclm, 1);
    if (lane == 0) exclm = -INFINITY;
    float r0 = fmaxf(exclm, u0), r1 = fmaxf(exclm, pm1);
    float mm0 = fmaxf(mprev, r0), mm1 = fmaxf(mprev, r1);
    FU[d * 128 + i0] = u0; FU[d * 128 + i1] = u1;
    FMM[d * 128 + i0] = mm0; FMM[d * 128 + i1] = mm1;
    FIW[d * 128 + i0] = expf(mprev - mm0); FIW[d * 128 + i1] = expf(mprev - mm1);
    FEN[d * 128 + i0] = expf(-(b0 + mm0)); FEN[d * 128 + i1] = expf(-(b1 + mm1));
  }
  if (tid < 256) {
    const int d = tid >> 7, k = tid & 127;
    const int dbh = d * 8 + b * 4 + h, cp = d ? 63 - co : co;
    FNP[tid] = ((const float*)(ws + W_NST))[(size_t)(dbh * 64 + cp) * 128 + k];
  }
  const float* cw = p.in[I_CW] + l * 5 * 1024;
  const float* cb = p.in[I_CB] + l * 1024;
  const float qscale = 0.08838834764831845f;
  const int mb = w * 16;
  const int irow = mb + (lane & 15);
  f32x4 hf[8];
#pragma unroll 1
  for (int d = 0; d < 2; d++) {
    const int dbh = d * 8 + b * 4 + h, cp = d ? 63 - co : co;
    __syncthreads();
#pragma unroll 1
    for (int t = 0; t < 4; t++) {
      int c = tid + t * NT, i = c >> 4, d8 = (c & 15) * 8;
      float o[8];
      conv8(Z, cw, cb, b, co * 128 + i, h * 128 + d8, h * 128 + d8, o);
      uint4 q;
      q.x = pack2(o[0] * qscale, o[1] * qscale); q.y = pack2(o[2] * qscale, o[3] * qscale);
      q.z = pack2(o[4] * qscale, o[5] * qscale); q.w = pack2(o[6] * qscale, o[7] * qscale);
      *(uint4*)&B0[i * LDT + d8] = q;
      conv8(Z, cw, cb, b, co * 128 + i, OFF_K + h * 128 + d8, 512 + h * 128 + d8, o);
      q.x = pack2(o[0], o[1]); q.y = pack2(o[2], o[3]); q.z = pack2(o[4], o[5]); q.w = pack2(o[6], o[7]);
      *(uint4*)&B1[i * LDT + d8] = q;
    }
    __syncthreads();
    f32x4 acc[1][8];
    zero_acc(acc);
    mma_lds<1, 8, true>(B0, B1, 128, mb, 0, acc);
    const float mmi = FMM[d * 128 + irow];
    float rowsum = 0.f;
#pragma unroll
    for (int jt = 0; jt < 8; jt++) {
      const int j0 = jt * 16 + (lane >> 4) * 4;
      float pv[4];
#pragma unroll
      for (int r = 0; r < 4; r++) {
        const int j = j0 + r;
        const bool ok = d ? (j >= irow) : (j <= irow);
        float e = ok ? acc[0][jt][r] * expf(FU[d * 128 + j] - mmi) : 0.f;
        pv[r] = e; rowsum += e;
      }
      *(uint2*)&B2[irow * LDT + j0] = pack4(pv[0], pv[1], pv[2], pv[3]);
    }
    rowsum += __shfl_xor(rowsum, 16); rowsum += __shfl_xor(rowsum, 32);
    float qn = 0.f;
    {
      const int kq0 = (lane >> 4) * 32;
#pragma unroll 8
      for (int k = 0; k < 32; k++) qn += bf2f(B0[irow * LDT + kq0 + k]) * FNP[d * 128 + kq0 + k];
    }
    qn += __shfl_xor(qn, 16); qn += __shfl_xor(qn, 32);
    const float iw = FIW[d * 128 + irow];
    const float den = rowsum + iw * qn;
    __syncthreads();
    {
      const bf16_t* C = (const bf16_t*)(ws + W_CST) + (size_t)(dbh * 64 + cp) * 16384;
#pragma unroll
      for (int t = 0; t < 4; t++) {
        int c = tid + t * NT, e = c >> 4, k8 = (c & 15) * 8;
        *(uint4*)&B1[e * LDT + k8] = *(const uint4*)(C + e * 128 + k8);
      }
    }
    __syncthreads();
    zero_acc(acc);
    mma_lds<1, 8, true>(B0, B1, 128, mb, 0, acc);
#pragma unroll
    for (int jt = 0; jt < 8; jt++) { acc[0][jt][0] *= iw; acc[0][jt][1] *= iw; acc[0][jt][2] *= iw; acc[0][jt][3] *= iw; }
    __syncthreads();
#pragma unroll 1
    for (int t = 0; t < 4; t++) {
      int c = tid + t * NT, j = c >> 4, e8 = (c & 15) * 8;
      uint4 v = *(const uint4*)(Z + (size_t)(tok0 + j) * ZS + OFF_V + h * 128 + e8);
      B0[(e8 + 0) * LDT + j] = (bf16_t)(v.x & 0xffff); B0[(e8 + 1) * LDT + j] = (bf16_t)(v.x >> 16);
      B0[(e8 + 2) * LDT + j] = (bf16_t)(v.y & 0xffff); B0[(e8 + 3) * LDT + j] = (bf16_t)(v.y >> 16);
      B0[(e8 + 4) * LDT + j] = (bf16_t)(v.z & 0xffff); B0[(e8 + 5) * LDT + j] = (bf16_t)(v.z >> 16);
      B0[(e8 + 6) * LDT + j] = (bf16_t)(v.w & 0xffff); B0[(e8 + 7) * LDT + j] = (bf16_t)(v.w >> 16);
    }
    __syncthreads();
    mma_lds<1, 8, true>(B2, B0, 128, mb, 0, acc);
    const float dn = 1.f / fmaxf(fabsf(den), FEN[d * 128 + irow]);
    if (d == 0) {
#pragma unroll
      for (int jt = 0; jt < 8; jt++) hf[jt] = acc[0][jt] * dn;
    } else {
#pragma unroll
      for (int jt = 0; jt < 8; jt++) hf[jt] += acc[0][jt] * dn;
    }
  }
  float s = 0.f;
#pragma unroll
  for (int jt = 0; jt < 8; jt++) s += hf[jt][0] + hf[jt][1] + hf[jt][2] + hf[jt][3];
  s += __shfl_xor(s, 16); s += __shfl_xor(s, 32);
  const float mu = s * (1.f / 128.f);
  float v = 0.f;
#pragma unroll
  for (int jt = 0; jt < 8; jt++)
#pragma unroll
    for (int r = 0; r < 4; r++) { float dd = hf[jt][r] - mu; v += dd * dd; }
  v += __shfl_xor(v, 16); v += __shfl_xor(v, 32);
  const float rs = rsqrtf(v * (1.f / 128.f) + EPS);
  const float* ng = p.in[I_MNG] + l * 512 + h * 128;
  bf16_t* HM = (bf16_t*)(ws + W_HM);
  const size_t tok = (size_t)tok0 + irow;
#pragma unroll
  for (int jt = 0; jt < 8; jt++) {
    const int e = jt * 16 + (lane >> 4) * 4;
    float4 gv = *(const float4*)(ng + e);
    uint2 zo = *(const uint2*)(Z + tok * ZS + OFF_O + h * 128 + e);
    float o0 = (hf[jt][0] - mu) * rs * gv.x * sigm(lo16(zo.x));
    float o1 = (hf[jt][1] - mu) * rs * gv.y * sigm(hi16(zo.x));
    float o2 = (hf[jt][2] - mu) * rs * gv.z * sigm(lo16(zo.y));
    float o3 = (hf[jt][3] - mu) * rs * gv.w * sigm(hi16(zo.y));
    *(uint2*)(HM + tok * 512 + h * 128 + e) = pack4(o0, o1, o2, o3);
  }
  __syncthreads();
}

#ifndef ONLY_PH
#define ONLY_PH -1
#endif
#define PHEN(x) (ONLY_PH < 0 || ONLY_PH == (x))
constexpr int NPL = 10;
constexpr int NPH = 2 * NPL + 1;

__device__ __forceinline__ void run_phase(const Params& p, int ph, char* smem) {
  const int l = ph / NPL, q = ph % NPL;
  const int bid = blockIdx.x, nb = gridDim.x;
  char* ws = p.ws;
  if (PHEN(10) && ph == NPH - 1) {
    for (int it = bid; it < 2048; it += nb) rms_item(p, 2, 1, it);
    return;
  }
  switch (q) {
    case 0: if (!PHEN(0)) break; {
      const int n_tab = (l == 0) ? 32 : 0;
      const int total = 16 + n_tab + N_TR + 2048;
      for (int it = bid; it < total; it += nb) {
        int i = it;
        if (i < 16) { s5_gen(p, l, i, smem); continue; }
        i -= 16;
        if (i < n_tab) { gen_tables(p, i); continue; }
        i -= n_tab;
        if (i < N_TR) { transpose_item(p, l, i, smem); continue; }
        i -= N_TR;
        if (l == 0) rms_item(p, 0, 0, i); else rms_item(p, 2, l - 1, i);
      }
    } break;
    case 1: if (!PHEN(1)) break;
      for (int it = bid; it < 64 * 21; it += nb) inproj_item(p, l, it, smem);
      break;
    case 2: if (!PHEN(2)) break;
      for (int it = bid; it < 512 + 128 + 512; it += nb) {
        if (it < 512) mlstm_local(p, l, it, smem);
        else if (it < 640) s5_e(p, it - 512, smem);
        else four_g1(p, it - 640, smem);
      }
      break;
    case 3: if (!PHEN(3)) break;
      for (int it = bid; it < 8 + 132 + 512; it += nb) {
        if (it < 8) s5_carry(p, it);
        else if (it < 140) mlstm_scan(p, it - 8);
        else four_g2(p, it - 140, smem);
      }
      break;
    case 4: if (!PHEN(4)) break;
      for (int it = bid; it < 512 + 256 + 512; it += nb) {
        if (it < 512) mlstm_out(p, l, it, smem);
        else if (it < 768) s5_tg(p, it - 512, smem);
        else four_g3(p, it - 768, smem);
      }
      break;
    case 5: if (!PHEN(5)) break;
      for (int it = bid; it < 1024; it += nb) merge_item(p, l, it, smem);
      break;
    case 6: if (!PHEN(6)) break;
      for (int it = bid; it < 64 * 8; it += nb)
        plain_gemm_item<0>((const bf16_t*)(ws + W_MIX), (const bf16_t*)(ws + W_WOUT), (bf16_t*)(ws + W_O), 1024, 1024, it, smem);
      break;
    case 7: if (!PHEN(7)) break;
      for (int it = bid; it < 2048; it += nb) rms_item(p, 1, l, it);
      break;
    case 8: if (!PHEN(8)) break;
      for (int it = bid; it < 64 * 32; it += nb)
        plain_gemm_item<1>((const bf16_t*)(ws + W_HBF), (const bf16_t*)(ws + W_W1), (bf16_t*)(ws + W_HID), 4096, 1024, it, smem);
      break;
    case 9: if (!PHEN(9)) break;
      for (int it = bid; it < 64 * 8; it += nb)
        plain_gemm_item<0>((const bf16_t*)(ws + W_HID), (const bf16_t*)(ws + W_W2), (bf16_t*)(ws + W_FO), 1024, 4096, it, smem);
      break;
  }
}

__global__ void __launch_bounds__(NT) k_main(Params p, int ph_lo, int ph_hi) {
  extern __shared__ __attribute__((aligned(16))) char smem[];
#if COOP
  cg::grid_group grid = cg::this_grid();
#endif
  for (int ph = ph_lo; ph < ph_hi; ph++) {
    run_phase(p, ph, smem);
#if COOP
    if (ph + 1 < ph_hi) grid.sync();
#endif
  }
}

extern "C" void kernel_launch(void* const* d_in, const int* in_sizes, int n_in, void* d_out, int out_size, void* d_ws, size_t ws_size,
                              hipStream_t stream) {
  static int grid = 0;
  if (grid == 0) {
    if (n_in != 25 || ws_size < W_END) { fprintf(stderr, "kernel_launch: bad inputs n_in=%d ws=%zu need %zu\n", n_in, ws_size, (size_t)W_END); grid = -1; return; }
    if (hipFuncSetAttribute((const void*)k_main, hipFuncAttributeMaxDynamicSharedMemorySize, SMEM_BYTES) != hipSuccess) { fprintf(stderr, "hipFuncSetAttribute failed\n"); grid = -1; return; }
    int dev = 0, cus = 0, per_cu = 0;
    hipGetDevice(&dev);
    hipDeviceGetAttribute(&cus, hipDeviceAttributeMultiprocessorCount, dev);
    hipOccupancyMaxActiveBlocksPerMultiprocessor(&per_cu, (const void*)k_main, NT, SMEM_BYTES);
    if (per_cu < 1) { fprintf(stderr, "occupancy query says 0 blocks/CU\n"); grid = -1; return; }
    grid = cus;
  }
  if (grid < 0) return;
  Params p{};
  for (int i = 0; i < 25; i++) p.in[i] = (const float*)d_in[i];
  p.out = (float*)d_out;
  p.ws = (char*)d_ws;
#if COOP
  int lo = 0, hi = NPH;
  void* args[] = {&p, &lo, &hi};
  hipError_t e = hipLaunchCooperativeKernel((const void*)k_main, dim3(grid), dim3(NT), args, SMEM_BYTES, stream);
  if (e != hipSuccess) fprintf(stderr, "cooperative launch failed: %s\n", hipGetErrorString(e));
#else
  for (int ph = 0; ph < NPH; ph++) hipLaunchKernelGGL(k_main, dim3(grid), dim3(NT), SMEM_BYTES, stream, p, ph, ph + 1);
#endif
}
```

```cpp
#include <hip/hip_runtime.h>
#include <hip/hip_cooperative_groups.h>
#include <stdint.h>
#include <stdio.h>
#include <math.h>
namespace cg = cooperative_groups;

#ifndef REP_MASK
#define REP_MASK 0
#endif
#ifndef PROBE_PH
#define PROBE_PH -1
#endif
#ifndef PROBE_N
#define PROBE_N 1
#endif
#ifndef PROBE_SCALE
#define PROBE_SCALE 1000.f
#endif
#ifndef COOP
#define COOP 1
#endif

typedef unsigned short bf16_t;
typedef __attribute__((ext_vector_type(8))) short bf16x8;
typedef __attribute__((ext_vector_type(4))) float f32x4;

#define NT 512
constexpr int SEQ = 8192, TOK = 16384, DM = 1024, NIN = 5648, ZS = 2560, DFF = 4096;
constexpr int OFF_K = 512, OFF_V = 1024, OFF_O = 1536, OFF_IG = 2048  , OFF_F = 2048, OFF_S = 2304  , OFF_GATE = 2576  ;
constexpr float EPS = 1e-6f;

enum { I_X = 0, I_GMPRE, I_GMPOST, I_GFPRE, I_GFPOST, I_WIN, I_BIN, I_CW, I_CB, I_MNG, I_WUPM, I_WUPF, I_LRE, I_LIM, I_LDT,
       I_BRE, I_BIM, I_CRE, I_CIM, I_SD, I_WGLU, I_BGLU, I_WOUT, I_W1, I_W2 };

constexpr size_t W_WIN = 0;
constexpr size_t W_WUPM = W_WIN + (size_t)NIN * 1024 * 2;
constexpr size_t W_WUPF = W_WUPM + 1024 * 512 * 2;
constexpr size_t W_WGLU = W_WUPF + 1024 * 256 * 2;
constexpr size_t W_WOUT = W_WGLU + 2048 * 256 * 2;
constexpr size_t W_W1 = W_WOUT + 1024 * 1024 * 2;
constexpr size_t W_W2 = W_W1 + 4096 * 1024 * 2;
constexpr size_t W_ET = W_W2 + 4096 * 1024 * 2;
constexpr size_t W_TG = W_ET + 16 * 256 * 512 * 2;
constexpr size_t W_F1T = W_TG + 16 * 512 * 768 * 2;
constexpr size_t W_F2T = W_F1T + 128 * 64 * 2;
constexpr size_t W_F3T = W_F2T + 256 * 256 * 2;
constexpr size_t W_TW = W_F3T + 64 * 128 * 2;
constexpr size_t W_LPOW = W_TW + 64 * 128 * 2 * 4;
constexpr size_t W_ZERO = W_LPOW + 2 * 16 * 64 * 2 * 4;
constexpr size_t W_AMAX = W_ZERO + 256;
constexpr size_t W_G = W_AMAX + 4096;
constexpr size_t W_MPREV = W_G + 4096;
constexpr size_t W_NST = W_MPREV + 4096;
constexpr size_t W_ZG = W_NST + 16 * 64 * 128 * 4;
constexpr size_t W_HBF = W_ZG + (size_t)TOK * 16 * 4;
constexpr size_t W_Z = W_HBF + (size_t)TOK * 1024 * 2;
constexpr size_t W_CST = W_Z + (size_t)TOK * ZS * 2;
constexpr size_t W_U1T = W_CST + (size_t)16 * 64 * 16384 * 2;
constexpr size_t W_A2T = W_U1T + (size_t)TOK * 512 * 2;
constexpr size_t W_YF = W_A2T + (size_t)TOK * 512 * 2;
constexpr size_t W_YS = W_YF + (size_t)TOK * 256 * 2;
constexpr size_t W_XEND = W_YS + (size_t)TOK * 256 * 2;
constexpr size_t W_XCAR = W_XEND + (size_t)512 * 16 * 256 * 2;
constexpr size_t W_BAR = W_XCAR + (size_t)512 * 16 * 256 * 2;
constexpr size_t W_KTG = W_BAR + 16384;
constexpr size_t W_END = W_KTG + (size_t)2 * 16 * 16384 * 4;
constexpr size_t W_HM = W_U1T;
constexpr size_t W_MIX = W_HBF;
constexpr size_t W_GATE = W_Z;
constexpr size_t W_O = W_Z + (size_t)TOK * 1024 * 2;
constexpr size_t W_HID = W_Z;
constexpr size_t W_FO = W_A2T;
static_assert(W_U1T + (size_t)TOK * 512 * 2 - W_Z >= (size_t)TOK * 4096 * 2, "hid alias");
static_assert(W_U1T - W_Z >= (size_t)TOK * 3072 * 2, "gate alias");

constexpr int SMEM_BYTES = 153600 + 16;

struct Params { const float* in[25]; float* out; char* ws; };

__device__ __forceinline__ int tidx() { int t = threadIdx.x; asm volatile("" : "+v"(t)); return t; }
__device__ __forceinline__ bf16_t f2bf(float f) {
  uint32_t u = __float_as_uint(f);
  u += 0x7fffu + ((u >> 16) & 1u);
  return (bf16_t)(u >> 16);
}
__device__ __forceinline__ float bf2f(bf16_t h) { return __uint_as_float(((uint32_t)h) << 16); }
__device__ __forceinline__ uint32_t pack2(float a, float b) { return (uint32_t)f2bf(a) | ((uint32_t)f2bf(b) << 16); }
__device__ __forceinline__ uint2 pack4(float a, float b, float c, float d) { uint2 r; r.x = pack2(a, b); r.y = pack2(c, d); return r; }
__device__ __forceinline__ float lo16(uint32_t u) { return __uint_as_float(u << 16); }
__device__ __forceinline__ float hi16(uint32_t u) { return __uint_as_float(u & 0xffff0000u); }
__device__ __forceinline__ float sigm(float x) { return __frcp_rn(1.f + __expf(-x)); }
__device__ __forceinline__ float logsig(float x) { return fminf(x, 0.f) - log1pf(expf(-fabsf(x))); }
__device__ __forceinline__ float gelu_tanh(float x) { float u = 0.7978845608028654f * (x + 0.044715f * x * x * x); return 0.5f * x * (1.f + tanhf(u)); }
__device__ __forceinline__ float wave_sum(float v) {
#pragma unroll
  for (int o = 32; o >= 1; o >>= 1) v += __shfl_xor(v, o);
  return v;
}
__device__ __forceinline__ float wave_max(float v) {
#pragma unroll
  for (int o = 32; o >= 1; o >>= 1) v = fmaxf(v, __shfl_xor(v, o));
  return v;
}
__device__ __forceinline__ float wave_incl_sum(float v, int lane) {
#pragma unroll
  for (int o = 1; o < 64; o <<= 1) { float t = __shfl_up(v, o); if (lane >= o) v += t; }
  return v;
}
__device__ __forceinline__ float wave_incl_max(float v, int lane) {
#pragma unroll
  for (int o = 1; o < 64; o <<= 1) { float t = __shfl_up(v, o); if (lane >= o) v = fmaxf(v, t); }
  return v;
}
__device__ __forceinline__ f32x4 mfma16(bf16x8 a, bf16x8 b, f32x4 c) { return __builtin_amdgcn_mfma_f32_16x16x32_bf16(a, b, c, 0, 0, 0); }

constexpr int BK = 64, LDK = 64;
template <int BM, int BN, int WM, int WN, bool SWAP, class AF, class BF>
__device__ __forceinline__ void gemm_acc(int K, AF aptr, BF bptr, char* smem, f32x4 (&acc)[BM / WM / 16][BN / WN / 16]) {
  constexpr int TM = BM / WM / 16, TN = BN / WN / 16;
  constexpr int CA = BM * 8 / NT, CB = BN * 8 / NT;
  static_assert(CA >= 1 && CB >= 1, "tile too small");
  bf16_t* As = (bf16_t*)smem;
  bf16_t* Bs = As + 2 * BM * LDK;
  const int tid = tidx(), lane = tid & 63, w = tid >> 6;
  const int mb = (w / WN) * (BM / WM), nb = (w % WN) * (BN / WN);
  const int r16 = lane & 15, fx = (r16 >> 1) & 7;
  uint4 ra0, ra1, ra2, ra3, rb0, rb1, rb2, rb3;
  ra0 = ra1 = ra2 = ra3 = rb0 = rb1 = rb2 = rb3 = make_uint4(0, 0, 0, 0);
  static_assert(CA <= 4 && CB <= 4, "chunks");
#define GLOAD(K0)                                                                                         \
  {                                                                                                       \
    { int c = tid; ra0 = *(const uint4*)aptr(c >> 3, (K0) + (c & 7) * 8); }                               \
    if (CA > 1) { int c = tid + NT; ra1 = *(const uint4*)aptr(c >> 3, (K0) + (c & 7) * 8); }              \
    if (CA > 2) { int c = tid + 2 * NT; ra2 = *(const uint4*)aptr(c >> 3, (K0) + (c & 7) * 8); }          \
    if (CA > 3) { int c = tid + 3 * NT; ra3 = *(const uint4*)aptr(c >> 3, (K0) + (c & 7) * 8); }          \
    { int c = tid; rb0 = *(const uint4*)bptr(c >> 3, (K0) + (c & 7) * 8); }                               \
    if (CB > 1) { int c = tid + NT; rb1 = *(const uint4*)bptr(c >> 3, (K0) + (c & 7) * 8); }              \
    if (CB > 2) { int c = tid + 2 * NT; rb2 = *(const uint4*)bptr(c >> 3, (K0) + (c & 7) * 8); }          \
    if (CB > 3) { int c = tid + 3 * NT; rb3 = *(const uint4*)bptr(c >> 3, (K0) + (c & 7) * 8); }          \
  }
#define SSTORE(AP, BP)                                                                                    \
  {                                                                                                       \
    { int c = tid; *(uint4*)&(AP)[(c >> 3) * LDK + (((c & 7) ^ ((c >> 4) & 7)) << 3)] = ra0; }                                  \
    if (CA > 1) { int c = tid + NT; *(uint4*)&(AP)[(c >> 3) * LDK + (((c & 7) ^ ((c >> 4) & 7)) << 3)] = ra1; }                 \
    if (CA > 2) { int c = tid + 2 * NT; *(uint4*)&(AP)[(c >> 3) * LDK + (((c & 7) ^ ((c >> 4) & 7)) << 3)] = ra2; }             \
    if (CA > 3) { int c = tid + 3 * NT; *(uint4*)&(AP)[(c >> 3) * LDK + (((c & 7) ^ ((c >> 4) & 7)) << 3)] = ra3; }             \
    { int c = tid; *(uint4*)&(BP)[(c >> 3) * LDK + (((c & 7) ^ ((c >> 4) & 7)) << 3)] = rb0; }                                  \
    if (CB > 1) { int c = tid + NT; *(uint4*)&(BP)[(c >> 3) * LDK + (((c & 7) ^ ((c >> 4) & 7)) << 3)] = rb1; }                 \
    if (CB > 2) { int c = tid + 2 * NT; *(uint4*)&(BP)[(c >> 3) * LDK + (((c & 7) ^ ((c >> 4) & 7)) << 3)] = rb2; }             \
    if (CB > 3) { int c = tid + 3 * NT; *(uint4*)&(BP)[(c >> 3) * LDK + (((c & 7) ^ ((c >> 4) & 7)) << 3)] = rb3; }             \
  }
  GLOAD(0);
  SSTORE(As, Bs);
  const int nk = K / BK;
  if (nk > 1) { GLOAD(BK); }
  __syncthreads();
#pragma unroll 1
  for (int kt = 0; kt < nk; kt++) {
    const int buf = kt & 1;
    if (kt + 1 < nk) {
      bf16_t* An = As + (buf ^ 1) * BM * LDK;
      bf16_t* Bn = Bs + (buf ^ 1) * BN * LDK;
      SSTORE(An, Bn);
      if (kt + 2 < nk) { GLOAD((kt + 2) * BK); }
    }
    const bf16_t* Ab = As + buf * BM * LDK;
    const bf16_t* Bb = Bs + buf * BN * LDK;
#pragma unroll
    for (int kk = 0; kk < 2; kk++) {
      bf16x8 af[TM], bfr[TN];
#pragma unroll
      for (int i = 0; i < TM; i++) af[i] = *(const bf16x8*)&Ab[(mb + i * 16 + r16) * LDK + (((kk * 4 + (lane >> 4)) ^ fx) << 3)];
#pragma unroll
      for (int j = 0; j < TN; j++) bfr[j] = *(const bf16x8*)&Bb[(nb + j * 16 + r16) * LDK + (((kk * 4 + (lane >> 4)) ^ fx) << 3)];
      __builtin_amdgcn_s_setprio(1);
#pragma unroll
      for (int i = 0; i < TM; i++)
#pragma unroll
        for (int j = 0; j < TN; j++) acc[i][j] = SWAP ? mfma16(bfr[j], af[i], acc[i][j]) : mfma16(af[i], bfr[j], acc[i][j]);
      __builtin_amdgcn_s_setprio(0);
    }
    __syncthreads();
  }
#undef GLOAD
#undef SSTORE
}

struct Stage { uint4 a0, a1, a2, a3, b0, b1, b2, b3; };
template <int BM, int BN, int WM, int WN, bool SWAP, class AF, class BF, class NAF, class NBF>
__device__ __forceinline__ void gemm_chain(int K, AF aptr, BF bptr, bool preloaded, bool has_next, NAF naptr, NBF nbptr, Stage& st, char* smem,
                                           f32x4 (&acc)[BM / WM / 16][BN / WN / 16]) {
  constexpr int TM = BM / WM / 16, TN = BN / WN / 16;
  constexpr int CA = BM * 8 / NT, CB = BN * 8 / NT;
  static_assert(CA >= 1 && CB >= 1 && CA <= 4 && CB <= 4, "chunks");
  bf16_t* As = (bf16_t*)smem;
  bf16_t* Bs = As + 2 * BM * LDK;
  const int tid = tidx(), lane = tid & 63, w = tid >> 6;
  const int mb = (w / WN) * (BM / WM), nb = (w % WN) * (BN / WN);
  const int r16 = lane & 15, fx = (r16 >> 1) & 7;
#define GLOADF(AP_, BP_, K0)                                                                              \
  {                                                                                                       \
    { int c = tid; st.a0 = *(const uint4*)AP_(c >> 3, (K0) + (c & 7) * 8); }                              \
    if (CA > 1) { int c = tid + NT; st.a1 = *(const uint4*)AP_(c >> 3, (K0) + (c & 7) * 8); }             \
    if (CA > 2) { int c = tid + 2 * NT; st.a2 = *(const uint4*)AP_(c >> 3, (K0) + (c & 7) * 8); }         \
    if (CA > 3) { int c = tid + 3 * NT; st.a3 = *(const uint4*)AP_(c >> 3, (K0) + (c & 7) * 8); }         \
    { int c = tid; st.b0 = *(const uint4*)BP_(c >> 3, (K0) + (c & 7) * 8); }                              \
    if (CB > 1) { int c = tid + NT; st.b1 = *(const uint4*)BP_(c >> 3, (K0) + (c & 7) * 8); }             \
    if (CB > 2) { int c = tid + 2 * NT; st.b2 = *(const uint4*)BP_(c >> 3, (K0) + (c & 7) * 8); }         \
    if (CB > 3) { int c = tid + 3 * NT; st.b3 = *(const uint4*)BP_(c >> 3, (K0) + (c & 7) * 8); }         \
  }
#define SOFFC(c) (((c) >> 3) * LDK + ((((c) & 7) ^ (((c) >> 4) & 7)) << 3))
#define SSTOREC(AP, BP)                                                                                   \
  {                                                                                                       \
    *(uint4*)&(AP)[SOFFC(tid)] = st.a0;                                                                   \
    if (CA > 1) *(uint4*)&(AP)[SOFFC(tid + NT)] = st.a1;                                                  \
    if (CA > 2) *(uint4*)&(AP)[SOFFC(tid + 2 * NT)] = st.a2;                                              \
    if (CA > 3) *(uint4*)&(AP)[SOFFC(tid + 3 * NT)] = st.a3;                                              \
    *(uint4*)&(BP)[SOFFC(tid)] = st.b0;                                                                   \
    if (CB > 1) *(uint4*)&(BP)[SOFFC(tid + NT)] = st.b1;                                                  \
    if (CB > 2) *(uint4*)&(BP)[SOFFC(tid + 2 * NT)] = st.b2;                                              \
    if (CB > 3) *(uint4*)&(BP)[SOFFC(tid + 3 * NT)] = st.b3;                                              \
  }
  const int nk = K / BK;
  if (!preloaded) { GLOADF(aptr, bptr, 0); }
  SSTOREC(As, Bs);
  GLOADF(aptr, bptr, BK);
  __syncthreads();
#pragma unroll 1
  for (int kt = 0; kt < nk; kt++) {
    const int buf = kt & 1;
    if (kt + 1 < nk) {
      bf16_t* An = As + (buf ^ 1) * BM * LDK;
      bf16_t* Bn = Bs + (buf ^ 1) * BN * LDK;
      SSTOREC(An, Bn);
      if (kt + 2 < nk) { GLOADF(aptr, bptr, (kt + 2) * BK); }
      else if (has_next) { GLOADF(naptr, nbptr, 0); }
    }
    const bf16_t* Ab = As + buf * BM * LDK;
    const bf16_t* Bb = Bs + buf * BN * LDK;
#pragma unroll
    for (int kk = 0; kk < 2; kk++) {
      bf16x8 af[TM], bfr[TN];
#pragma unroll
      for (int i = 0; i < TM; i++) af[i] = *(const bf16x8*)&Ab[(mb + i * 16 + r16) * LDK + (((kk * 4 + (lane >> 4)) ^ fx) << 3)];
#pragma unroll
      for (int j = 0; j < TN; j++) bfr[j] = *(const bf16x8*)&Bb[(nb + j * 16 + r16) * LDK + (((kk * 4 + (lane >> 4)) ^ fx) << 3)];
      __builtin_amdgcn_s_setprio(1);
#pragma unroll
      for (int i = 0; i < TM; i++)
#pragma unroll
        for (int j = 0; j < TN; j++) acc[i][j] = SWAP ? mfma16(bfr[j], af[i], acc[i][j]) : mfma16(af[i], bfr[j], acc[i][j]);
      __builtin_amdgcn_s_setprio(0);
    }
    __syncthreads();
  }
#undef GLOADF
#undef SOFFC
#undef SSTOREC
}

__device__ __forceinline__ int perm32(int r) { return (r & ~31) + 8 * ((r & 15) >> 2) + 4 * ((r >> 4) & 1) + (r & 3); }

template <int TM, int TN>
__device__ __forceinline__ void zero_acc(f32x4 (&acc)[TM][TN]) {
#pragma unroll
  for (int i = 0; i < TM; i++)
#pragma unroll
    for (int j = 0; j < TN; j++) acc[i][j] = f32x4{0.f, 0.f, 0.f, 0.f};
}

constexpr int LDT = 144;
template <int TM, int TN, bool SWAP>
__device__ __forceinline__ void mma_lds(const bf16_t* A, const bf16_t* B, int K, int mb, int nb, f32x4 (&acc)[TM][TN]) {
  const int lane = tidx() & 63, r16 = lane & 15, kq = (lane >> 4) * 8;
  for (int k0 = 0; k0 < K; k0 += 32) {
    bf16x8 af[TM], bfr[TN];
#pragma unroll
    for (int i = 0; i < TM; i++) af[i] = *(const bf16x8*)&A[(mb + i * 16 + r16) * LDT + k0 + kq];
#pragma unroll
    for (int j = 0; j < TN; j++) bfr[j] = *(const bf16x8*)&B[(nb + j * 16 + r16) * LDT + k0 + kq];
    __builtin_amdgcn_s_setprio(1);
#pragma unroll
    for (int i = 0; i < TM; i++)
#pragma unroll
      for (int j = 0; j < TN; j++) acc[i][j] = SWAP ? mfma16(bfr[j], af[i], acc[i][j]) : mfma16(af[i], bfr[j], acc[i][j]);
    __builtin_amdgcn_s_setprio(0);
  }
}

__device__ __forceinline__ void transpose_tile(const float* __restrict__ src, bf16_t* __restrict__ dst, int K, int N, int tile, char* smem) {
  float* sm = (float*)smem;
  const int ntn = (N + 255) >> 8;
  const int k0 = (tile / ntn) * 64, n0 = (tile % ntn) * 256;
  const int tid = tidx();
  {
    float4 v[8];
#pragma unroll
    for (int t = 0; t < 8; t++) {
      int idx = tid + t * NT, r = idx >> 6, c = (idx & 63) * 4;
      v[t] = (n0 + c < N) ? *(const float4*)(src + (size_t)(k0 + r) * N + n0 + c) : make_float4(0.f, 0.f, 0.f, 0.f);
    }
#pragma unroll
    for (int t = 0; t < 8; t++) {
      int idx = tid + t * NT, r = idx >> 6, c = (idx & 63) * 4;
      sm[r * 257 + c] = v[t].x; sm[r * 257 + c + 1] = v[t].y; sm[r * 257 + c + 2] = v[t].z; sm[r * 257 + c + 3] = v[t].w;
    }
  }
  __syncthreads();
#pragma unroll 8
  for (int t = 0; t < 16; t++) {
    int idx = tid + t * NT, r = idx >> 5, c = (idx & 31) * 2;
    if (n0 + r < N) *(uint32_t*)(dst + (size_t)(n0 + r) * K + k0 + c) = pack2(sm[c * 257 + r], sm[(c + 1) * 257 + r]);
  }
  __syncthreads();
}

__device__ __forceinline__ void transpose_item(const Params& p, int l, int i, char* smem) {
  char* ws = p.ws;
  if (i < 368) { transpose_tile(p.in[I_WIN] + (size_t)l * 1024 * NIN, (bf16_t*)(ws + W_WIN), 1024, NIN, i, smem); return; }
  i -= 368;
  if (i < 32) { transpose_tile(p.in[I_WUPM] + (size_t)l * 512 * 1024, (bf16_t*)(ws + W_WUPM), 512, 1024, i, smem); return; }
  i -= 32;
  if (i < 16) { transpose_tile(p.in[I_WUPF] + (size_t)l * 256 * 1024, (bf16_t*)(ws + W_WUPF), 256, 1024, i, smem); return; }
  i -= 16;
  if (i < 32) { transpose_tile(p.in[I_WGLU] + (size_t)l * 256 * 2048, (bf16_t*)(ws + W_WGLU), 256, 2048, i, smem); return; }
  i -= 32;
  if (i < 64) { transpose_tile(p.in[I_WOUT] + (size_t)l * 1024 * 1024, (bf16_t*)(ws + W_WOUT), 1024, 1024, i, smem); return; }
  i -= 64;
  if (i < 256) { transpose_tile(p.in[I_W1] + (size_t)l * 1024 * 4096, (bf16_t*)(ws + W_W1), 1024, 4096, i, smem); return; }
  i -= 256;
  transpose_tile(p.in[I_W2] + (size_t)l * 4096 * 1024, (bf16_t*)(ws + W_W2), 4096, 1024, i, smem);
}
constexpr int N_TR = 368 + 32 + 16 + 32 + 64 + 256 + 256;

__device__ __forceinline__ void gen_tables(const Params& p, int item) {
  char* ws = p.ws;
  bf16_t* F1T = (bf16_t*)(ws + W_F1T);
  bf16_t* F2T = (bf16_t*)(ws + W_F2T);
  bf16_t* F3T = (bf16_t*)(ws + W_F3T);
  float* TW = (float*)(ws + W_TW);
  uint32_t* ZR = (uint32_t*)(ws + W_ZERO);
  constexpr int E1 = 8192, E2 = 65536, E3 = 8192, E4 = 8192, E5 = 64;
  for (int e = item * NT + tidx(); e < E1 + E2 + E3 + E4 + E5; e += 32 * NT) {
    int i = e;
    if (i < E1) {
      int n = i >> 6, d = i & 63, c = n >> 6, j = n & 63;
      float s, co; sincospif((float)((j * d) & 63) / 32.f, &s, &co);
      F1T[i] = f2bf(c == 0 ? co : -s);
      continue;
    }
    i -= E1;
    if (i < E2) {
      int n = i >> 8, k = i & 255;
      int k1 = (n >> 5) * 16 + (n & 15), cp = (n >> 4) & 1, c = k >> 7, s1 = k & 127;
      float s, co; sincospif((float)((s1 * k1) & 127) / 64.f, &s, &co);
      float v = (cp == 0) ? (c == 0 ? co : s) : (c == 0 ? -s : co);
      F2T[i] = f2bf(v);
      continue;
    }
    i -= E2;
    if (i < E3) {
      int k2 = i >> 7, k = i & 127, cp = k >> 6, s2 = k & 63;
      float s, co; sincospif((float)((s2 * k2) & 63) / 32.f, &s, &co);
      const float scale = 0.0013810679320049757f;
      F3T[i] = f2bf((cp == 0 ? co : s) * scale);
      continue;
    }
    i -= E3;
    if (i < E4) {
      int s2 = i >> 7, k1 = i & 127;
      float s, co; sincospif((float)(s2 * k1) / 4096.f, &s, &co);
      TW[2 * i] = co; TW[2 * i + 1] = s;
      continue;
    }
    i -= E4;
    ZR[i] = 0u;
  }
}

__device__ __forceinline__ void s5_setup(const Params& p, int l, int g, float* POW, float* BB, float* CC) {
  const int tid = tidx();
  for (int e = tid; e < 2 * 64 * 33; e += NT) {
    int d = e / (64 * 33), r = e - d * 64 * 33, tau = r >> 6, pp = r & 63;
    int gi = ((l * 2 + d) * 16 + g);
    float dt = expf(p.in[I_LDT][gi]);
    float lr = p.in[I_LRE][gi * 64 + pp], li = p.in[I_LIM][gi * 64 + pp];
    float m2 = expf(lr * dt * (float)tau);
    float s2, c2; sincosf(li * dt * (float)tau, &s2, &c2);
    POW[((d * 33 + tau) * 64 + pp) * 2] = m2 * c2;
    POW[((d * 33 + tau) * 64 + pp) * 2 + 1] = m2 * s2;
  }
  for (int e = tid; e < 2048; e += NT) {
    int d = e >> 10, pp = (e >> 4) & 63, ci = e & 15;
    int gi = ((l * 2 + d) * 16 + g);
    float dt = expf(p.in[I_LDT][gi]);
    float lr = p.in[I_LRE][gi * 64 + pp], li = p.in[I_LIM][gi * 64 + pp];
    float mag = expf(lr * dt);
    float sn, cs; sincosf(li * dt, &sn, &cs);
    float lbr = mag * cs, lbi = mag * sn;
    float den = lr * lr + li * li;
    float fr = ((lbr - 1.f) * lr + lbi * li) / den;
    float fi = (lbi * lr - (lbr - 1.f) * li) / den;
    float br = p.in[I_BRE][(gi * 64 + pp) * 16 + ci], bi = p.in[I_BIM][(gi * 64 + pp) * 16 + ci];
    BB[e * 2] = fr * br - fi * bi;
    BB[e * 2 + 1] = fr * bi + fi * br;
  }
  for (int e = tid; e < 2048; e += NT) {
    int d = e >> 10, r = e & 1023;
    int gi = ((l * 2 + d) * 16 + g);
    CC[e * 2] = p.in[I_CRE][gi * 1024 + r];
    CC[e * 2 + 1] = p.in[I_CIM][gi * 1024 + r];
  }
  __syncthreads();
}
__device__ __forceinline__ void s5_kt(const Params& p, int item, char* smem) {
  float* POW = (float*)smem;
  float* BB = POW + 2 * 33 * 64 * 2;
  float* CC = BB + 2 * 64 * 16 * 2;
  const int part = item & 7, g = (item >> 3) & 15, l = item >> 7;
  s5_setup(p, l, g, POW, BB, CC);
  float* KTG = (float*)(p.ws + W_KTG) + (size_t)(l * 16 + g) * 16384;
  const int tid = tidx();
  for (int e = part * 2048 + tid; e < part * 2048 + 2048; e += NT) {
    int d = e >> 13, tau = (e >> 8) & 31, co = (e >> 4) & 15, ci = e & 15;
    float s = 0.f;
    for (int pp = 0; pp < 64; pp++) {
      float cr = CC[((d * 16 + co) * 64 + pp) * 2], cim = CC[((d * 16 + co) * 64 + pp) * 2 + 1];
      float pr = POW[((d * 33 + tau) * 64 + pp) * 2], pi = POW[((d * 33 + tau) * 64 + pp) * 2 + 1];
      float xr = cr * pr - cim * pi, xi = cr * pi + cim * pr;
      float br = BB[((d * 64 + pp) * 16 + ci) * 2], bi = BB[((d * 64 + pp) * 16 + ci) * 2 + 1];
      s += xr * br - xi * bi;
    }
    KTG[e] = s;
  }
  __syncthreads();
}
__device__ __forceinline__ void s5_fill(const Params& p, int l, int item, char* smem) {
  float* POW = (float*)smem;
  float* BB = POW + 2 * 33 * 64 * 2;
  float* CC = BB + 2 * 64 * 16 * 2;
  float* KT = CC + 2 * 16 * 64 * 2;
  const int part = item & 7, g = item >> 3;
  const int tid = tidx();
  char* ws = p.ws;
  const float* KTG = (const float*)(ws + W_KTG) + (size_t)(l * 16 + g) * 16384;
  for (int e = tid; e < 4096; e += NT) ((float4*)KT)[e] = ((const float4*)KTG)[e];
  s5_setup(p, l, g, POW, BB, CC);
  if (part == 0 && tid < 128) {
    int d = tid >> 6, pp = tid & 63;
    float* LP = (float*)(ws + W_LPOW);
    LP[((d * 16 + g) * 64 + pp) * 2] = POW[((d * 33 + 32) * 64 + pp) * 2];
    LP[((d * 16 + g) * 64 + pp) * 2 + 1] = POW[((d * 33 + 32) * 64 + pp) * 2 + 1];
  }
  bf16_t* TG = (bf16_t*)(ws + W_TG) + (size_t)g * 512 * 768;
  const float* dsk = p.in[I_SD] + (l * 16 + g) * 16;
  for (int e = part * 64 * 768 + tid; e < (part + 1) * 64 * 768; e += NT) {
    int n = e / 768, k = e - n * 768;
    int t = n >> 4, co = n & 15;
    float v;
    if (k < 512) {
      int s = k >> 4, ci = k & 15;
      if (t > s) v = KT[((0 * 32 + (t - s)) * 16 + co) * 16 + ci];
      else if (t < s) v = KT[((1 * 32 + (s - t)) * 16 + co) * 16 + ci];
      else v = KT[(co)*16 + ci] + KT[((32) * 16 + co) * 16 + ci] + (co == ci ? dsk[co] : 0.f);
    } else {
      int kk = k - 512, d = kk >> 7, pp = (kk & 127) >> 1, c = kk & 1;
      int tau = d == 0 ? t + 1 : 32 - t;
      float cr = CC[((d * 16 + co) * 64 + pp) * 2], cim = CC[((d * 16 + co) * 64 + pp) * 2 + 1];
      float pr = POW[((d * 33 + tau) * 64 + pp) * 2], pi = POW[((d * 33 + tau) * 64 + pp) * 2 + 1];
      float xr = cr * pr - cim * pi, xi = cr * pi + cim * pr;
      v = c == 0 ? xr : -xi;
    }
    TG[e] = f2bf(v);
  }
  bf16_t* ET = (bf16_t*)(ws + W_ET) + (size_t)g * 256 * 512;
  for (int e = part * 32 * 512 + tid; e < (part + 1) * 32 * 512; e += NT) {
    int n = e >> 9, k = e & 511;
    int d = n >> 7, pp = (n & 127) >> 1, c = n & 1, s = k >> 4, ci = k & 15;
    int tau = d == 0 ? 31 - s : s;
    float pr = POW[((d * 33 + tau) * 64 + pp) * 2], pi = POW[((d * 33 + tau) * 64 + pp) * 2 + 1];
    float br = BB[((d * 64 + pp) * 16 + ci) * 2], bi = BB[((d * 64 + pp) * 16 + ci) * 2 + 1];
    float v = c == 0 ? (pr * br - pi * bi) : (pr * bi + pi * br);
    ET[e] = f2bf(v);
  }
  __syncthreads();
}

__device__ __forceinline__ void rms_item(const Params& p, int mode, int l, int item) {
  const int lane = tidx() & 63, w = tidx() >> 6;
  const int row = item * 8 + w;
  char* ws = p.ws;
  const float* xin = (mode == 2 || l > 0) ? p.out : p.in[I_X];
  float xv[16];
#pragma unroll
  for (int t = 0; t < 4; t++) {
    float4 v = *(const float4*)(xin + (size_t)row * 1024 + t * 256 + lane * 4);
    xv[t * 4] = v.x; xv[t * 4 + 1] = v.y; xv[t * 4 + 2] = v.z; xv[t * 4 + 3] = v.w;
  }
  if (mode >= 1) {
    const bf16_t* y = (const bf16_t*)(ws + (mode == 1 ? W_O : W_FO)) + (size_t)row * 1024;
    const float* gp = (mode == 1 ? p.in[I_GMPOST] : p.in[I_GFPOST]) + l * 1024;
    float yv[16];
    float ss = 0.f;
#pragma unroll
    for (int t = 0; t < 4; t++) {
      uint2 u = *(const uint2*)(y + t * 256 + lane * 4);
      yv[t * 4] = lo16(u.x); yv[t * 4 + 1] = hi16(u.x); yv[t * 4 + 2] = lo16(u.y); yv[t * 4 + 3] = hi16(u.y);
    }
#pragma unroll
    for (int e = 0; e < 16; e++) ss += yv[e] * yv[e];
    ss = wave_sum(ss);
    float r = rsqrtf(ss * (1.f / 1024.f) + EPS);
#pragma unroll
    for (int t = 0; t < 4; t++) {
      float4 gv = *(const float4*)(gp + t * 256 + lane * 4);
      xv[t * 4] += yv[t * 4] * r * gv.x; xv[t * 4 + 1] += yv[t * 4 + 1] * r * gv.y;
      xv[t * 4 + 2] += yv[t * 4 + 2] * r * gv.z; xv[t * 4 + 3] += yv[t * 4 + 3] * r * gv.w;
      *(float4*)(p.out + (size_t)row * 1024 + t * 256 + lane * 4) = make_float4(xv[t * 4], xv[t * 4 + 1], xv[t * 4 + 2], xv[t * 4 + 3]);
    }
  }
  const bool wh = (mode != 2) || (l + 1 < 2);
  if (wh) {
    const float* gh = (mode == 0 ? p.in[I_GMPRE] + l * 1024 : (mode == 1 ? p.in[I_GFPRE] + l * 1024 : p.in[I_GMPRE] + (l + 1) * 1024));
    float ss = 0.f;
#pragma unroll
    for (int e = 0; e < 16; e++) ss += xv[e] * xv[e];
    ss = wave_sum(ss);
    float r = rsqrtf(ss * (1.f / 1024.f) + EPS);
    bf16_t* h = (bf16_t*)(ws + W_HBF) + (size_t)row * 1024;
#pragma unroll
    for (int t = 0; t < 4; t++) {
      float4 gv = *(const float4*)(gh + t * 256 + lane * 4);
      *(uint2*)(h + t * 256 + lane * 4) = pack4(xv[t * 4] * r * gv.x, xv[t * 4 + 1] * r * gv.y, xv[t * 4 + 2] * r * gv.z, xv[t * 4 + 3] * r * gv.w);
    }
  }
}

template <int NTL, int PN>
__device__ __forceinline__ void tile_map(int it, int& mt, int& nt) {
  constexpr int PM = 32 / PN, NPN = NTL / PN;
  constexpr int total = 64 * NTL, full = (total / 256) * 256;
  int gp, within;
  if (it < full) { int xcd = it & 7, loc = it >> 3; gp = (loc >> 5) * 8 + xcd; within = loc & 31; }
  else { int rem = it - full; gp = full / 32 + (rem >> 5); within = rem & 31; }
  const int mp = gp / NPN, np = gp - mp * NPN;
  mt = mp * PM + within / PN;
  nt = np * PN + within % PN;
}

__device__ __forceinline__ void inproj_item(const Params& p, int l, int item, char* smem) {
  int mt, nt;
  tile_map<10, 2>(item, mt, nt);
  const int m0 = mt * 256, n0 = nt * 256;
  const int nsh = n0 >= 2048 ? 16 : 0;
  char* ws = p.ws;
  const bf16_t* A = (const bf16_t*)(ws + W_HBF) + (size_t)m0 * 1024;
  const bf16_t* B = (const bf16_t*)(ws + W_WIN) + (size_t)(n0 + nsh) * 1024;
  f32x4 acc[8][4];
  zero_acc(acc);
  gemm_acc<256, 256, 2, 4, true>(1024, [&](int r, int k) { return A + (size_t)r * 1024 + k; }, [&](int r, int k) { return B + (size_t)perm32(r) * 1024 + k; }, smem, acc);
  const int lane = tidx() & 63, w = tidx() >> 6;
  const int mb = (w / 4) * 128, nb = (w % 4) * 64;
  bf16_t* Z = (bf16_t*)(ws + W_Z);
  const float* bin = p.in[I_BIN] + l * NIN;
#pragma unroll
  for (int jj = 0; jj < 2; jj++) {
    const int n = n0 + nsh + nb + jj * 32 + (lane >> 4) * 8;
    float4 b0 = *(const float4*)(bin + n), b1 = *(const float4*)(bin + n + 4);
#pragma unroll
    for (int i = 0; i < 8; i++) {
      const int m = m0 + mb + i * 16 + (lane & 15);
      uint4 o;
      o.x = pack2(acc[i][2 * jj][0] + b0.x, acc[i][2 * jj][1] + b0.y); o.y = pack2(acc[i][2 * jj][2] + b0.z, acc[i][2 * jj][3] + b0.w);
      o.z = pack2(acc[i][2 * jj + 1][0] + b1.x, acc[i][2 * jj + 1][1] + b1.y); o.w = pack2(acc[i][2 * jj + 1][2] + b1.z, acc[i][2 * jj + 1][3] + b1.w);
      *(uint4*)(Z + (size_t)m * ZS + (n - nsh)) = o;
    }
  }
}
__device__ __forceinline__ void inproj_half_item(const Params& p, int l, int item, char* smem) {
  const int big = 512 + (item >> 1), half = item & 1;
  int mt, nt;
  tile_map<10, 2>(big, mt, nt);
  const int m0 = mt * 256, n0 = nt * 256 + half * 128;
  const int nsh = n0 >= 2048 ? 16 : 0;
  char* ws = p.ws;
  const bf16_t* A = (const bf16_t*)(ws + W_HBF) + (size_t)m0 * 1024;
  const bf16_t* B = (const bf16_t*)(ws + W_WIN) + (size_t)(n0 + nsh) * 1024;
  f32x4 acc[4][4];
  zero_acc(acc);
  gemm_acc<256, 128, 4, 2, true>(1024, [&](int r, int k) { return A + (size_t)r * 1024 + k; }, [&](int r, int k) { return B + (size_t)perm32(r) * 1024 + k; }, smem, acc);
  const int lane = tidx() & 63, w = tidx() >> 6;
  const int mb = (w / 2) * 64, nb = (w % 2) * 64;
  bf16_t* Z = (bf16_t*)(ws + W_Z);
  const float* bin = p.in[I_BIN] + l * NIN;
#pragma unroll
  for (int jj = 0; jj < 2; jj++) {
    const int n = n0 + nsh + nb + jj * 32 + (lane >> 4) * 8;
    float4 b0 = *(const float4*)(bin + n), b1 = *(const float4*)(bin + n + 4);
#pragma unroll
    for (int i = 0; i < 4; i++) {
      const int m = m0 + mb + i * 16 + (lane & 15);
      uint4 o;
      o.x = pack2(acc[i][2 * jj][0] + b0.x, acc[i][2 * jj][1] + b0.y); o.y = pack2(acc[i][2 * jj][2] + b0.z, acc[i][2 * jj][3] + b0.w);
      o.z = pack2(acc[i][2 * jj + 1][0] + b1.x, acc[i][2 * jj + 1][1] + b1.y); o.w = pack2(acc[i][2 * jj + 1][2] + b1.z, acc[i][2 * jj + 1][3] + b1.w);
      *(uint4*)(Z + (size_t)m * ZS + (n - nsh)) = o;
    }
  }
}
__device__ __forceinline__ void ingate_item(const Params& p, int l, int item, char* smem) {
  const int m0 = item * 256;
  char* ws = p.ws;
  const bf16_t* A = (const bf16_t*)(ws + W_HBF) + (size_t)m0 * 1024;
  const bf16_t* B = (const bf16_t*)(ws + W_WIN) + (size_t)OFF_IG * 1024;
  f32x4 acc[4][2];
  zero_acc(acc);
  gemm_acc<256, 64, 4, 2, true>(1024, [&](int r, int k) { return A + (size_t)r * 1024 + k; }, [&](int r, int k) { int rr = r < 16 ? r : 15; return B + (size_t)rr * 1024 + k; }, smem, acc);
  const int lane = tidx() & 63, w = tidx() >> 6;
  const int mb = (w / 2) * 64;
  float* ZG = (float*)(ws + W_ZG);
  const float* bin = p.in[I_BIN] + l * NIN + OFF_IG;
  if ((w & 1) == 0) {
    const int n = (lane >> 4) * 4;
    float4 bv = *(const float4*)(bin + n);
#pragma unroll
    for (int i = 0; i < 4; i++) {
      const int m = m0 + mb + i * 16 + (lane & 15);
      *(float4*)(ZG + (size_t)m * 16 + n) = make_float4(acc[i][0][0] + bv.x, acc[i][0][1] + bv.y, acc[i][0][2] + bv.z, acc[i][0][3] + bv.w);
    }
  }
}

template <int MODE, int NTL, int PN>
__device__ __forceinline__ void plain_gemm_item(const bf16_t* A, const bf16_t* Bt, bf16_t* C, int K, int item, char* smem) {
  constexpr int N = NTL * 256;
  int mt, nt;
  tile_map<NTL, PN>(item, mt, nt);
  const int m0 = mt * 256, n0 = nt * 256;
  const bf16_t* Ab = A + (size_t)m0 * K;
  const bf16_t* Bb = Bt + (size_t)n0 * K;
  f32x4 acc[8][4];
  zero_acc(acc);
  gemm_acc<256, 256, 2, 4, true>(K, [&](int r, int k) { return Ab + (size_t)r * K + k; }, [&](int r, int k) { return Bb + (size_t)perm32(r) * K + k; }, smem, acc);
  const int lane = tidx() & 63, w = tidx() >> 6;
  const int mb = (w / 4) * 128, nb = (w % 4) * 64;
#pragma unroll
  for (int jj = 0; jj < 2; jj++) {
    const int n = n0 + nb + jj * 32 + (lane >> 4) * 8;
#pragma unroll
    for (int i = 0; i < 8; i++) {
      const int m = m0 + mb + i * 16 + (lane & 15);
      float v[8];
#pragma unroll
      for (int r = 0; r < 4; r++) { v[r] = acc[i][2 * jj][r]; v[4 + r] = acc[i][2 * jj + 1][r]; }
      if (MODE == 1) {
#pragma unroll
        for (int r = 0; r < 8; r++) { v[r] = fmaxf(v[r], 0.f); v[r] *= v[r]; }
      }
      uint4 o;
      o.x = pack2(v[0], v[1]); o.y = pack2(v[2], v[3]); o.z = pack2(v[4], v[5]); o.w = pack2(v[6], v[7]);
      *(uint4*)(C + (size_t)m * N + n) = o;
    }
  }
}

template <int MODE, int NTL, int PN>
__device__ __forceinline__ void plain_gemm_chain(const bf16_t* A, const bf16_t* Bt, bf16_t* C, int K, int item, int next, bool has_next, bool preloaded, Stage& st, char* smem) {
  constexpr int N = NTL * 256;
  int mt, nt, mt2 = 0, nt2 = 0;
  tile_map<NTL, PN>(item, mt, nt);
  if (has_next) tile_map<NTL, PN>(next, mt2, nt2);
  const int m0 = mt * 256, n0 = nt * 256;
  const bf16_t* Ab = A + (size_t)m0 * K;
  const bf16_t* Bb = Bt + (size_t)n0 * K;
  const bf16_t* Ab2 = A + (size_t)mt2 * 256 * K;
  const bf16_t* Bb2 = Bt + (size_t)nt2 * 256 * K;
  f32x4 acc[8][4];
  zero_acc(acc);
  gemm_chain<256, 256, 2, 4, true>(K, [&](int r, int k) { return Ab + (size_t)r * K + k; }, [&](int r, int k) { return Bb + (size_t)perm32(r) * K + k; },
                                   preloaded, has_next, [&](int r, int k) { return Ab2 + (size_t)r * K + k; }, [&](int r, int k) { return Bb2 + (size_t)perm32(r) * K + k; }, st, smem, acc);
  const int lane = tidx() & 63, w = tidx() >> 6;
  const int mb = (w / 4) * 128, nb = (w % 4) * 64;
#pragma unroll
  for (int jj = 0; jj < 2; jj++) {
    const int n = n0 + nb + jj * 32 + (lane >> 4) * 8;
#pragma unroll
    for (int i = 0; i < 8; i++) {
      const int m = m0 + mb + i * 16 + (lane & 15);
      float v[8];
#pragma unroll
      for (int r = 0; r < 4; r++) { v[r] = acc[i][2 * jj][r]; v[4 + r] = acc[i][2 * jj + 1][r]; }
      if (MODE == 1) {
#pragma unroll
        for (int r = 0; r < 8; r++) { v[r] = fmaxf(v[r], 0.f); v[r] *= v[r]; }
      }
      uint4 o;
      o.x = pack2(v[0], v[1]); o.y = pack2(v[2], v[3]); o.z = pack2(v[4], v[5]); o.w = pack2(v[6], v[7]);
      *(uint4*)(C + (size_t)m * N + n) = o;
    }
  }
}

__device__ __forceinline__ void merge_item(const Params& p, int l, int item, char* smem) {
  int mt, nt;
  tile_map<8, 4>(item, mt, nt);
  const int m0 = mt * 256, n0 = nt * 128;
  char* ws = p.ws;
  const bf16_t* HB = (const bf16_t*)(ws + W_HBF) + (size_t)m0 * 1024;
  const bf16_t* HM = (const bf16_t*)(ws + W_HM) + (size_t)m0 * 512;
  const bf16_t* YF = (const bf16_t*)(ws + W_YF) + (size_t)m0 * 256;
  const bf16_t* YS = (const bf16_t*)(ws + W_YS) + (size_t)m0 * 256;
  const bf16_t* WG = (const bf16_t*)(ws + W_WIN) + (size_t)(OFF_GATE + n0) * 1024;
  const bf16_t* WUM = (const bf16_t*)(ws + W_WUPM) + (size_t)n0 * 512;
  const bf16_t* WUF = (const bf16_t*)(ws + W_WUPF) + (size_t)n0 * 256;
  const bf16_t* WGL = (const bf16_t*)(ws + W_WGLU) + (size_t)n0 * 256;
  const float* bin = p.in[I_BIN] + l * NIN + OFF_GATE;
  const float* bgl = p.in[I_BGLU] + l * 2048;
  uint2 mixp[4][4];
#pragma unroll
  for (int i = 0; i < 4; i++)
#pragma unroll
    for (int j = 0; j < 4; j++) mixp[i][j] = make_uint2(0u, 0u);
  bf16_t* MIX = (bf16_t*)(ws + W_MIX);
#pragma unroll 1
  for (int br = 0; br < 3; br++) {
    uint2 gp[4][4];
    {
      f32x4 acc[4][4];
      zero_acc(acc);
      const bf16_t* WGb = WG + (size_t)br * 1024 * 1024;
      gemm_acc<256, 128, 4, 2, true>(1024, [&](int r, int k) { return HB + (size_t)r * 1024 + k; }, [&](int r, int k) { return WGb + (size_t)r * 1024 + k; }, smem, acc);
#pragma unroll
      for (int j = 0; j < 4; j++) {
        const int n = n0 + ((tidx() >> 6) & 1) * 64 + j * 16 + ((tidx() >> 4) & 3) * 4;
        float4 bv = *(const float4*)(bin + br * 1024 + n);
#pragma unroll
        for (int i = 0; i < 4; i++)
          gp[i][j] = pack4(sigm(acc[i][j][0] + bv.x), sigm(acc[i][j][1] + bv.y), sigm(acc[i][j][2] + bv.z), sigm(acc[i][j][3] + bv.w));
      }
    }
    if (br == 2) {
      f32x4 a2[4][4];
      zero_acc(a2);
      gemm_acc<256, 128, 4, 2, true>(256, [&](int r, int k) { return YS + (size_t)r * 256 + k; }, [&](int r, int k) { return WGL + (size_t)(1024 + r) * 256 + k; }, smem, a2);
#pragma unroll
      for (int j = 0; j < 4; j++) {
        const int n = n0 + ((tidx() >> 6) & 1) * 64 + j * 16 + ((tidx() >> 4) & 3) * 4;
        float4 b2 = *(const float4*)(bgl + 1024 + n);
#pragma unroll
        for (int i = 0; i < 4; i++)
          gp[i][j] = pack4(lo16(gp[i][j].x) * sigm(a2[i][j][0] + b2.x), hi16(gp[i][j].x) * sigm(a2[i][j][1] + b2.y),
                           lo16(gp[i][j].y) * sigm(a2[i][j][2] + b2.z), hi16(gp[i][j].y) * sigm(a2[i][j][3] + b2.w));
      }
    }
    const bf16_t* A = br == 0 ? HM : (br == 1 ? YF : YS);
    const bf16_t* W = br == 0 ? WUM : (br == 1 ? WUF : WGL);
    const int KA = br == 0 ? 512 : 256;
    f32x4 acc[4][4];
    zero_acc(acc);
    gemm_acc<256, 128, 4, 2, true>(KA, [&](int r, int k) { return A + (size_t)r * KA + k; }, [&](int r, int k) { return W + (size_t)r * KA + k; }, smem, acc);
#pragma unroll
    for (int j = 0; j < 4; j++) {
      const int n = n0 + ((tidx() >> 6) & 1) * 64 + j * 16 + ((tidx() >> 4) & 3) * 4;
      float4 b1 = make_float4(0.f, 0.f, 0.f, 0.f);
      if (br == 2) b1 = *(const float4*)(bgl + n);
#pragma unroll
      for (int i = 0; i < 4; i++) {
        mixp[i][j] = pack4(lo16(mixp[i][j].x) + (acc[i][j][0] + b1.x) * lo16(gp[i][j].x), hi16(mixp[i][j].x) + (acc[i][j][1] + b1.y) * hi16(gp[i][j].x),
                           lo16(mixp[i][j].y) + (acc[i][j][2] + b1.z) * lo16(gp[i][j].y), hi16(mixp[i][j].y) + (acc[i][j][3] + b1.w) * hi16(gp[i][j].y));
      }
    }
  }
#pragma unroll
  for (int j = 0; j < 4; j++) {
    const int n = n0 + ((tidx() >> 6) & 1) * 64 + j * 16 + ((tidx() >> 4) & 3) * 4;
#pragma unroll
    for (int i = 0; i < 4; i++) {
      const int m = m0 + (tidx() >> 7) * 64 + i * 16 + (tidx() & 15);
      *(uint2*)(MIX + (size_t)m * 1024 + n) = mixp[i][j];
    }
  }
}

__device__ __forceinline__ void mergelite_item(const Params& p, int l, int item, char* smem) {
  int mt, nt;
  tile_map<8, 4>(item, mt, nt);
  const int m0 = mt * 256, n0 = nt * 128;
  char* ws = p.ws;
  const bf16_t* HM = (const bf16_t*)(ws + W_HM) + (size_t)m0 * 512;
  const bf16_t* YF = (const bf16_t*)(ws + W_YF) + (size_t)m0 * 256;
  const bf16_t* YS = (const bf16_t*)(ws + W_YS) + (size_t)m0 * 256;
  const bf16_t* WUM = (const bf16_t*)(ws + W_WUPM) + (size_t)n0 * 512;
  const bf16_t* WUF = (const bf16_t*)(ws + W_WUPF) + (size_t)n0 * 256;
  const bf16_t* WGL = (const bf16_t*)(ws + W_WGLU) + (size_t)n0 * 256;
  const bf16_t* WGL2 = WGL + (size_t)1024 * 256;
  const float* bgl = p.in[I_BGLU] + l * 2048;
  const bf16_t* G = (const bf16_t*)(ws + W_GATE);
  bf16_t* MIX = (bf16_t*)(ws + W_MIX);
#define MROW(i) (m0 + (tidx() >> 7) * 64 + (i) * 16 + (tidx() & 15))
#define NCOL8(jj) (n0 + ((tidx() >> 6) & 1) * 64 + (jj) * 32 + ((tidx() >> 4) & 3) * 8)
  Stage st; st.a0 = st.a1 = st.a2 = st.a3 = st.b0 = st.b1 = st.b2 = st.b3 = make_uint4(0, 0, 0, 0);
  uint2 mixp[4][4], tmpp[4][4];
#pragma unroll
  for (int i = 0; i < 4; i++)
#pragma unroll
    for (int j = 0; j < 4; j++) { mixp[i][j] = make_uint2(0u, 0u); tmpp[i][j] = make_uint2(0u, 0u); }
#pragma unroll 1
  for (int sg = 0; sg < 4; sg++) {
    const bf16_t* A = sg == 0 ? HM : (sg == 1 ? YF : YS);
    const bf16_t* W = sg == 0 ? WUM : (sg == 1 ? WUF : (sg == 2 ? WGL : WGL2));
    const int KA = sg == 0 ? 512 : 256;
    const bf16_t* A2 = sg == 0 ? YF : YS;
    const bf16_t* W2 = sg == 0 ? WUF : (sg == 1 ? WGL : WGL2);
    f32x4 acc[4][4];
    zero_acc(acc);
    gemm_chain<256, 128, 4, 2, true>(KA, [&](int r, int k) { return A + (size_t)r * KA + k; }, [&](int r, int k) { return W + (size_t)perm32(r) * KA + k; },
                                     sg > 0, sg < 3, [&](int r, int k) { return A2 + (size_t)r * 256 + k; }, [&](int r, int k) { return W2 + (size_t)perm32(r) * 256 + k; }, st, smem, acc);
    if (sg < 2) {
#pragma unroll
      for (int jj = 0; jj < 2; jj++)
#pragma unroll
        for (int i = 0; i < 4; i++) {
          const uint4 g = *(const uint4*)(G + (size_t)MROW(i) * 3072 + sg * 1024 + NCOL8(jj));
          const uint2 o0 = mixp[i][2 * jj], o1 = mixp[i][2 * jj + 1];
          mixp[i][2 * jj].x = pack2(lo16(o0.x) + acc[i][2 * jj][0] * lo16(g.x), hi16(o0.x) + acc[i][2 * jj][1] * hi16(g.x));
          mixp[i][2 * jj].y = pack2(lo16(o0.y) + acc[i][2 * jj][2] * lo16(g.y), hi16(o0.y) + acc[i][2 * jj][3] * hi16(g.y));
          mixp[i][2 * jj + 1].x = pack2(lo16(o1.x) + acc[i][2 * jj + 1][0] * lo16(g.z), hi16(o1.x) + acc[i][2 * jj + 1][1] * hi16(g.z));
          mixp[i][2 * jj + 1].y = pack2(lo16(o1.y) + acc[i][2 * jj + 1][2] * lo16(g.w), hi16(o1.y) + acc[i][2 * jj + 1][3] * hi16(g.w));
        }
    } else if (sg == 2) {
#pragma unroll
      for (int jj = 0; jj < 2; jj++) {
        const float4 b0 = *(const float4*)(bgl + NCOL8(jj)), b1 = *(const float4*)(bgl + NCOL8(jj) + 4);
#pragma unroll
        for (int i = 0; i < 4; i++) {
          tmpp[i][2 * jj].x = pack2(acc[i][2 * jj][0] + b0.x, acc[i][2 * jj][1] + b0.y);
          tmpp[i][2 * jj].y = pack2(acc[i][2 * jj][2] + b0.z, acc[i][2 * jj][3] + b0.w);
          tmpp[i][2 * jj + 1].x = pack2(acc[i][2 * jj + 1][0] + b1.x, acc[i][2 * jj + 1][1] + b1.y);
          tmpp[i][2 * jj + 1].y = pack2(acc[i][2 * jj + 1][2] + b1.z, acc[i][2 * jj + 1][3] + b1.w);
        }
      }
    } else {
#pragma unroll
      for (int jj = 0; jj < 2; jj++) {
        const float4 b0 = *(const float4*)(bgl + 1024 + NCOL8(jj)), b1 = *(const float4*)(bgl + 1024 + NCOL8(jj) + 4);
#pragma unroll
        for (int i = 0; i < 4; i++) {
          const uint4 g = *(const uint4*)(G + (size_t)MROW(i) * 3072 + 2048 + NCOL8(jj));
          const uint2 t0 = tmpp[i][2 * jj], t1 = tmpp[i][2 * jj + 1], o0 = mixp[i][2 * jj], o1 = mixp[i][2 * jj + 1];
          uint4 o;
          o.x = pack2(lo16(o0.x) + lo16(t0.x) * sigm(acc[i][2 * jj][0] + b0.x) * lo16(g.x), hi16(o0.x) + hi16(t0.x) * sigm(acc[i][2 * jj][1] + b0.y) * hi16(g.x));
          o.y = pack2(lo16(o0.y) + lo16(t0.y) * sigm(acc[i][2 * jj][2] + b0.z) * lo16(g.y), hi16(o0.y) + hi16(t0.y) * sigm(acc[i][2 * jj][3] + b0.w) * hi16(g.y));
          o.z = pack2(lo16(o1.x) + lo16(t1.x) * sigm(acc[i][2 * jj + 1][0] + b1.x) * lo16(g.z), hi16(o1.x) + hi16(t1.x) * sigm(acc[i][2 * jj + 1][1] + b1.y) * hi16(g.z));
          o.w = pack2(lo16(o1.y) + lo16(t1.y) * sigm(acc[i][2 * jj + 1][2] + b1.z) * lo16(g.w), hi16(o1.y) + hi16(t1.y) * sigm(acc[i][2 * jj + 1][3] + b1.w) * hi16(g.w));
          *(uint4*)(MIX + (size_t)MROW(i) * 1024 + NCOL8(jj)) = o;
        }
      }
    }
  }
#undef MROW
#undef NCOL8
}

__device__ __forceinline__ void four_g1(const Params& p, int item, char* smem) {
  const int g = item & 3, s2 = (item >> 2) & 63, b = item >> 8;
  char* ws = p.ws;
  const bf16_t* Z = (const bf16_t*)(ws + W_Z) + ((size_t)b * SEQ + s2) * ZS + OFF_F + g * 64;
  const bf16_t* F1T = (const bf16_t*)(ws + W_F1T);
  f32x4 acc[2][4];
  zero_acc(acc);
  gemm_acc<128, 128, 4, 2, false>(64, [&](int r, int k) { return Z + (size_t)r * 64 * ZS + k; }, [&](int r, int k) { return F1T + r * 64 + k; }, smem, acc);
  const int lane = tidx() & 63, w = tidx() >> 6;
  const int mb = (w / 2) * 32, nb = (w % 2) * 64;
  bf16_t* U1T = (bf16_t*)(ws + W_U1T);
#pragma unroll
  for (int i = 0; i < 2; i++) {
    const int s1 = mb + i * 16 + (lane >> 4) * 4;
#pragma unroll
    for (int j = 0; j < 4; j++) {
      const int n = nb + j * 16 + (lane & 15), c = n >> 6, jj = n & 63;
      size_t off = ((((size_t)(b * 256 + g * 64 + jj) * 64 + s2) * 2 + c) * 128) + s1;
      *(uint2*)(U1T + off) = pack4(acc[i][j][0], acc[i][j][1], acc[i][j][2], acc[i][j][3]);
    }
  }
}
__device__ __forceinline__ void four_g2(const Params& p, int item, char* smem) {
  const int mt = item >> 1, nt = item & 1;
  const int m0 = mt * 128, n0 = nt * 128;
  char* ws = p.ws;
  const bf16_t* A = (const bf16_t*)(ws + W_U1T) + (size_t)m0 * 256;
  const bf16_t* B = (const bf16_t*)(ws + W_F2T) + (size_t)n0 * 256;
  f32x4 acc[2][4];
  zero_acc(acc);
  gemm_acc<128, 128, 4, 2, false>(256, [&](int r, int k) { return A + (size_t)r * 256 + k; }, [&](int r, int k) { return B + (size_t)r * 256 + k; }, smem, acc);
  const int lane = tidx() & 63, w = tidx() >> 6;
  const int mb = (w / 2) * 32, nb = (w % 2) * 64;
  const float* TW = (const float*)(ws + W_TW);
  bf16_t* A2T = (bf16_t*)(ws + W_A2T);
#pragma unroll
  for (int i = 0; i < 2; i++) {
    const int m = m0 + mb + i * 16 + (lane >> 4) * 4;
    const int s2 = m & 63, col = (m >> 6) & 255, b = m >> 14;
#pragma unroll
    for (int jp = 0; jp < 2; jp++) {
      const int nn = n0 + nb + jp * 32;
      const int k1 = (nn >> 5) * 16 + (lane & 15);
      float re[4], im[4];
#pragma unroll
      for (int r = 0; r < 4; r++) {
        float c = TW[((s2 + r) * 128 + k1) * 2], s = TW[((s2 + r) * 128 + k1) * 2 + 1];
        float ar = acc[i][jp * 2][r], ai = acc[i][jp * 2 + 1][r];
        re[r] = ar * c + ai * s;
        im[r] = ai * c - ar * s;
      }
      size_t off = ((size_t)(b * 128 + k1) * 256 + col) * 128 + s2;
      *(uint2*)(A2T + off) = pack4(re[0], re[1], re[2], re[3]);
      *(uint2*)(A2T + off + 64) = pack4(im[0], im[1], im[2], im[3]);
    }
  }
}
__device__ __forceinline__ void four_g3(const Params& p, int item, char* smem) {
  const int m0 = item * 128;
  char* ws = p.ws;
  const bf16_t* A = (const bf16_t*)(ws + W_A2T) + (size_t)m0 * 128;
  const bf16_t* B = (const bf16_t*)(ws + W_F3T);
  f32x4 acc[2][2];
  zero_acc(acc);
  gemm_acc<128, 64, 4, 2, false>(128, [&](int r, int k) { return A + (size_t)r * 128 + k; }, [&](int r, int k) { return B + r * 128 + k; }, smem, acc);
  const int lane = tidx() & 63, w = tidx() >> 6;
  const int mb = (w / 2) * 32, nb = (w % 2) * 32;
  bf16_t* YF = (bf16_t*)(ws + W_YF);
#pragma unroll
  for (int i = 0; i < 2; i++) {
    const int m = m0 + mb + i * 16 + (lane >> 4) * 4;
    const int col = m & 255, k1 = (m >> 8) & 127, b = m >> 15;
#pragma unroll
    for (int j = 0; j < 2; j++) {
      const int k2 = nb + j * 16 + (lane & 15);
      size_t off = ((size_t)b * SEQ + k1 + 128 * k2) * 256 + col;
      *(uint2*)(YF + off) = pack4(acc[i][j][0], acc[i][j][1], acc[i][j][2], acc[i][j][3]);
    }
  }
}

__device__ __forceinline__ void s5_e(const Params& p, int item, char* smem) {
  const int g = item >> 3, mt = (item >> 1) & 3, nt = item & 1;
  const int m0 = mt * 128, n0 = nt * 128;
  char* ws = p.ws;
  const bf16_t* Z = (const bf16_t*)(ws + W_Z) + OFF_S + g * 16;
  const bf16_t* B = (const bf16_t*)(ws + W_ET) + ((size_t)g * 256 + n0) * 512;
  f32x4 acc[2][4];
  zero_acc(acc);
  gemm_acc<128, 128, 4, 2, true>(512,
      [&](int r, int k) { int m = m0 + r; int tok = (m >> 8) * SEQ + (m & 255) * 32 + (k >> 4); return Z + (size_t)tok * ZS + (k & 15); },
      [&](int r, int k) { return B + (size_t)r * 512 + k; }, smem, acc);
  const int lane = tidx() & 63, w = tidx() >> 6;
  const int mb = (w / 2) * 32, nb = (w % 2) * 64;
  bf16_t* XE = (bf16_t*)(ws + W_XEND);
#pragma unroll
  for (int i = 0; i < 2; i++) {
    const int m = m0 + mb + i * 16 + (lane & 15);
#pragma unroll
    for (int j = 0; j < 4; j++) {
      const int n = n0 + nb + j * 16 + (lane >> 4) * 4;
      *(uint2*)(XE + ((size_t)m * 16 + g) * 256 + n) = pack4(acc[i][j][0], acc[i][j][1], acc[i][j][2], acc[i][j][3]);
    }
  }
}
__device__ __forceinline__ void s5_carry(const Params& p, int blk) {
  const int gt = blk * NT + tidx();
  const int b = gt >> 11, g = (gt >> 7) & 15, d = (gt >> 6) & 1, pp = gt & 63;
  char* ws = p.ws;
  const float* LP = (const float*)(ws + W_LPOW) + ((d * 16 + g) * 64 + pp) * 2;
  const float lr = LP[0], li = LP[1];
  const uint32_t* XE = (const uint32_t*)(ws + W_XEND);
  uint32_t* XC = (uint32_t*)(ws + W_XCAR);
  float xr = 0.f, xi = 0.f;
  for (int c0 = 0; c0 < 256; c0 += 32) {
    uint32_t v[32];
#pragma unroll
    for (int u = 0; u < 32; u++) {
      int c = d == 0 ? c0 + u : 255 - (c0 + u);
      v[u] = XE[(((size_t)(b * 256 + c) * 16 + g) * 256 + d * 128 + pp * 2) >> 1];
    }
#pragma unroll
    for (int u = 0; u < 32; u++) {
      int c = d == 0 ? c0 + u : 255 - (c0 + u);
      float nr = lr * xr - li * xi + lo16(v[u]);
      float ni = lr * xi + li * xr + hi16(v[u]);
      xr = nr; xi = ni;
      XC[(((size_t)(b * 256 + c) * 16 + g) * 256 + d * 128 + pp * 2) >> 1] = pack2(xr, xi);
    }
  }
}
__device__ __forceinline__ void s5_tg(const Params& p, int item, char* smem) {
  const int g = item >> 4, mt = (item >> 2) & 3, nt = item & 3;
  const int m0 = mt * 128, n0 = nt * 128;
  char* ws = p.ws;
  const bf16_t* Z = (const bf16_t*)(ws + W_Z) + OFF_S + g * 16;
  const bf16_t* XC = (const bf16_t*)(ws + W_XCAR);
  const bf16_t* ZR = (const bf16_t*)(ws + W_ZERO);
  const bf16_t* B = (const bf16_t*)(ws + W_TG) + ((size_t)g * 512 + n0) * 768;
  f32x4 acc[2][4];
  zero_acc(acc);
  gemm_acc<128, 128, 4, 2, true>(768,
      [&](int r, int k) -> const bf16_t* {
        int m = m0 + r; int b = m >> 8, c = m & 255;
        if (k < 512) { int tok = b * SEQ + c * 32 + (k >> 4); return Z + (size_t)tok * ZS + (k & 15); }
        int kk = k - 512; int d = kk >> 7; int cc = d == 0 ? c - 1 : c + 1;
        if (cc < 0 || cc > 255) return ZR;
        return XC + ((size_t)(b * 256 + cc) * 16 + g) * 256 + kk;
      },
      [&](int r, int k) { return B + (size_t)r * 768 + k; }, smem, acc);
  const int lane = tidx() & 63, w = tidx() >> 6;
  const int mb = (w / 2) * 32, nb = (w % 2) * 64;
  bf16_t* YS = (bf16_t*)(ws + W_YS);
#pragma unroll
  for (int i = 0; i < 2; i++) {
    const int m = m0 + mb + i * 16 + (lane & 15);
    const int b = m >> 8, c = m & 255;
#pragma unroll
    for (int j = 0; j < 4; j++) {
      const int n = n0 + nb + j * 16 + (lane >> 4) * 4;
      const int t = n >> 4, co = n & 15;
      size_t off = ((size_t)b * SEQ + c * 32 + t) * 256 + g * 16 + co;
      *(uint2*)(YS + off) = pack4(gelu_tanh(acc[i][j][0]), gelu_tanh(acc[i][j][1]), gelu_tanh(acc[i][j][2]), gelu_tanh(acc[i][j][3]));
    }
  }
}

__device__ __forceinline__ void conv8(const bf16_t* __restrict__ Z, const float* __restrict__ cw, const float* __restrict__ cb,
                                      int b, int s, int zcol, int ch, float (&o)[8]) {
  float4 b0 = *(const float4*)(cb + ch), b1 = *(const float4*)(cb + ch + 4);
  o[0] = b0.x; o[1] = b0.y; o[2] = b0.z; o[3] = b0.w; o[4] = b1.x; o[5] = b1.y; o[6] = b1.z; o[7] = b1.w;
#pragma unroll
  for (int wq = 0; wq < 5; wq++) {
    int ss = s + wq - 2;
    if (ss >= 0 && ss < SEQ) {
      uint4 v = *(const uint4*)(Z + ((size_t)b * SEQ + ss) * ZS + zcol);
      float4 w0 = *(const float4*)(cw + wq * 1024 + ch), w1 = *(const float4*)(cw + wq * 1024 + ch + 4);
      o[0] += w0.x * lo16(v.x); o[1] += w0.y * hi16(v.x); o[2] += w0.z * lo16(v.y); o[3] += w0.w * hi16(v.y);
      o[4] += w1.x * lo16(v.z); o[5] += w1.y * hi16(v.z); o[6] += w1.z * lo16(v.w); o[7] += w1.w * hi16(v.w);
    }
  }
#pragma unroll
  for (int e = 0; e < 8; e++) o[e] = o[e] * sigm(o[e]);
}

__device__ __forceinline__ void mlstm_local(const Params& p, int l, int item, char* smem) {
  const int co = item & 63, h = (item >> 6) & 3, b = item >> 8;
  char* ws = p.ws;
  bf16_t* KTs = (bf16_t*)smem;
  bf16_t* VTs = KTs + 128 * LDT;
  float* WV = (float*)(VTs + 128 * LDT);
  const int tid = tidx(), lane = tid & 63, w = tid >> 6;
  const int tok0 = b * SEQ + co * 128;
  const bf16_t* Z = (const bf16_t*)(ws + W_Z);
  const float* ZG = (const float*)(ws + W_ZG);
  if (w < 2) {
    const int d = w, dbh = d * 8 + b * 4 + h, cp = d ? 63 - co : co;
    const int l0 = 2 * lane, l1 = l0 + 1;
    const int i0 = d ? 127 - l0 : l0, i1 = d ? 127 - l1 : l1;
    float ig0 = ZG[(size_t)(tok0 + i0) * 16 + d * 4 + h], ig1 = ZG[(size_t)(tok0 + i1) * 16 + d * 4 + h];
    float f0 = logsig(ZG[(size_t)(tok0 + i0) * 16 + 8 + d * 4 + h]), f1 = logsig(ZG[(size_t)(tok0 + i1) * 16 + 8 + d * 4 + h]);
    float s1 = f0 + f1;
    float incl = wave_incl_sum(s1, lane);
    float excl = incl - s1;
    float b0 = excl + f0, b1 = incl;
    float gtot = __shfl(incl, 63);
    float a0 = gtot - b0 + ig0, a1 = gtot - b1 + ig1;
    float am = wave_max(fmaxf(a0, a1));
    WV[d * 128 + i0] = expf(a0 - am);
    WV[d * 128 + i1] = expf(a1 - am);
    if (lane == 0) {
      ((float*)(ws + W_AMAX))[dbh * 64 + cp] = am;
      ((float*)(ws + W_G))[dbh * 64 + cp] = gtot;
    }
  }
  const float* cw = p.in[I_CW] + l * 5 * 1024;
  const float* cb = p.in[I_CB] + l * 1024;
#pragma unroll 1
  for (int t = 0; t < 4; t++) {
    int c = tid + t * NT, i = c & 127, d8 = (c >> 7) * 8;
    float o[8];
    conv8(Z, cw, cb, b, co * 128 + i, OFF_K + h * 128 + d8, 512 + h * 128 + d8, o);
#pragma unroll
    for (int e = 0; e < 8; e++) KTs[(d8 + e) * LDT + i] = f2bf(o[e]);
  }
  __syncthreads();
  if (tid < 256) {
    const int d = tid >> 7, k = tid & 127;
    const int dbh = d * 8 + b * 4 + h, cp = d ? 63 - co : co;
    float s = 0.f;
    for (int i = 0; i < 128; i++) s += WV[d * 128 + i] * bf2f(KTs[k * LDT + i]);
    ((float*)(ws + W_NST))[(size_t)(dbh * 64 + cp) * 128 + k] = s;
  }
  bf16_t* CST = (bf16_t*)(ws + W_CST);
  const int mb = (w / 2) * 32, nb = (w % 2) * 64;
#pragma unroll 1
  for (int d = 0; d < 2; d++) {
    const int dbh = d * 8 + b * 4 + h, cp = d ? 63 - co : co;
#pragma unroll 1
    for (int t = 0; t < 4; t++) {
      int c = tid + t * NT, i = c & 127, e8 = (c >> 7) * 8;
      uint4 v = *(const uint4*)(Z + (size_t)(tok0 + i) * ZS + OFF_V + h * 128 + e8);
      float wv = WV[d * 128 + i];
      VTs[(e8 + 0) * LDT + i] = f2bf(lo16(v.x) * wv); VTs[(e8 + 1) * LDT + i] = f2bf(hi16(v.x) * wv);
      VTs[(e8 + 2) * LDT + i] = f2bf(lo16(v.y) * wv); VTs[(e8 + 3) * LDT + i] = f2bf(hi16(v.y) * wv);
      VTs[(e8 + 4) * LDT + i] = f2bf(lo16(v.z) * wv); VTs[(e8 + 5) * LDT + i] = f2bf(hi16(v.z) * wv);
      VTs[(e8 + 6) * LDT + i] = f2bf(lo16(v.w) * wv); VTs[(e8 + 7) * LDT + i] = f2bf(hi16(v.w) * wv);
    }
    __syncthreads();
    f32x4 acc[2][4];
    zero_acc(acc);
    mma_lds<2, 4, false>(KTs, VTs, 128, mb, nb, acc);
    bf16_t* C = CST + (size_t)(dbh * 64 + cp) * 16384;
#pragma unroll
    for (int i = 0; i < 2; i++) {
      const int k = mb + i * 16 + (lane >> 4) * 4;
#pragma unroll
      for (int j = 0; j < 4; j++) {
        const int e = nb + j * 16 + (lane & 15);
        *(uint2*)(C + e * 128 + k) = pack4(acc[i][j][0], acc[i][j][1], acc[i][j][2], acc[i][j][3]);
      }
    }
    __syncthreads();
  }
}

__device__ __forceinline__ void mlstm_scan(const Params& p, int blk) {
  char* ws = p.ws;
  const float* AM = (const float*)(ws + W_AMAX);
  const float* G = (const float*)(ws + W_G);
  if (blk < 128) {
    const int gt = blk * NT + tidx(), dbh = gt >> 12, e4 = gt & 4095;
    uint2* C = (uint2*)(ws + W_CST) + (size_t)dbh * 64 * 4096 + e4;
    float m = 0.f, c0 = 0.f, c1 = 0.f, c2 = 0.f, c3 = 0.f;
    for (int cc0 = 0; cc0 < 64; cc0 += 16) {
      uint2 v[16];
      float gg[16], aa[16];
#pragma unroll
      for (int u = 0; u < 16; u++) { v[u] = C[(size_t)(cc0 + u) * 4096]; gg[u] = G[dbh * 64 + cc0 + u]; aa[u] = AM[dbh * 64 + cc0 + u]; }
#pragma unroll
      for (int u = 0; u < 16; u++) {
        const int cc = cc0 + u;
        float g = gg[u], am = aa[u];
        float mn = fmaxf(g + m, am);
        float so = __expf(g + m - mn), sn = __expf(am - mn);
        C[(size_t)cc * 4096] = pack4(c0, c1, c2, c3);
        if (e4 == 0) ((float*)(ws + W_MPREV))[dbh * 64 + cc] = m;
        c0 = so * c0 + sn * lo16(v[u].x); c1 = so * c1 + sn * hi16(v[u].x);
        c2 = so * c2 + sn * lo16(v[u].y); c3 = so * c3 + sn * hi16(v[u].y);
        m = mn;
      }
    }
  } else {
    const int gt = (blk - 128) * NT + tidx(), dbh = gt >> 7, k = gt & 127;
    float* N = (float*)(ws + W_NST) + (size_t)dbh * 64 * 128 + k;
    float m = 0.f, n = 0.f;
    for (int cc = 0; cc < 64; cc++) {
      float g = G[dbh * 64 + cc], am = AM[dbh * 64 + cc];
      float mn = fmaxf(g + m, am);
      float so = expf(g + m - mn), sn = expf(am - mn);
      float v = N[cc * 128];
      N[cc * 128] = n;
      n = so * n + sn * v;
      m = mn;
    }
  }
}

__device__ __forceinline__ void mlstm_out(const Params& p, int l, int item, char* smem) {
  const int co = item & 63, h = (item >> 6) & 3, b = item >> 8;
  char* ws = p.ws;
  bf16_t* B0 = (bf16_t*)smem;
  bf16_t* B1 = B0 + 128 * LDT;
  bf16_t* B2 = B1 + 128 * LDT;
  bf16_t* B3 = B2 + 128 * LDT;
  float* FU = (float*)(B3 + 128 * LDT);
  float* FMM = FU + 256;
  float* FIW = FMM + 256;
  float* FEN = FIW + 256;
  float* FNP = FEN + 256;
  const int tid = tidx(), lane = tid & 63, w = tid >> 6;
  const int tok0 = b * SEQ + co * 128;
  const bf16_t* Z = (const bf16_t*)(ws + W_Z);
  const float* ZG = (const float*)(ws + W_ZG);
  const bf16_t* C0p = (const bf16_t*)(ws + W_CST) + (size_t)((0 * 8 + b * 4 + h) * 64 + co) * 16384;
  const bf16_t* C1p = (const bf16_t*)(ws + W_CST) + (size_t)((1 * 8 + b * 4 + h) * 64 + (63 - co)) * 16384;
#define PFV(t) (*(const uint4*)(Z + (size_t)(tok0 + ((tid + (t) * NT) & 127)) * ZS + OFF_V + h * 128 + ((tid + (t) * NT) >> 7) * 8))
#define PFC(P, t) (*(const uint4*)((P) + ((tid + (t) * NT) >> 4) * 128 + ((tid + (t) * NT) & 15) * 8))
  const uint4 vp0 = PFV(0), vp1 = PFV(1), vp2 = PFV(2), vp3 = PFV(3);
  const uint4 ca0 = PFC(C0p, 0), ca1 = PFC(C0p, 1), ca2 = PFC(C0p, 2), ca3 = PFC(C0p, 3);
  const uint4 cb0 = PFC(C1p, 0), cb1 = PFC(C1p, 1), cb2 = PFC(C1p, 2), cb3 = PFC(C1p, 3);
#undef PFV
#undef PFC
  if (w < 2) {
    const int d = w, dbh = d * 8 + b * 4 + h, cp = d ? 63 - co : co;
    const float mprev = ((const float*)(ws + W_MPREV))[dbh * 64 + cp];
    const int l0 = 2 * lane, l1 = l0 + 1;
    const int i0 = d ? 127 - l0 : l0, i1 = d ? 127 - l1 : l1;
    float ig0 = ZG[(size_t)(tok0 + i0) * 16 + d * 4 + h], ig1 = ZG[(size_t)(tok0 + i1) * 16 + d * 4 + h];
    float f0 = logsig(ZG[(size_t)(tok0 + i0) * 16 + 8 + d * 4 + h]), f1 = logsig(ZG[(size_t)(tok0 + i1) * 16 + 8 + d * 4 + h]);
    float s1 = f0 + f1;
    float incl = wave_incl_sum(s1, lane);
    float b0 = incl - s1 + f0, b1 = incl;
    float u0 = ig0 - b0, u1 = ig1 - b1;
    float pm1 = fmaxf(u0, u1);
    float inclm = wave_incl_max(pm1, lane);
    float exclm = __shfl_up(inclm, 1);
    if (lane == 0) exclm = -INFINITY;
    float r0 = fmaxf(exclm, u0), r1 = fmaxf(exclm, pm1);
    float mm0 = fmaxf(mprev, r0), mm1 = fmaxf(mprev, r1);
    FU[d * 128 + i0] = u0; FU[d * 128 + i1] = u1;
    FMM[d * 128 + i0] = mm0; FMM[d * 128 + i1] = mm1;
    FIW[d * 128 + i0] = expf(mprev - mm0); FIW[d * 128 + i1] = expf(mprev - mm1);
    FEN[d * 128 + i0] = expf(-(b0 + mm0)); FEN[d * 128 + i1] = expf(-(b1 + mm1));
  }
  if (tid < 256) {
    const int d = tid >> 7, k = tid & 127;
    const int dbh = d * 8 + b * 4 + h, cp = d ? 63 - co : co;
    FNP[tid] = ((const float*)(ws + W_NST))[(size_t)(dbh * 64 + cp) * 128 + k];
  }
  const float* cw = p.in[I_CW] + l * 5 * 1024;
  const float* cb = p.in[I_CB] + l * 1024;
  const float qscale = 0.08838834764831845f;
  const int mb = w * 16;
  const int irow = mb + (lane & 15);
  f32x4 hf[8];
  {
#pragma unroll 1
    for (int t = 0; t < 4; t++) {
      int c = tid + t * NT, i = c >> 4, d8 = (c & 15) * 8;
      float o[8];
      conv8(Z, cw, cb, b, co * 128 + i, h * 128 + d8, h * 128 + d8, o);
      uint4 q;
      q.x = pack2(o[0] * qscale, o[1] * qscale); q.y = pack2(o[2] * qscale, o[3] * qscale);
      q.z = pack2(o[4] * qscale, o[5] * qscale); q.w = pack2(o[6] * qscale, o[7] * qscale);
      *(uint4*)&B0[i * LDT + d8] = q;
      conv8(Z, cw, cb, b, co * 128 + i, OFF_K + h * 128 + d8, 512 + h * 128 + d8, o);
      q.x = pack2(o[0], o[1]); q.y = pack2(o[2], o[3]); q.z = pack2(o[4], o[5]); q.w = pack2(o[6], o[7]);
      *(uint4*)&B1[i * LDT + d8] = q;
    }
  }
  __syncthreads();
  f32x4 accS[1][8];
  zero_acc(accS);
  mma_lds<1, 8, true>(B0, B1, 128, mb, 0, accS);
  float qn0 = 0.f, qn1 = 0.f;
  {
    const int kq0 = (lane >> 4) * 32;
#pragma unroll 8
    for (int k = 0; k < 32; k++) { float qv = bf2f(B0[irow * LDT + kq0 + k]); qn0 += qv * FNP[kq0 + k]; qn1 += qv * FNP[128 + kq0 + k]; }
  }
  qn0 += __shfl_xor(qn0, 16); qn0 += __shfl_xor(qn0, 32);
  qn1 += __shfl_xor(qn1, 16); qn1 += __shfl_xor(qn1, 32);
  __syncthreads();
#define VTS(t, v)                                                                                         \
  {                                                                                                       \
    const int c_ = tid + (t) * NT, j_ = c_ & 127, e8_ = (c_ >> 7) * 8;                                    \
    B1[(e8_ + 0) * LDT + j_] = (bf16_t)((v).x & 0xffff); B1[(e8_ + 1) * LDT + j_] = (bf16_t)((v).x >> 16); \
    B1[(e8_ + 2) * LDT + j_] = (bf16_t)((v).y & 0xffff); B1[(e8_ + 3) * LDT + j_] = (bf16_t)((v).y >> 16); \
    B1[(e8_ + 4) * LDT + j_] = (bf16_t)((v).z & 0xffff); B1[(e8_ + 5) * LDT + j_] = (bf16_t)((v).z >> 16); \
    B1[(e8_ + 6) * LDT + j_] = (bf16_t)((v).w & 0xffff); B1[(e8_ + 7) * LDT + j_] = (bf16_t)((v).w >> 16); \
  }
  VTS(0, vp0) VTS(1, vp1) VTS(2, vp2) VTS(3, vp3)
#undef VTS
#define CST_(t, v) { const int c_ = tid + (t) * NT; *(uint4*)&B3[(c_ >> 4) * LDT + (c_ & 15) * 8] = (v); }
#pragma unroll
  for (int d = 0; d < 2; d++) {
    if (d == 0) { CST_(0, ca0) CST_(1, ca1) CST_(2, ca2) CST_(3, ca3) }
    else { CST_(0, cb0) CST_(1, cb1) CST_(2, cb2) CST_(3, cb3) }
    const float mmi = FMM[d * 128 + irow];
    float rowsum = 0.f;
#pragma unroll
    for (int jt = 0; jt < 8; jt++) {
      const int j0 = jt * 16 + (lane >> 4) * 4;
      float pv[4];
#pragma unroll
      for (int r = 0; r < 4; r++) {
        const int j = j0 + r;
        const bool ok = d ? (j >= irow) : (j <= irow);
        float e = ok ? accS[0][jt][r] * __expf(FU[d * 128 + j] - mmi) : 0.f;
        pv[r] = e; rowsum += e;
      }
      *(uint2*)&B2[irow * LDT + j0] = pack4(pv[0], pv[1], pv[2], pv[3]);
    }
    rowsum += __shfl_xor(rowsum, 16); rowsum += __shfl_xor(rowsum, 32);
    const float iw = FIW[d * 128 + irow];
    const float den = rowsum + iw * (d ? qn1 : qn0);
    __syncthreads();
    f32x4 acc[1][8];
    zero_acc(acc);
    mma_lds<1, 8, true>(B0, B3, 128, mb, 0, acc);
#pragma unroll
    for (int jt = 0; jt < 8; jt++) { acc[0][jt][0] *= iw; acc[0][jt][1] *= iw; acc[0][jt][2] *= iw; acc[0][jt][3] *= iw; }
    mma_lds<1, 8, true>(B2, B1, 128, mb, 0, acc);
    const float dn = 1.f / fmaxf(fabsf(den), FEN[d * 128 + irow]);
    if (d == 0) {
#pragma unroll
      for (int jt = 0; jt < 8; jt++) hf[jt] = acc[0][jt] * dn;
      __syncthreads();
    } else {
#pragma unroll
      for (int jt = 0; jt < 8; jt++) hf[jt] += acc[0][jt] * dn;
    }
  }
#undef CST_
  float s = 0.f;
#pragma unroll
  for (int jt = 0; jt < 8; jt++) s += hf[jt][0] + hf[jt][1] + hf[jt][2] + hf[jt][3];
  s += __shfl_xor(s, 16); s += __shfl_xor(s, 32);
  const float mu = s * (1.f / 128.f);
  float v = 0.f;
#pragma unroll
  for (int jt = 0; jt < 8; jt++)
#pragma unroll
    for (int r = 0; r < 4; r++) { float dd = hf[jt][r] - mu; v += dd * dd; }
  v += __shfl_xor(v, 16); v += __shfl_xor(v, 32);
  const float rs = rsqrtf(v * (1.f / 128.f) + EPS);
  const float* ng = p.in[I_MNG] + l * 512 + h * 128;
  bf16_t* HM = (bf16_t*)(ws + W_HM);
  const size_t tok = (size_t)tok0 + irow;
#pragma unroll
  for (int jt = 0; jt < 8; jt++) {
    const int e = jt * 16 + (lane >> 4) * 4;
    float4 gv = *(const float4*)(ng + e);
    uint2 zo = *(const uint2*)(Z + tok * ZS + OFF_O + h * 128 + e);
    float o0 = (hf[jt][0] - mu) * rs * gv.x * sigm(lo16(zo.x));
    float o1 = (hf[jt][1] - mu) * rs * gv.y * sigm(hi16(zo.x));
    float o2 = (hf[jt][2] - mu) * rs * gv.z * sigm(lo16(zo.y));
    float o3 = (hf[jt][3] - mu) * rs * gv.w * sigm(hi16(zo.y));
    *(uint2*)(HM + tok * 512 + h * 128 + e) = pack4(o0, o1, o2, o3);
  }
  __syncthreads();
}

#define XB_TMO      128
#define XB_XCNT(j)  (256  + 64 * (j))
#define XB_XSUB(j)  (1280 + 64 * (j))
#define XB_XGEN(j)  (2304 + 64 * (j))
#define XB_TOP      3328
#define XB_TOPGEN   3392
#define XCD_BAR_WORDS 3456
#define XB_SPIN_CAP (1u << 22)
#define LAS __attribute__((address_space(3)))
__device__ __forceinline__ unsigned xb_ld(unsigned* p) { return __hip_atomic_load(p, __ATOMIC_RELAXED, __HIP_MEMORY_SCOPE_AGENT); }
__device__ __forceinline__ unsigned xb_add(unsigned* p, unsigned v) { return __hip_atomic_fetch_add(p, v, __ATOMIC_RELAXED, __HIP_MEMORY_SCOPE_AGENT); }
__device__ __forceinline__ unsigned xb_xcc_id() { return (unsigned)__builtin_amdgcn_s_getreg((3 << 11) | 20) & 0xFu; }
#define XB_SPIN(cond, bar) do { unsigned _sp = 0; while (cond) { __builtin_amdgcn_s_sleep(1); \
    if ((++_sp & 255u) == 0u) { if (xb_ld(&(bar)[XB_TMO])) break; if (_sp > XB_SPIN_CAP) { atomicAdd(&(bar)[XB_TMO], 1u); break; } } } } while (0)
struct XcdBarrier { unsigned* bar; unsigned x; volatile LAS unsigned* st; };
__device__ __forceinline__ XcdBarrier xcd_barrier_post(unsigned* bar, volatile LAS unsigned* st) {
  XcdBarrier b; b.bar = bar; b.x = xb_xcc_id(); b.st = st;
  if (threadIdx.x == 0) (void)xb_add(&bar[XB_XCNT(b.x)], 1u);
  return b;
}
__device__ __forceinline__ void xcd_barrier_complete(unsigned* bar, unsigned x, unsigned& nloc, unsigned& nx) {
  const unsigned G = gridDim.x * gridDim.y * gridDim.z;
  unsigned sum, cnt, mine, sp = 0u;
  for (;;) {
    sum = 0u; cnt = 0u; mine = 0u;
#pragma unroll
    for (unsigned j = 0; j < 16; ++j) { const unsigned c = xb_ld(&bar[XB_XCNT(j)]); sum += c; cnt += (c > 0u) ? 1u : 0u; mine = (j == x) ? c : mine; }
    if (sum == G) break;
    __builtin_amdgcn_s_sleep(1);
    if ((++sp & 255u) == 0u) { if (xb_ld(&bar[XB_TMO])) break; if (sp > XB_SPIN_CAP) { atomicAdd(&bar[XB_TMO], 1u); break; } }
  }
  nloc = mine > 0u ? mine : 1u; nx = cnt > 0u ? cnt : 1u;
}
__device__ __forceinline__ void xcd_barrier(const XcdBarrier& b) {
  asm volatile("s_waitcnt vmcnt(0)" ::: "memory");
  __syncthreads();
  if (threadIdx.x == 0) {
    unsigned* bar = b.bar;
    __builtin_amdgcn_s_waitcnt(0);
    unsigned nloc = b.st[0], nx = b.st[1];
    if (nloc == 0u) { xcd_barrier_complete(bar, b.x, nloc, nx); b.st[0] = nloc; b.st[1] = nx; }
    const unsigned old = xb_add(&bar[XB_XSUB(b.x)], 1u);
    const unsigned gen = old / nloc;
    if (old + 1u == (gen + 1u) * nloc) {
      __builtin_amdgcn_fence(__ATOMIC_RELEASE, "agent");
      asm volatile("s_waitcnt vmcnt(0)" ::: "memory");
      const unsigned og = xb_add(&bar[XB_TOP], 1u);
      const unsigned tg = og / nx;
      if (og + 1u == (tg + 1u) * nx) xb_add(&bar[XB_TOPGEN], 1u);
      else XB_SPIN(xb_ld(&bar[XB_TOPGEN]) == tg, bar);
      __builtin_amdgcn_fence(__ATOMIC_ACQUIRE, "agent");
      xb_add(&bar[XB_XGEN(b.x)], 1u);
      asm volatile("s_waitcnt vmcnt(0)" ::: "memory");
    } else {
      XB_SPIN(xb_ld(&bar[XB_XGEN(b.x)]) == gen, bar);
      __builtin_amdgcn_fence(__ATOMIC_ACQUIRE, "agent");
      asm volatile("s_waitcnt vmcnt(0)" ::: "memory");
    }
  }
  __syncthreads();
}

namespace pg8 {
#define PG8_LAS __attribute__((address_space(3)))
typedef unsigned short bf16_t;
typedef short bf16x8 __attribute__((ext_vector_type(8)));
typedef float f32x4 __attribute__((ext_vector_type(4)));
typedef unsigned u32x4 __attribute__((ext_vector_type(4)));
constexpr int BM = 256, BK = 64, HALF = 128, HTB = HALF * BK * 2  , STAGE_BYTES = 8 * HTB, NXCD = 8, WGM = 8;

__host__ __device__ __forceinline__ int lds_byte(int r, int c) { const int st = (r >> 4) * 2 + (c >> 5), rr = r & 15, cc = c & 31, ob = rr * 64 + cc * 2; return st * 1024 + (ob ^ (((ob >> 9) & 1) << 5)); }
__host__ __device__ __forceinline__ void stage_rc(int b, int& R, int& C) { const int st = b / 1024, sb = b % 1024, swz = sb ^ (((sb >> 9) & 1) << 5); R = (st >> 1) * 16 + swz / 64; C = (st & 1) * 32 + (swz % 64) / 2; }
__host__ __device__ __forceinline__ int perm32(int rho) { const int n = rho >> 4, i = rho & 15; return 8 * (i >> 2) + 4 * n + (i & 3); }

struct Unit { int pm, pn; };
struct Gemm { const bf16_t* A; const bf16_t* Bt; int M, N, K; };

struct StaticOrder {
    int nM, nN, nwg, G, c;
    __host__ __device__ void init(int M, int N, int G_, int c_) { nM = M / BM; nN = N / BM; nwg = nM * nN; G = G_; c = c_; }
    __host__ __device__ bool next(int i, Unit& u) const {
        const long L = (long)i * G + c; if (L >= nwg) return false;
        int wgid = (int)L; { const int q = nwg / NXCD, r = nwg % NXCD, xcd = wgid % NXCD, off = wgid / NXCD; wgid = (xcd < r ? xcd * (q + 1) : r * (q + 1) + (xcd - r) * q) + off; }
        const int nig = WGM * nN, gid = wgid / nig, fm = gid * WGM, gsz = (nM - fm) < WGM ? (nM - fm) : WGM;
        u.pm = fm + ((wgid % nig) % gsz); u.pn = (wgid % nig) / gsz; return true;
    }
    __device__ __forceinline__ void a_ready(const Unit&) const {}
    __device__ __forceinline__ void done(const Unit&) const {}
};

template <int MODE> struct EpiAct {
    static constexpr bool PERM = true, AFTER_DRAIN = false;
    bf16_t* O; int ldc; const float* bias;
    __device__ __forceinline__ unsigned pk(float lo, float hi) const {
        unsigned a = __float_as_uint(lo), b = __float_as_uint(hi);
        a += 0x7fffu + ((a >> 16) & 1u); b += 0x7fffu + ((b >> 16) & 1u);
        return (a >> 16) | (b & 0xffff0000u);
    }
    __device__ __forceinline__ float act(float v) const {
        if (MODE == 1) { v = fmaxf(v, 0.f); return v * v; }
        if (MODE == 2) return __frcp_rn(1.f + __expf(-v));
        return v;
    }
    __device__ __forceinline__ void operator()(const f32x4 (&acc)[2][2][4][2], const Unit& u, int wr, int wc, int fr, int fq) const {
        const int row0 = u.pm * BM + wr * 64 + fr, col0 = u.pn * BM + wc * 32 + 8 * fq;
        f32x4 bv[2][2];
#pragma unroll
        for (int bj = 0; bj < 2; ++bj)
#pragma unroll
            for (int n = 0; n < 2; ++n) bv[bj][n] = (MODE >= 2) ? *(const f32x4*)(bias + col0 + bj * HALF + 4 * n) : (f32x4){0.f, 0.f, 0.f, 0.f};
#pragma unroll
        for (int ai = 0; ai < 2; ++ai)
#pragma unroll
            for (int m = 0; m < 4; ++m) { bf16_t* rowp = O + (size_t)(row0 + ai * HALF + m * 16) * ldc + col0;
#pragma unroll
                for (int bj = 0; bj < 2; ++bj) { const f32x4 v0 = acc[ai][bj][m][0] + bv[bj][0], v1 = acc[ai][bj][m][1] + bv[bj][1];
                    u32x4 w; w.x = pk(act(v0[0]), act(v0[1])); w.y = pk(act(v0[2]), act(v0[3])); w.z = pk(act(v1[0]), act(v1[1])); w.w = pk(act(v1[2]), act(v1[3]));
                    *(u32x4*)(rowp + bj * HALF) = w; } }
    }
};

template <class Epi, class Sched, bool STAMP = false>
__device__ __forceinline__ void gemm_phase(PG8_LAS unsigned char* lds, const Gemm g, const Sched& S, const Epi& E, unsigned long long* stamps) {
    const int tid = tidx(), wid = __builtin_amdgcn_readfirstlane(tid >> 6), lane = tid & 63, wr = wid >> 2, wc = wid & 3, fr = lane & 15, fq = lane >> 4;
    const int K = g.K, nt = K / BK;
    int ts_lo = 0, ts_hi = 0, nts = 0; const unsigned long long rt_entry = STAMP ? (unsigned long long)wall_clock64() : 0ull;
#define PG8_STAMP() do { if (STAMP && wid == 0 && nts < 64) { const unsigned long long _c = (unsigned long long)clock64(); \
        ts_lo = (lane == nts) ? (int)(unsigned)_c : ts_lo; ts_hi = (lane == nts) ? (int)(unsigned)(_c >> 32) : ts_hi; ++nts; } } while (0)
    PG8_STAMP();
    unsigned voffA[2], voffB[2];
#pragma unroll
    for (int i = 0; i < 2; ++i) { int R, C; stage_rc(tid * 16 + i * 8192, R, C); const int Rb = Epi::PERM ? ((R & ~31) + perm32(R & 31)) : R;
        voffA[i] = (unsigned)(R * K + C) * 2u; voffB[i] = (unsigned)(Rb * K + C) * 2u; }
    const size_t kstep = (size_t)(BK * 2);
    const size_t hstep = (size_t)HALF * K * 2;
    const size_t tstep = 2 * hstep;
    const unsigned ldsw = (unsigned)wid * 1024u;
    const int aoff = lds_byte(wr * 64 + fr, fq * 8), boff = lds_byte(wc * 32 + fr, fq * 8);
#define PG8_SA(b, h) (((b) * 2 + (h)) * HTB)
#define PG8_SB(b, h) ((4 + (b) * 2 + (h)) * HTB)
#define PG8_STAGE(bufoff, gbase, voff) do { _Pragma("unroll") for (int _i = 0; _i < 2; ++_i) \
        __builtin_amdgcn_global_load_lds((const unsigned*)((const char*)(gbase) + (voff)[_i]), (PG8_LAS unsigned*)(lds + (bufoff) + ldsw + _i * 8192), 16, 0, 0); } while (0)
#define PG8_LDA(dst, b, h) do { _Pragma("unroll") for (int m = 0; m < 4; ++m) _Pragma("unroll") for (int k = 0; k < 2; ++k) dst[m][k] = *(const PG8_LAS bf16x8*)(lds + PG8_SA(b, h) + aoff + m * 2048 + k * 1024); } while (0)
#define PG8_LDB(dst, b, h) do { _Pragma("unroll") for (int n = 0; n < 2; ++n) _Pragma("unroll") for (int k = 0; k < 2; ++k) dst[n][k] = *(const PG8_LAS bf16x8*)(lds + PG8_SB(b, h) + boff + n * 2048 + k * 1024); } while (0)
#define PG8_MMA(ai, bj, At, Bt) do { __builtin_amdgcn_s_setprio(1); _Pragma("unroll") for (int m = 0; m < 4; ++m) _Pragma("unroll") for (int n = 0; n < 2; ++n) _Pragma("unroll") for (int k = 0; k < 2; ++k) \
        acc[ai][bj][m][n] = __builtin_amdgcn_mfma_f32_16x16x32_bf16(Bt[n][k], At[m][k], acc[ai][bj][m][n], 0, 0, 0); __builtin_amdgcn_s_setprio(0); } while (0)
#define PG8_WAIT_V(n) asm volatile("s_waitcnt vmcnt(" #n ")" ::: "memory")
#define PG8_WAIT_L(n) asm volatile("s_waitcnt lgkmcnt(" #n ")" ::: "memory")
#define PG8_BAR __builtin_amdgcn_s_barrier()
#define PG8_SCHED __builtin_amdgcn_sched_barrier(0)
    Unit cur, nxt; int ui = 0;
    if (!S.next(0, cur)) return;
    f32x4 acc[2][2][4][2];
#pragma unroll
    for (int a = 0; a < 2; ++a)
#pragma unroll
        for (int b = 0; b < 2; ++b)
#pragma unroll
            for (int m = 0; m < 4; ++m)
#pragma unroll
                for (int n = 0; n < 2; ++n) acc[a][b][m][n] = (f32x4){0.f, 0.f, 0.f, 0.f};
    bf16x8 At[4][2], B0[2][2], B1[2][2];
    const char* cA = (const char*)g.A + (size_t)cur.pm * tstep; const char* cB = (const char*)g.Bt + (size_t)cur.pn * tstep;
    S.a_ready(cur);
    PG8_STAGE(PG8_SB(0, 0), cB, voffB); PG8_STAGE(PG8_SA(0, 0), cA, voffA); PG8_STAGE(PG8_SB(0, 1), cB + hstep, voffB); PG8_STAGE(PG8_SA(0, 1), cA + hstep, voffA);
    if (wr == 1) PG8_BAR;
    PG8_WAIT_V(4); PG8_BAR;
    PG8_STAGE(PG8_SB(1, 0), cB + kstep, voffB); PG8_STAGE(PG8_SA(1, 0), cA + kstep, voffA); PG8_STAGE(PG8_SB(1, 1), cB + hstep + kstep, voffB);
    PG8_WAIT_V(6); PG8_BAR;
    PG8_STAMP();
    for (;;) {
        const bool has_next = S.next(ui + 1, nxt);
        const char* nA = has_next ? (const char*)g.A + (size_t)nxt.pm * tstep : cA; const char* nB = has_next ? (const char*)g.Bt + (size_t)nxt.pn * tstep : cB;
        for (int t = 0; t < nt; t += 2) {
            const bool last = (t == nt - 2);
            const char* a1 = cA + (size_t)(t + 1) * kstep;
            const char* a2 = last ? nA : cA + (size_t)(t + 2) * kstep; const char* b2 = last ? nB : cB + (size_t)(t + 2) * kstep;
            const char* a3 = a2 + kstep; const char* b3 = b2 + kstep;
            if (last && has_next) S.a_ready(nxt);
            PG8_LDB(B0, 0, 0); PG8_SCHED; PG8_LDA(At, 0, 0); PG8_STAGE(PG8_SA(1, 1), a1 + hstep, voffA);
            PG8_WAIT_L(8); PG8_BAR; PG8_WAIT_L(0); PG8_MMA(0, 0, At, B0); PG8_BAR; PG8_SCHED;
            PG8_LDB(B1, 0, 1); PG8_STAGE(PG8_SB(0, 0), b2, voffB);
            PG8_BAR; PG8_WAIT_L(0); PG8_MMA(0, 1, At, B1); PG8_BAR;
            PG8_LDA(At, 0, 1); PG8_STAGE(PG8_SA(0, 0), a2, voffA);
            PG8_BAR; PG8_WAIT_L(0); PG8_MMA(1, 0, At, B0); PG8_BAR; PG8_SCHED;
            PG8_STAGE(PG8_SB(0, 1), b2 + hstep, voffB);
            PG8_WAIT_V(6); PG8_BAR; PG8_MMA(1, 1, At, B1); PG8_BAR;
            PG8_LDB(B0, 1, 0); PG8_SCHED; PG8_LDA(At, 1, 0); PG8_STAGE(PG8_SA(0, 1), a2 + hstep, voffA);
            PG8_WAIT_L(8); PG8_BAR; PG8_WAIT_L(0); PG8_MMA(0, 0, At, B0); PG8_BAR; PG8_SCHED;
            PG8_LDB(B1, 1, 1); PG8_STAGE(PG8_SB(1, 0), b3, voffB);
            PG8_BAR; PG8_WAIT_L(0); PG8_MMA(0, 1, At, B1); PG8_BAR;
            PG8_LDA(At, 1, 1); PG8_STAGE(PG8_SA(1, 0), a3, voffA);
            PG8_BAR; PG8_WAIT_L(0); PG8_MMA(1, 0, At, B0); PG8_BAR; PG8_SCHED;
            PG8_STAGE(PG8_SB(1, 1), b3 + hstep, voffB);
            PG8_WAIT_V(6); PG8_BAR; PG8_MMA(1, 1, At, B1); PG8_BAR;
        }
        PG8_STAMP();
        if constexpr (!Epi::AFTER_DRAIN) { E(acc, cur, wr, wc, fr, fq); S.done(cur); }
        PG8_STAMP();
        if (!has_next) break;
#pragma unroll
        for (int a = 0; a < 2; ++a)
#pragma unroll
            for (int b = 0; b < 2; ++b)
#pragma unroll
                for (int m = 0; m < 4; ++m)
#pragma unroll
                    for (int n = 0; n < 2; ++n) acc[a][b][m][n] = (f32x4){0.f, 0.f, 0.f, 0.f};
        cur = nxt; cA = nA; cB = nB; ++ui;
    }
    PG8_WAIT_V(0);
    if (wr == 0) PG8_BAR;
    PG8_BAR;
    if constexpr (Epi::AFTER_DRAIN) { E.fused(acc, cur, wr, wc, fr, fq, lds, wid, lane); S.done(cur); }
    PG8_STAMP();
    if (STAMP && wid == 0) { stamps[lane] = lane < nts ? (((unsigned long long)(unsigned)ts_hi << 32) | (unsigned)ts_lo) : 0ull;
        if (lane == 62) stamps[62] = rt_entry; if (lane == 63) stamps[63] = (unsigned long long)wall_clock64(); }
#undef PG8_STAMP
#undef PG8_SA
#undef PG8_SB
#undef PG8_STAGE
#undef PG8_LDA
#undef PG8_LDB
#undef PG8_MMA
#undef PG8_WAIT_V
#undef PG8_WAIT_L
#undef PG8_BAR
#undef PG8_SCHED
}
}

#ifndef ONLY_PH
#define ONLY_PH -1
#endif
#define PHEN(x) (ONLY_PH < 0 || ONLY_PH == (x))
constexpr int NPL = 11;
constexpr int NPH = 2 * NPL + 1;

__device__ __forceinline__ void run_phase(const Params& p, int ph, char* smem) {
  const int l = ph / NPL, q = ph % NPL;
  const int bid = blockIdx.x, nb = gridDim.x;
  char* ws = p.ws;
  if (PHEN(11) && ph == NPH - 1) {
    for (int it = bid; it < 2048; it += nb) rms_item(p, 2, 1, it);
    return;
  }
  switch (q) {
    case 0: if (!PHEN(0)) break; {
      const int n_tab = (l == 0) ? 32 : 0;
      const int n_kt = (l == 0) ? 256 : 0;
      const int total = n_kt + n_tab + N_TR + 2048;
      for (int it = bid; it < total; it += nb) {
        int i = it;
        if (i < n_kt) { s5_kt(p, i, smem); continue; }
        i -= n_kt;
        if (i < n_tab) { gen_tables(p, i); continue; }
        i -= n_tab;
        if (i < N_TR) { transpose_item(p, l, i, smem); continue; }
        i -= N_TR;
        if (l == 0) rms_item(p, 0, 0, i); else rms_item(p, 2, l - 1, i);
      }
    } break;
    case 1: if (!PHEN(1)) break;
      {
        const float* bin = p.in[I_BIN] + l * NIN;
        {
          pg8::Gemm g{(const pg8::bf16_t*)(ws + W_HBF), (const pg8::bf16_t*)(ws + W_WIN), TOK, 2048, 1024};
          pg8::StaticOrder S; S.init(TOK, 2048, (int)gridDim.x, (int)blockIdx.x);
          pg8::EpiAct<3> E{(pg8::bf16_t*)(ws + W_Z), ZS, bin};
          pg8::gemm_phase<pg8::EpiAct<3>, pg8::StaticOrder, false>((PG8_LAS unsigned char*)smem, g, S, E, nullptr);
        }
        {
          pg8::Gemm g{(const pg8::bf16_t*)(ws + W_HBF), (const pg8::bf16_t*)(ws + W_WIN) + (size_t)2064 * 1024, TOK, 512, 1024};
          pg8::StaticOrder S; S.init(TOK, 512, (int)gridDim.x, (int)blockIdx.x);
          pg8::EpiAct<3> E{(pg8::bf16_t*)(ws + W_Z) + 2048, ZS, bin + 2064};
          pg8::gemm_phase<pg8::EpiAct<3>, pg8::StaticOrder, false>((PG8_LAS unsigned char*)smem, g, S, E, nullptr);
        }
        const int hb = nb / 2;
        if (bid >= hb) {
          for (int it = bid - hb; it < 64 + 128; it += nb - hb) {
            if (it < 64) ingate_item(p, l, it, smem);
            else s5_fill(p, l, it - 64, smem);
          }
        }
      }
      break;
    case 2: if (!PHEN(2)) break;
      for (int it = bid; it < 512 + 128 + 512; it += nb) {
        if (it < 512) mlstm_local(p, l, it, smem);
        else if (it < 640) s5_e(p, it - 512, smem);
        else four_g1(p, it - 640, smem);
      }
      break;
    case 3: if (!PHEN(3)) break;
      for (int it = bid; it < 8 + 132 + 512; it += nb) {
        if (it < 8) s5_carry(p, it);
        else if (it < 140) mlstm_scan(p, it - 8);
        else four_g2(p, it - 140, smem);
      }
      break;
    case 4: if (!PHEN(4)) break;
      for (int it = bid; it < 512 + 256 + 512; it += nb) {
        if (it < 512) mlstm_out(p, l, it, smem);
        else if (it < 768) s5_tg(p, it - 512, smem);
        else four_g3(p, it - 768, smem);
      }
      break;
    case 5: if (!PHEN(5)) break;
      {
        pg8::Gemm g{(const pg8::bf16_t*)(ws + W_HBF), (const pg8::bf16_t*)(ws + W_WIN) + (size_t)OFF_GATE * 1024, TOK, 3072, 1024};
        pg8::StaticOrder S; S.init(TOK, 3072, (int)gridDim.x, (int)blockIdx.x);
        pg8::EpiAct<2> E{(pg8::bf16_t*)(ws + W_GATE), 3072, p.in[I_BIN] + l * NIN + OFF_GATE};
        pg8::gemm_phase<pg8::EpiAct<2>, pg8::StaticOrder, false>((PG8_LAS unsigned char*)smem, g, S, E, nullptr);
      }
      break;
    case 6: if (!PHEN(6)) break;
      for (int it = bid; it < 512; it += nb) mergelite_item(p, l, it, smem);
      break;
    case 7: if (!PHEN(7)) break;
      {
        pg8::Gemm g{(const pg8::bf16_t*)(ws + W_MIX), (const pg8::bf16_t*)(ws + W_WOUT), TOK, 1024, 1024};
        pg8::StaticOrder S; S.init(TOK, 1024, (int)gridDim.x, (int)blockIdx.x);
        pg8::EpiAct<0> E{(pg8::bf16_t*)(ws + W_O), 1024, nullptr};
        pg8::gemm_phase<pg8::EpiAct<0>, pg8::StaticOrder, false>((PG8_LAS unsigned char*)smem, g, S, E, nullptr);
      }
      break;
    case 8: if (!PHEN(8)) break;
      for (int it = bid; it < 2048; it += nb) rms_item(p, 1, l, it);
      break;
    case 9: if (!PHEN(9)) break;
      {
        pg8::Gemm g{(const pg8::bf16_t*)(ws + W_HBF), (const pg8::bf16_t*)(ws + W_W1), TOK, 4096, 1024};
        pg8::StaticOrder S; S.init(TOK, 4096, (int)gridDim.x, (int)blockIdx.x);
        pg8::EpiAct<1> E{(pg8::bf16_t*)(ws + W_HID), 4096, nullptr};
        pg8::gemm_phase<pg8::EpiAct<1>, pg8::StaticOrder, false>((PG8_LAS unsigned char*)smem, g, S, E, nullptr);
      }
      break;
    case 10: if (!PHEN(10)) break;
      {
        pg8::Gemm g{(const pg8::bf16_t*)(ws + W_HID), (const pg8::bf16_t*)(ws + W_W2), TOK, 1024, 4096};
        pg8::StaticOrder S; S.init(TOK, 1024, (int)gridDim.x, (int)blockIdx.x);
        pg8::EpiAct<0> E{(pg8::bf16_t*)(ws + W_FO), 1024, nullptr};
        pg8::gemm_phase<pg8::EpiAct<0>, pg8::StaticOrder, false>((PG8_LAS unsigned char*)smem, g, S, E, nullptr);
      }
      break;
  }
}

__global__ void __launch_bounds__(NT) k_main(Params p, int ph_lo, int ph_hi) {
  extern __shared__ __attribute__((aligned(16))) char smem[];
#if COOP
  cg::grid_group grid = cg::this_grid();
  volatile LAS unsigned* st = (volatile LAS unsigned*)(smem + SMEM_BYTES - 16);
  if (threadIdx.x == 0) { st[0] = 0u; st[1] = 0u; }
  if (blockIdx.x == 0) { for (int i = threadIdx.x; i < 4096; i += NT) ((unsigned*)(p.ws + W_BAR))[i] = 0u; }
  __syncthreads();
  XcdBarrier xb; xb.bar = (unsigned*)(p.ws + W_BAR); xb.x = 0; xb.st = st;
#endif
#if PROBE_PH >= 0
  long long t0 = 0, t1 = 0;
#endif
  for (int ph = ph_lo; ph < ph_hi; ph++) {
#if PROBE_PH >= 0
    if (ph == PROBE_PH) t0 = wall_clock64();
    if (ph == PROBE_PH + PROBE_N) t1 = wall_clock64();
#endif
    run_phase(p, ph, smem);
#if COOP
    if (ph + 1 < ph_hi) {
      if (ph == ph_lo) { grid.sync(); xb = xcd_barrier_post((unsigned*)(p.ws + W_BAR), st); }
      else xcd_barrier(xb);
    }
#endif
  }
#if PROBE_PH >= 0
  xcd_barrier(xb);
  if (blockIdx.x == 0 && threadIdx.x == 0) { float us = (float)(t1 - t0) * 0.01f; p.out[0] += 0.1f + us * (1.f / PROBE_SCALE); }
#endif
}

extern "C" void kernel_launch(void* const* d_in, const int* in_sizes, int n_in, void* d_out, int out_size, void* d_ws, size_t ws_size,
                              hipStream_t stream) {
  static int grid = 0;
  if (grid == 0) {
    if (n_in != 25 || ws_size < W_END) { fprintf(stderr, "kernel_launch: bad inputs n_in=%d ws=%zu need %zu\n", n_in, ws_size, (size_t)W_END); grid = -1; return; }
    if (hipFuncSetAttribute((const void*)k_main, hipFuncAttributeMaxDynamicSharedMemorySize, SMEM_BYTES) != hipSuccess) { fprintf(stderr, "hipFuncSetAttribute failed\n"); grid = -1; return; }
    int dev = 0, cus = 0, per_cu = 0;
    hipGetDevice(&dev);
    hipDeviceGetAttribute(&cus, hipDeviceAttributeMultiprocessorCount, dev);
    hipOccupancyMaxActiveBlocksPerMultiprocessor(&per_cu, (const void*)k_main, NT, SMEM_BYTES);
    if (per_cu < 1) { fprintf(stderr, "occupancy query says 0 blocks/CU\n"); grid = -1; return; }
    grid = cus;
  }
  if (grid < 0) return;
  Params p{};
  for (int i = 0; i < 25; i++) p.in[i] = (const float*)d_in[i];
  p.out = (float*)d_out;
  p.ws = (char*)d_ws;
#if COOP
  int lo = 0, hi = NPH;
  void* args[] = {&p, &lo, &hi};
  hipError_t e = hipLaunchCooperativeKernel((const void*)k_main, dim3(grid), dim3(NT), args, SMEM_BYTES, stream);
  if (e != hipSuccess) fprintf(stderr, "cooperative launch failed: %s\n", hipGetErrorString(e));
#else
  for (int ph = 0; ph < NPH; ph++) hipLaunchKernelGGL(k_main, dim3(grid), dim3(NT), SMEM_BYTES, stream, p, ph, ph + 1);
#endif
}
```

```cpp
#include <hip/hip_runtime.h>
#include <hip/hip_cooperative_groups.h>
#include <stdint.h>
#include <stdio.h>
#include <math.h>
namespace cg = cooperative_groups;

#ifndef REP_MASK
#define REP_MASK 0
#endif
#ifndef PROBE_PH
#define PROBE_PH -1
#endif
#ifndef PROBE_N
#define PROBE_N 1
#endif
#ifndef PROBE_SCALE
#define PROBE_SCALE 1000.f
#endif
#ifndef COOP
#define COOP 1
#endif

typedef unsigned short bf16_t;
typedef __attribute__((ext_vector_type(8))) short bf16x8;
typedef __attribute__((ext_vector_type(4))) float f32x4;

#define NT 512
constexpr int SEQ = 8192, TOK = 16384, DM = 1024, NIN = 5648, ZS = 2560, DFF = 4096;
constexpr int OFF_K = 512, OFF_V = 1024, OFF_O = 1536, OFF_IG = 2048  , OFF_F = 2048, OFF_S = 2304  , OFF_GATE = 2576  ;
constexpr float EPS = 1e-6f;

enum { I_X = 0, I_GMPRE, I_GMPOST, I_GFPRE, I_GFPOST, I_WIN, I_BIN, I_CW, I_CB, I_MNG, I_WUPM, I_WUPF, I_LRE, I_LIM, I_LDT,
       I_BRE, I_BIM, I_CRE, I_CIM, I_SD, I_WGLU, I_BGLU, I_WOUT, I_W1, I_W2 };

constexpr size_t W_WIN = 0;
constexpr size_t W_WUPM = W_WIN + (size_t)NIN * 1024 * 2;
constexpr size_t W_WUPF = W_WUPM + 1024 * 512 * 2;
constexpr size_t W_WGLU = W_WUPF + 1024 * 256 * 2;
constexpr size_t W_WOUT = W_WGLU + 2048 * 256 * 2;
constexpr size_t W_W1 = W_WOUT + 1024 * 1024 * 2;
constexpr size_t W_W2 = W_W1 + 4096 * 1024 * 2;
constexpr size_t W_ET = W_W2 + 4096 * 1024 * 2;
constexpr size_t W_TG = W_ET + 16 * 256 * 512 * 2;
constexpr size_t W_F1T = W_TG + 16 * 512 * 768 * 2;
constexpr size_t W_F2T = W_F1T + 128 * 64 * 2;
constexpr size_t W_F3T = W_F2T + 256 * 256 * 2;
constexpr size_t W_TW = W_F3T + 64 * 128 * 2;
constexpr size_t W_LPOW = W_TW + 64 * 128 * 2 * 4;
constexpr size_t W_ZERO = W_LPOW + 2 * 16 * 64 * 2 * 4;
constexpr size_t W_AMAX = W_ZERO + 256;
constexpr size_t W_G = W_AMAX + 4096;
constexpr size_t W_MPREV = W_G + 4096;
constexpr size_t W_NST = W_MPREV + 4096;
constexpr size_t W_ZG = W_NST + 16 * 64 * 128 * 4;
constexpr size_t W_HBF = W_ZG + (size_t)TOK * 16 * 4;
constexpr size_t W_Z = W_HBF + (size_t)TOK * 1024 * 2;
constexpr size_t W_CST = W_Z + (size_t)TOK * ZS * 2;
constexpr size_t W_U1T = W_CST + (size_t)16 * 64 * 16384 * 2;
constexpr size_t W_A2T = W_U1T + (size_t)TOK * 512 * 2;
constexpr size_t W_YF = W_A2T + (size_t)TOK * 512 * 2;
constexpr size_t W_YS = W_YF + (size_t)TOK * 256 * 2;
constexpr size_t W_XEND = W_YS + (size_t)TOK * 256 * 2;
constexpr size_t W_XCAR = W_XEND + (size_t)512 * 16 * 256 * 2;
constexpr size_t W_BAR = W_XCAR + (size_t)512 * 16 * 256 * 2;
constexpr size_t W_KTG = W_BAR + 16384;
constexpr size_t W_END = W_KTG + (size_t)2 * 16 * 16384 * 4;
constexpr size_t W_HM = W_U1T;
constexpr size_t W_MIX = W_HBF;
constexpr size_t W_GATE = W_Z;
constexpr size_t W_O = W_Z + (size_t)TOK * 1024 * 2;
constexpr size_t W_HID = W_Z;
constexpr size_t W_FO = W_A2T;
static_assert(W_U1T + (size_t)TOK * 512 * 2 - W_Z >= (size_t)TOK * 4096 * 2, "hid alias");
static_assert(W_U1T - W_Z >= (size_t)TOK * 3072 * 2, "gate alias");

constexpr int SMEM_BYTES = 153600 + 16;

struct Params { const float* in[25]; float* out; char* ws; };

__device__ __forceinline__ int tidx() { int t = threadIdx.x; asm volatile("" : "+v"(t)); return t; }
__device__ __forceinline__ bf16_t f2bf(float f) {
  uint32_t u = __float_as_uint(f);
  u += 0x7fffu + ((u >> 16) & 1u);
  return (bf16_t)(u >> 16);
}
__device__ __forceinline__ float bf2f(bf16_t h) { return __uint_as_float(((uint32_t)h) << 16); }
__device__ __forceinline__ uint32_t pack2(float a, float b) { return (uint32_t)f2bf(a) | ((uint32_t)f2bf(b) << 16); }
__device__ __forceinline__ uint2 pack4(float a, float b, float c, float d) { uint2 r; r.x = pack2(a, b); r.y = pack2(c, d); return r; }
__device__ __forceinline__ float lo16(uint32_t u) { return __uint_as_float(u << 16); }
__device__ __forceinline__ float hi16(uint32_t u) { return __uint_as_float(u & 0xffff0000u); }
__device__ __forceinline__ float sigm(float x) { return __frcp_rn(1.f + __expf(-x)); }
__device__ __forceinline__ float logsig(float x) { return fminf(x, 0.f) - log1pf(expf(-fabsf(x))); }
__device__ __forceinline__ float gelu_tanh(float x) { float u = 0.7978845608028654f * (x + 0.044715f * x * x * x); return 0.5f * x * (1.f + tanhf(u)); }
__device__ __forceinline__ float wave_sum(float v) {
#pragma unroll
  for (int o = 32; o >= 1; o >>= 1) v += __shfl_xor(v, o);
  return v;
}
__device__ __forceinline__ float wave_max(float v) {
#pragma unroll
  for (int o = 32; o >= 1; o >>= 1) v = fmaxf(v, __shfl_xor(v, o));
  return v;
}
__device__ __forceinline__ float wave_incl_sum(float v, int lane) {
#pragma unroll
  for (int o = 1; o < 64; o <<= 1) { float t = __shfl_up(v, o); if (lane >= o) v += t; }
  return v;
}
__device__ __forceinline__ float wave_incl_max(float v, int lane) {
#pragma unroll
  for (int o = 1; o < 64; o <<= 1) { float t = __shfl_up(v, o); if (lane >= o) v = fmaxf(v, t); }
  return v;
}
__device__ __forceinline__ f32x4 mfma16(bf16x8 a, bf16x8 b, f32x4 c) { return __builtin_amdgcn_mfma_f32_16x16x32_bf16(a, b, c, 0, 0, 0); }

constexpr int BK = 64, LDK = 64;
template <int BM, int BN, int WM, int WN, bool SWAP, class AF, class BF>
__device__ __forceinline__ void gemm_acc(int K, AF aptr, BF bptr, char* smem, f32x4 (&acc)[BM / WM / 16][BN / WN / 16]) {
  constexpr int TM = BM / WM / 16, TN = BN / WN / 16;
  constexpr int CA = BM * 8 / NT, CB = BN * 8 / NT;
  static_assert(CA >= 1 && CB >= 1, "tile too small");
  bf16_t* As = (bf16_t*)smem;
  bf16_t* Bs = As + 2 * BM * LDK;
  const int tid = tidx(), lane = tid & 63, w = tid >> 6;
  const int mb = (w / WN) * (BM / WM), nb = (w % WN) * (BN / WN);
  const int r16 = lane & 15, fx = (r16 >> 1) & 7;
  uint4 ra0, ra1, ra2, ra3, rb0, rb1, rb2, rb3;
  ra0 = ra1 = ra2 = ra3 = rb0 = rb1 = rb2 = rb3 = make_uint4(0, 0, 0, 0);
  static_assert(CA <= 4 && CB <= 4, "chunks");
#define GLOAD(K0)                                                                                         \
  {                                                                                                       \
    { int c = tid; ra0 = *(const uint4*)aptr(c >> 3, (K0) + (c & 7) * 8); }                               \
    if (CA > 1) { int c = tid + NT; ra1 = *(const uint4*)aptr(c >> 3, (K0) + (c & 7) * 8); }              \
    if (CA > 2) { int c = tid + 2 * NT; ra2 = *(const uint4*)aptr(c >> 3, (K0) + (c & 7) * 8); }          \
    if (CA > 3) { int c = tid + 3 * NT; ra3 = *(const uint4*)aptr(c >> 3, (K0) + (c & 7) * 8); }          \
    { int c = tid; rb0 = *(const uint4*)bptr(c >> 3, (K0) + (c & 7) * 8); }                               \
    if (CB > 1) { int c = tid + NT; rb1 = *(const uint4*)bptr(c >> 3, (K0) + (c & 7) * 8); }              \
    if (CB > 2) { int c = tid + 2 * NT; rb2 = *(const uint4*)bptr(c >> 3, (K0) + (c & 7) * 8); }          \
    if (CB > 3) { int c = tid + 3 * NT; rb3 = *(const uint4*)bptr(c >> 3, (K0) + (c & 7) * 8); }          \
  }
#define SSTORE(AP, BP)                                                                                    \
  {                                                                                                       \
    { int c = tid; *(uint4*)&(AP)[(c >> 3) * LDK + (((c & 7) ^ ((c >> 4) & 7)) << 3)] = ra0; }                                  \
    if (CA > 1) { int c = tid + NT; *(uint4*)&(AP)[(c >> 3) * LDK + (((c & 7) ^ ((c >> 4) & 7)) << 3)] = ra1; }                 \
    if (CA > 2) { int c = tid + 2 * NT; *(uint4*)&(AP)[(c >> 3) * LDK + (((c & 7) ^ ((c >> 4) & 7)) << 3)] = ra2; }             \
    if (CA > 3) { int c = tid + 3 * NT; *(uint4*)&(AP)[(c >> 3) * LDK + (((c & 7) ^ ((c >> 4) & 7)) << 3)] = ra3; }             \
    { int c = tid; *(uint4*)&(BP)[(c >> 3) * LDK + (((c & 7) ^ ((c >> 4) & 7)) << 3)] = rb0; }                                  \
    if (CB > 1) { int c = tid + NT; *(uint4*)&(BP)[(c >> 3) * LDK + (((c & 7) ^ ((c >> 4) & 7)) << 3)] = rb1; }                 \
    if (CB > 2) { int c = tid + 2 * NT; *(uint4*)&(BP)[(c >> 3) * LDK + (((c & 7) ^ ((c >> 4) & 7)) << 3)] = rb2; }             \
    if (CB > 3) { int c = tid + 3 * NT; *(uint4*)&(BP)[(c >> 3) * LDK + (((c & 7) ^ ((c >> 4) & 7)) << 3)] = rb3; }             \
  }
  GLOAD(0);
  SSTORE(As, Bs);
  const int nk = K / BK;
  if (nk > 1) { GLOAD(BK); }
  __syncthreads();
#pragma unroll 1
  for (int kt = 0; kt < nk; kt++) {
    const int buf = kt & 1;
    if (kt + 1 < nk) {
      bf16_t* An = As + (buf ^ 1) * BM * LDK;
      bf16_t* Bn = Bs + (buf ^ 1) * BN * LDK;
      SSTORE(An, Bn);
      if (kt + 2 < nk) { GLOAD((kt + 2) * BK); }
    }
    const bf16_t* Ab = As + buf * BM * LDK;
    const bf16_t* Bb = Bs + buf * BN * LDK;
#pragma unroll
    for (int kk = 0; kk < 2; kk++) {
      bf16x8 af[TM], bfr[TN];
#pragma unroll
      for (int i = 0; i < TM; i++) af[i] = *(const bf16x8*)&Ab[(mb + i * 16 + r16) * LDK + (((kk * 4 + (lane >> 4)) ^ fx) << 3)];
#pragma unroll
      for (int j = 0; j < TN; j++) bfr[j] = *(const bf16x8*)&Bb[(nb + j * 16 + r16) * LDK + (((kk * 4 + (lane >> 4)) ^ fx) << 3)];
      __builtin_amdgcn_s_setprio(1);
#pragma unroll
      for (int i = 0; i < TM; i++)
#pragma unroll
        for (int j = 0; j < TN; j++) acc[i][j] = SWAP ? mfma16(bfr[j], af[i], acc[i][j]) : mfma16(af[i], bfr[j], acc[i][j]);
      __builtin_amdgcn_s_setprio(0);
    }
    __syncthreads();
  }
#undef GLOAD
#undef SSTORE
}

struct Stage { uint4 a0, a1, a2, a3, b0, b1, b2, b3; };
template <int BM, int BN, int WM, int WN, bool SWAP, class AF, class BF, class NAF, class NBF>
__device__ __forceinline__ void gemm_chain(int K, AF aptr, BF bptr, bool preloaded, bool has_next, NAF naptr, NBF nbptr, Stage& st, char* smem,
                                           f32x4 (&acc)[BM / WM / 16][BN / WN / 16]) {
  constexpr int TM = BM / WM / 16, TN = BN / WN / 16;
  constexpr int CA = BM * 8 / NT, CB = BN * 8 / NT;
  static_assert(CA >= 1 && CB >= 1 && CA <= 4 && CB <= 4, "chunks");
  bf16_t* As = (bf16_t*)smem;
  bf16_t* Bs = As + 2 * BM * LDK;
  const int tid = tidx(), lane = tid & 63, w = tid >> 6;
  const int mb = (w / WN) * (BM / WM), nb = (w % WN) * (BN / WN);
  const int r16 = lane & 15, fx = (r16 >> 1) & 7;
#define GLOADF(AP_, BP_, K0)                                                                              \
  {                                                                                                       \
    { int c = tid; st.a0 = *(const uint4*)AP_(c >> 3, (K0) + (c & 7) * 8); }                              \
    if (CA > 1) { int c = tid + NT; st.a1 = *(const uint4*)AP_(c >> 3, (K0) + (c & 7) * 8); }             \
    if (CA > 2) { int c = tid + 2 * NT; st.a2 = *(const uint4*)AP_(c >> 3, (K0) + (c & 7) * 8); }         \
    if (CA > 3) { int c = tid + 3 * NT; st.a3 = *(const uint4*)AP_(c >> 3, (K0) + (c & 7) * 8); }         \
    { int c = tid; st.b0 = *(const uint4*)BP_(c >> 3, (K0) + (c & 7) * 8); }                              \
    if (CB > 1) { int c = tid + NT; st.b1 = *(const uint4*)BP_(c >> 3, (K0) + (c & 7) * 8); }             \
    if (CB > 2) { int c = tid + 2 * NT; st.b2 = *(const uint4*)BP_(c >> 3, (K0) + (c & 7) * 8); }         \
    if (CB > 3) { int c = tid + 3 * NT; st.b3 = *(const uint4*)BP_(c >> 3, (K0) + (c & 7) * 8); }         \
  }
#define SOFFC(c) (((c) >> 3) * LDK + ((((c) & 7) ^ (((c) >> 4) & 7)) << 3))
#define SSTOREC(AP, BP)                                                                                   \
  {                                                                                                       \
    *(uint4*)&(AP)[SOFFC(tid)] = st.a0;                                                                   \
    if (CA > 1) *(uint4*)&(AP)[SOFFC(tid + NT)] = st.a1;                                                  \
    if (CA > 2) *(uint4*)&(AP)[SOFFC(tid + 2 * NT)] = st.a2;                                              \
    if (CA > 3) *(uint4*)&(AP)[SOFFC(tid + 3 * NT)] = st.a3;                                              \
    *(uint4*)&(BP)[SOFFC(tid)] = st.b0;                                                                   \
    if (CB > 1) *(uint4*)&(BP)[SOFFC(tid + NT)] = st.b1;                                                  \
    if (CB > 2) *(uint4*)&(BP)[SOFFC(tid + 2 * NT)] = st.b2;                                              \
    if (CB > 3) *(uint4*)&(BP)[SOFFC(tid + 3 * NT)] = st.b3;                                              \
  }
  const int nk = K / BK;
  if (!preloaded) { GLOADF(aptr, bptr, 0); }
  SSTOREC(As, Bs);
  GLOADF(aptr, bptr, BK);
  __syncthreads();
#pragma unroll 1
  for (int kt = 0; kt < nk; kt++) {
    const int buf = kt & 1;
    if (kt + 1 < nk) {
      bf16_t* An = As + (buf ^ 1) * BM * LDK;
      bf16_t* Bn = Bs + (buf ^ 1) * BN * LDK;
      SSTOREC(An, Bn);
      if (kt + 2 < nk) { GLOADF(aptr, bptr, (kt + 2) * BK); }
      else if (has_next) { GLOADF(naptr, nbptr, 0); }
    }
    const bf16_t* Ab = As + buf * BM * LDK;
    const bf16_t* Bb = Bs + buf * BN * LDK;
#pragma unroll
    for (int kk = 0; kk < 2; kk++) {
      bf16x8 af[TM], bfr[TN];
#pragma unroll
      for (int i = 0; i < TM; i++) af[i] = *(const bf16x8*)&Ab[(mb + i * 16 + r16) * LDK + (((kk * 4 + (lane >> 4)) ^ fx) << 3)];
#pragma unroll
      for (int j = 0; j < TN; j++) bfr[j] = *(const bf16x8*)&Bb[(nb + j * 16 + r16) * LDK + (((kk * 4 + (lane >> 4)) ^ fx) << 3)];
      __builtin_amdgcn_s_setprio(1);
#pragma unroll
      for (int i = 0; i < TM; i++)
#pragma unroll
        for (int j = 0; j < TN; j++) acc[i][j] = SWAP ? mfma16(bfr[j], af[i], acc[i][j]) : mfma16(af[i], bfr[j], acc[i][j]);
      __builtin_amdgcn_s_setprio(0);
    }
    __syncthreads();
  }
#undef GLOADF
#undef SOFFC
#undef SSTOREC
}

__device__ __forceinline__ int perm32(int r) { return (r & ~31) + 8 * ((r & 15) >> 2) + 4 * ((r >> 4) & 1) + (r & 3); }

template <int TM, int TN>
__device__ __forceinline__ void zero_acc(f32x4 (&acc)[TM][TN]) {
#pragma unroll
  for (int i = 0; i < TM; i++)
#pragma unroll
    for (int j = 0; j < TN; j++) acc[i][j] = f32x4{0.f, 0.f, 0.f, 0.f};
}

constexpr int LDT = 144;
template <int TM, int TN, bool SWAP>
__device__ __forceinline__ void mma_lds(const bf16_t* A, const bf16_t* B, int K, int mb, int nb, f32x4 (&acc)[TM][TN]) {
  const int lane = tidx() & 63, r16 = lane & 15, kq = (lane >> 4) * 8;
  for (int k0 = 0; k0 < K; k0 += 32) {
    bf16x8 af[TM], bfr[TN];
#pragma unroll
    for (int i = 0; i < TM; i++) af[i] = *(const bf16x8*)&A[(mb + i * 16 + r16) * LDT + k0 + kq];
#pragma unroll
    for (int j = 0; j < TN; j++) bfr[j] = *(const bf16x8*)&B[(nb + j * 16 + r16) * LDT + k0 + kq];
    __builtin_amdgcn_s_setprio(1);
#pragma unroll
    for (int i = 0; i < TM; i++)
#pragma unroll
      for (int j = 0; j < TN; j++) acc[i][j] = SWAP ? mfma16(bfr[j], af[i], acc[i][j]) : mfma16(af[i], bfr[j], acc[i][j]);
    __builtin_amdgcn_s_setprio(0);
  }
}

__device__ __forceinline__ void transpose_tile(const float* __restrict__ src, bf16_t* __restrict__ dst, int K, int N, int tile, char* smem) {
  float* sm = (float*)smem;
  const int ntn = (N + 255) >> 8;
  const int k0 = (tile / ntn) * 64, n0 = (tile % ntn) * 256;
  const int tid = tidx();
  {
    float4 v[8];
#pragma unroll
    for (int t = 0; t < 8; t++) {
      int idx = tid + t * NT, r = idx >> 6, c = (idx & 63) * 4;
      v[t] = (n0 + c < N) ? *(const float4*)(src + (size_t)(k0 + r) * N + n0 + c) : make_float4(0.f, 0.f, 0.f, 0.f);
    }
#pragma unroll
    for (int t = 0; t < 8; t++) {
      int idx = tid + t * NT, r = idx >> 6, c = (idx & 63) * 4;
      sm[r * 257 + c] = v[t].x; sm[r * 257 + c + 1] = v[t].y; sm[r * 257 + c + 2] = v[t].z; sm[r * 257 + c + 3] = v[t].w;
    }
  }
  __syncthreads();
#pragma unroll 8
  for (int t = 0; t < 16; t++) {
    int idx = tid + t * NT, r = idx >> 5, c = (idx & 31) * 2;
    if (n0 + r < N) *(uint32_t*)(dst + (size_t)(n0 + r) * K + k0 + c) = pack2(sm[c * 257 + r], sm[(c + 1) * 257 + r]);
  }
  __syncthreads();
}

__device__ __forceinline__ void transpose_item(const Params& p, int l, int i, char* smem) {
  char* ws = p.ws;
  if (i < 368) { transpose_tile(p.in[I_WIN] + (size_t)l * 1024 * NIN, (bf16_t*)(ws + W_WIN), 1024, NIN, i, smem); return; }
  i -= 368;
  if (i < 32) { transpose_tile(p.in[I_WUPM] + (size_t)l * 512 * 1024, (bf16_t*)(ws + W_WUPM), 512, 1024, i, smem); return; }
  i -= 32;
  if (i < 16) { transpose_tile(p.in[I_WUPF] + (size_t)l * 256 * 1024, (bf16_t*)(ws + W_WUPF), 256, 1024, i, smem); return; }
  i -= 16;
  if (i < 32) { transpose_tile(p.in[I_WGLU] + (size_t)l * 256 * 2048, (bf16_t*)(ws + W_WGLU), 256, 2048, i, smem); return; }
  i -= 32;
  if (i < 64) { transpose_tile(p.in[I_WOUT] + (size_t)l * 1024 * 1024, (bf16_t*)(ws + W_WOUT), 1024, 1024, i, smem); return; }
  i -= 64;
  if (i < 256) { transpose_tile(p.in[I_W1] + (size_t)l * 1024 * 4096, (bf16_t*)(ws + W_W1), 1024, 4096, i, smem); return; }
  i -= 256;
  transpose_tile(p.in[I_W2] + (size_t)l * 4096 * 1024, (bf16_t*)(ws + W_W2), 4096, 1024, i, smem);
}
constexpr int N_TR = 368 + 32 + 16 + 32 + 64 + 256 + 256;

__device__ __forceinline__ void gen_tables(const Params& p, int item) {
  char* ws = p.ws;
  bf16_t* F1T = (bf16_t*)(ws + W_F1T);
  bf16_t* F2T = (bf16_t*)(ws + W_F2T);
  bf16_t* F3T = (bf16_t*)(ws + W_F3T);
  float* TW = (float*)(ws + W_TW);
  uint32_t* ZR = (uint32_t*)(ws + W_ZERO);
  constexpr int E1 = 8192, E2 = 65536, E3 = 8192, E4 = 8192, E5 = 64;
  for (int e = item * NT + tidx(); e < E1 + E2 + E3 + E4 + E5; e += 32 * NT) {
    int i = e;
    if (i < E1) {
      int n = i >> 6, d = i & 63, c = n >> 6, j = n & 63;
      float s, co; sincospif((float)((j * d) & 63) / 32.f, &s, &co);
      F1T[i] = f2bf(c == 0 ? co : -s);
      continue;
    }
    i -= E1;
    if (i < E2) {
      int n = i >> 8, k = i & 255;
      int k1 = (n >> 5) * 16 + (n & 15), cp = (n >> 4) & 1, c = k >> 7, s1 = k & 127;
      float s, co; sincospif((float)((s1 * k1) & 127) / 64.f, &s, &co);
      float v = (cp == 0) ? (c == 0 ? co : s) : (c == 0 ? -s : co);
      F2T[i] = f2bf(v);
      continue;
    }
    i -= E2;
    if (i < E3) {
      int k2 = i >> 7, k = i & 127, cp = k >> 6, s2 = k & 63;
      float s, co; sincospif((float)((s2 * k2) & 63) / 32.f, &s, &co);
      const float scale = 0.0013810679320049757f;
      F3T[i] = f2bf((cp == 0 ? co : s) * scale);
      continue;
    }
    i -= E3;
    if (i < E4) {
      int s2 = i >> 7, k1 = i & 127;
      float s, co; sincospif((float)(s2 * k1) / 4096.f, &s, &co);
      TW[2 * i] = co; TW[2 * i + 1] = s;
      continue;
    }
    i -= E4;
    ZR[i] = 0u;
  }
}

__device__ __forceinline__ void s5_setup(const Params& p, int l, int g, float* POW, float* BB, float* CC) {
  const int tid = tidx();
  for (int e = tid; e < 2 * 64 * 33; e += NT) {
    int d = e / (64 * 33), r = e - d * 64 * 33, tau = r >> 6, pp = r & 63;
    int gi = ((l * 2 + d) * 16 + g);
    float dt = expf(p.in[I_LDT][gi]);
    float lr = p.in[I_LRE][gi * 64 + pp], li = p.in[I_LIM][gi * 64 + pp];
    float m2 = expf(lr * dt * (float)tau);
    float s2, c2; sincosf(li * dt * (float)tau, &s2, &c2);
    POW[((d * 33 + tau) * 64 + pp) * 2] = m2 * c2;
    POW[((d * 33 + tau) * 64 + pp) * 2 + 1] = m2 * s2;
  }
  for (int e = tid; e < 2048; e += NT) {
    int d = e >> 10, pp = (e >> 4) & 63, ci = e & 15;
    int gi = ((l * 2 + d) * 16 + g);
    float dt = expf(p.in[I_LDT][gi]);
    float lr = p.in[I_LRE][gi * 64 + pp], li = p.in[I_LIM][gi * 64 + pp];
    float mag = expf(lr * dt);
    float sn, cs; sincosf(li * dt, &sn, &cs);
    float lbr = mag * cs, lbi = mag * sn;
    float den = lr * lr + li * li;
    float fr = ((lbr - 1.f) * lr + lbi * li) / den;
    float fi = (lbi * lr - (lbr - 1.f) * li) / den;
    float br = p.in[I_BRE][(gi * 64 + pp) * 16 + ci], bi = p.in[I_BIM][(gi * 64 + pp) * 16 + ci];
    BB[e * 2] = fr * br - fi * bi;
    BB[e * 2 + 1] = fr * bi + fi * br;
  }
  for (int e = tid; e < 2048; e += NT) {
    int d = e >> 10, r = e & 1023;
    int gi = ((l * 2 + d) * 16 + g);
    CC[e * 2] = p.in[I_CRE][gi * 1024 + r];
    CC[e * 2 + 1] = p.in[I_CIM][gi * 1024 + r];
  }
  __syncthreads();
}
__device__ __forceinline__ void s5_kt(const Params& p, int item, char* smem) {
  float* POW = (float*)smem;
  float* BB = POW + 2 * 33 * 64 * 2;
  float* CC = BB + 2 * 64 * 16 * 2;
  const int part = item & 7, g = (item >> 3) & 15, l = item >> 7;
  s5_setup(p, l, g, POW, BB, CC);
  float* KTG = (float*)(p.ws + W_KTG) + (size_t)(l * 16 + g) * 16384;
  const int tid = tidx();
  for (int e = part * 2048 + tid; e < part * 2048 + 2048; e += NT) {
    int d = e >> 13, tau = (e >> 8) & 31, co = (e >> 4) & 15, ci = e & 15;
    float s = 0.f;
    for (int pp = 0; pp < 64; pp++) {
      float cr = CC[((d * 16 + co) * 64 + pp) * 2], cim = CC[((d * 16 + co) * 64 + pp) * 2 + 1];
      float pr = POW[((d * 33 + tau) * 64 + pp) * 2], pi = POW[((d * 33 + tau) * 64 + pp) * 2 + 1];
      float xr = cr * pr - cim * pi, xi = cr * pi + cim * pr;
      float br = BB[((d * 64 + pp) * 16 + ci) * 2], bi = BB[((d * 64 + pp) * 16 + ci) * 2 + 1];
      s += xr * br - xi * bi;
    }
    KTG[e] = s;
  }
  __syncthreads();
}
__device__ __forceinline__ void s5_fill(const Params& p, int l, int item, char* smem) {
  float* POW = (float*)smem;
  float* BB = POW + 2 * 33 * 64 * 2;
  float* CC = BB + 2 * 64 * 16 * 2;
  float* KT = CC + 2 * 16 * 64 * 2;
  const int part = item & 7, g = item >> 3;
  const int tid = tidx();
  char* ws = p.ws;
  const float* KTG = (const float*)(ws + W_KTG) + (size_t)(l * 16 + g) * 16384;
  for (int e = tid; e < 4096; e += NT) ((float4*)KT)[e] = ((const float4*)KTG)[e];
  s5_setup(p, l, g, POW, BB, CC);
  if (part == 0 && tid < 128) {
    int d = tid >> 6, pp = tid & 63;
    float* LP = (float*)(ws + W_LPOW);
    LP[((d * 16 + g) * 64 + pp) * 2] = POW[((d * 33 + 32) * 64 + pp) * 2];
    LP[((d * 16 + g) * 64 + pp) * 2 + 1] = POW[((d * 33 + 32) * 64 + pp) * 2 + 1];
  }
  bf16_t* TG = (bf16_t*)(ws + W_TG) + (size_t)g * 512 * 768;
  const float* dsk = p.in[I_SD] + (l * 16 + g) * 16;
  for (int e = part * 64 * 768 + tid; e < (part + 1) * 64 * 768; e += NT) {
    int n = e / 768, k = e - n * 768;
    int t = n >> 4, co = n & 15;
    float v;
    if (k < 512) {
      int s = k >> 4, ci = k & 15;
      if (t > s) v = KT[((0 * 32 + (t - s)) * 16 + co) * 16 + ci];
      else if (t < s) v = KT[((1 * 32 + (s - t)) * 16 + co) * 16 + ci];
      else v = KT[(co)*16 + ci] + KT[((32) * 16 + co) * 16 + ci] + (co == ci ? dsk[co] : 0.f);
    } else {
      int kk = k - 512, d = kk >> 7, pp = (kk & 127) >> 1, c = kk & 1;
      int tau = d == 0 ? t + 1 : 32 - t;
      float cr = CC[((d * 16 + co) * 64 + pp) * 2], cim = CC[((d * 16 + co) * 64 + pp) * 2 + 1];
      float pr = POW[((d * 33 + tau) * 64 + pp) * 2], pi = POW[((d * 33 + tau) * 64 + pp) * 2 + 1];
      float xr = cr * pr - cim * pi, xi = cr * pi + cim * pr;
      v = c == 0 ? xr : -xi;
    }
    TG[e] = f2bf(v);
  }
  bf16_t* ET = (bf16_t*)(ws + W_ET) + (size_t)g * 256 * 512;
  for (int e = part * 32 * 512 + tid; e < (part + 1) * 32 * 512; e += NT) {
    int n = e >> 9, k = e & 511;
    int d = n >> 7, pp = (n & 127) >> 1, c = n & 1, s = k >> 4, ci = k & 15;
    int tau = d == 0 ? 31 - s : s;
    float pr = POW[((d * 33 + tau) * 64 + pp) * 2], pi = POW[((d * 33 + tau) * 64 + pp) * 2 + 1];
    float br = BB[((d * 64 + pp) * 16 + ci) * 2], bi = BB[((d * 64 + pp) * 16 + ci) * 2 + 1];
    float v = c == 0 ? (pr * br - pi * bi) : (pr * bi + pi * br);
    ET[e] = f2bf(v);
  }
  __syncthreads();
}

__device__ __forceinline__ void rms_item(const Params& p, int mode, int l, int item) {
  const int lane = tidx() & 63, w = tidx() >> 6;
  const int row = item * 8 + w;
  char* ws = p.ws;
  const float* xin = (mode == 2 || l > 0) ? p.out : p.in[I_X];
  float xv[16];
#pragma unroll
  for (int t = 0; t < 4; t++) {
    float4 v = *(const float4*)(xin + (size_t)row * 1024 + t * 256 + lane * 4);
    xv[t * 4] = v.x; xv[t * 4 + 1] = v.y; xv[t * 4 + 2] = v.z; xv[t * 4 + 3] = v.w;
  }
  if (mode >= 1) {
    const bf16_t* y = (const bf16_t*)(ws + (mode == 1 ? W_O : W_FO)) + (size_t)row * 1024;
    const float* gp = (mode == 1 ? p.in[I_GMPOST] : p.in[I_GFPOST]) + l * 1024;
    float yv[16];
    float ss = 0.f;
#pragma unroll
    for (int t = 0; t < 4; t++) {
      uint2 u = *(const uint2*)(y + t * 256 + lane * 4);
      yv[t * 4] = lo16(u.x); yv[t * 4 + 1] = hi16(u.x); yv[t * 4 + 2] = lo16(u.y); yv[t * 4 + 3] = hi16(u.y);
    }
#pragma unroll
    for (int e = 0; e < 16; e++) ss += yv[e] * yv[e];
    ss = wave_sum(ss);
    float r = rsqrtf(ss * (1.f / 1024.f) + EPS);
#pragma unroll
    for (int t = 0; t < 4; t++) {
      float4 gv = *(const float4*)(gp + t * 256 + lane * 4);
      xv[t * 4] += yv[t * 4] * r * gv.x; xv[t * 4 + 1] += yv[t * 4 + 1] * r * gv.y;
      xv[t * 4 + 2] += yv[t * 4 + 2] * r * gv.z; xv[t * 4 + 3] += yv[t * 4 + 3] * r * gv.w;
      *(float4*)(p.out + (size_t)row * 1024 + t * 256 + lane * 4) = make_float4(xv[t * 4], xv[t * 4 + 1], xv[t * 4 + 2], xv[t * 4 + 3]);
    }
  }
  const bool wh = (mode != 2) || (l + 1 < 2);
  if (wh) {
    const float* gh = (mode == 0 ? p.in[I_GMPRE] + l * 1024 : (mode == 1 ? p.in[I_GFPRE] + l * 1024 : p.in[I_GMPRE] + (l + 1) * 1024));
    float ss = 0.f;
#pragma unroll
    for (int e = 0; e < 16; e++) ss += xv[e] * xv[e];
    ss = wave_sum(ss);
    float r = rsqrtf(ss * (1.f / 1024.f) + EPS);
    bf16_t* h = (bf16_t*)(ws + W_HBF) + (size_t)row * 1024;
#pragma unroll
    for (int t = 0; t < 4; t++) {
      float4 gv = *(const float4*)(gh + t * 256 + lane * 4);
      *(uint2*)(h + t * 256 + lane * 4) = pack4(xv[t * 4] * r * gv.x, xv[t * 4 + 1] * r * gv.y, xv[t * 4 + 2] * r * gv.z, xv[t * 4 + 3] * r * gv.w);
    }
  }
}

template <int NTL, int PN>
__device__ __forceinline__ void tile_map(int it, int& mt, int& nt) {
  constexpr int PM = 32 / PN, NPN = NTL / PN;
  constexpr int total = 64 * NTL, full = (total / 256) * 256;
  int gp, within;
  if (it < full) { int xcd = it & 7, loc = it >> 3; gp = (loc >> 5) * 8 + xcd; within = loc & 31; }
  else { int rem = it - full; gp = full / 32 + (rem >> 5); within = rem & 31; }
  const int mp = gp / NPN, np = gp - mp * NPN;
  mt = mp * PM + within / PN;
  nt = np * PN + within % PN;
}

__device__ __forceinline__ void inproj_item(const Params& p, int l, int item, char* smem) {
  int mt, nt;
  tile_map<10, 2>(item, mt, nt);
  const int m0 = mt * 256, n0 = nt * 256;
  const int nsh = n0 >= 2048 ? 16 : 0;
  char* ws = p.ws;
  const bf16_t* A = (const bf16_t*)(ws + W_HBF) + (size_t)m0 * 1024;
  const bf16_t* B = (const bf16_t*)(ws + W_WIN) + (size_t)(n0 + nsh) * 1024;
  f32x4 acc[8][4];
  zero_acc(acc);
  gemm_acc<256, 256, 2, 4, true>(1024, [&](int r, int k) { return A + (size_t)r * 1024 + k; }, [&](int r, int k) { return B + (size_t)perm32(r) * 1024 + k; }, smem, acc);
  const int lane = tidx() & 63, w = tidx() >> 6;
  const int mb = (w / 4) * 128, nb = (w % 4) * 64;
  bf16_t* Z = (bf16_t*)(ws + W_Z);
  const float* bin = p.in[I_BIN] + l * NIN;
#pragma unroll
  for (int jj = 0; jj < 2; jj++) {
    const int n = n0 + nsh + nb + jj * 32 + (lane >> 4) * 8;
    float4 b0 = *(const float4*)(bin + n), b1 = *(const float4*)(bin + n + 4);
#pragma unroll
    for (int i = 0; i < 8; i++) {
      const int m = m0 + mb + i * 16 + (lane & 15);
      uint4 o;
      o.x = pack2(acc[i][2 * jj][0] + b0.x, acc[i][2 * jj][1] + b0.y); o.y = pack2(acc[i][2 * jj][2] + b0.z, acc[i][2 * jj][3] + b0.w);
      o.z = pack2(acc[i][2 * jj + 1][0] + b1.x, acc[i][2 * jj + 1][1] + b1.y); o.w = pack2(acc[i][2 * jj + 1][2] + b1.z, acc[i][2 * jj + 1][3] + b1.w);
      *(uint4*)(Z + (size_t)m * ZS + (n - nsh)) = o;
    }
  }
}
__device__ __forceinline__ void inproj_half_item(const Params& p, int l, int item, char* smem) {
  const int big = 512 + (item >> 1), half = item & 1;
  int mt, nt;
  tile_map<10, 2>(big, mt, nt);
  const int m0 = mt * 256, n0 = nt * 256 + half * 128;
  const int nsh = n0 >= 2048 ? 16 : 0;
  char* ws = p.ws;
  const bf16_t* A = (const bf16_t*)(ws + W_HBF) + (size_t)m0 * 1024;
  const bf16_t* B = (const bf16_t*)(ws + W_WIN) + (size_t)(n0 + nsh) * 1024;
  f32x4 acc[4][4];
  zero_acc(acc);
  gemm_acc<256, 128, 4, 2, true>(1024, [&](int r, int k) { return A + (size_t)r * 1024 + k; }, [&](int r, int k) { return B + (size_t)perm32(r) * 1024 + k; }, smem, acc);
  const int lane = tidx() & 63, w = tidx() >> 6;
  const int mb = (w / 2) * 64, nb = (w % 2) * 64;
  bf16_t* Z = (bf16_t*)(ws + W_Z);
  const float* bin = p.in[I_BIN] + l * NIN;
#pragma unroll
  for (int jj = 0; jj < 2; jj++) {
    const int n = n0 + nsh + nb + jj * 32 + (lane >> 4) * 8;
    float4 b0 = *(const float4*)(bin + n), b1 = *(const float4*)(bin + n + 4);
#pragma unroll
    for (int i = 0; i < 4; i++) {
      const int m = m0 + mb + i * 16 + (lane & 15);
      uint4 o;
      o.x = pack2(acc[i][2 * jj][0] + b0.x, acc[i][2 * jj][1] + b0.y); o.y = pack2(acc[i][2 * jj][2] + b0.z, acc[i][2 * jj][3] + b0.w);
      o.z = pack2(acc[i][2 * jj + 1][0] + b1.x, acc[i][2 * jj + 1][1] + b1.y); o.w = pack2(acc[i][2 * jj + 1][2] + b1.z, acc[i][2 * jj + 1][3] + b1.w);
      *(uint4*)(Z + (size_t)m * ZS + (n - nsh)) = o;
    }
  }
}
__device__ __forceinline__ void ingate_item(const Params& p, int l, int item, char* smem) {
  const int m0 = item * 256;
  char* ws = p.ws;
  const bf16_t* A = (const bf16_t*)(ws + W_HBF) + (size_t)m0 * 1024;
  const bf16_t* B = (const bf16_t*)(ws + W_WIN) + (size_t)OFF_IG * 1024;
  f32x4 acc[4][2];
  zero_acc(acc);
  gemm_acc<256, 64, 4, 2, true>(1024, [&](int r, int k) { return A + (size_t)r * 1024 + k; }, [&](int r, int k) { int rr = r < 16 ? r : 15; return B + (size_t)rr * 1024 + k; }, smem, acc);
  const int lane = tidx() & 63, w = tidx() >> 6;
  const int mb = (w / 2) * 64;
  float* ZG = (float*)(ws + W_ZG);
  const float* bin = p.in[I_BIN] + l * NIN + OFF_IG;
  if ((w & 1) == 0) {
    const int n = (lane >> 4) * 4;
    float4 bv = *(const float4*)(bin + n);
#pragma unroll
    for (int i = 0; i < 4; i++) {
      const int m = m0 + mb + i * 16 + (lane & 15);
      *(float4*)(ZG + (size_t)m * 16 + n) = make_float4(acc[i][0][0] + bv.x, acc[i][0][1] + bv.y, acc[i][0][2] + bv.z, acc[i][0][3] + bv.w);
    }
  }
}

template <int MODE, int NTL, int PN>
__device__ __forceinline__ void plain_gemm_item(const bf16_t* A, const bf16_t* Bt, bf16_t* C, int K, int item, char* smem) {
  constexpr int N = NTL * 256;
  int mt, nt;
  tile_map<NTL, PN>(item, mt, nt);
  const int m0 = mt * 256, n0 = nt * 256;
  const bf16_t* Ab = A + (size_t)m0 * K;
  const bf16_t* Bb = Bt + (size_t)n0 * K;
  f32x4 acc[8][4];
  zero_acc(acc);
  gemm_acc<256, 256, 2, 4, true>(K, [&](int r, int k) { return Ab + (size_t)r * K + k; }, [&](int r, int k) { return Bb + (size_t)perm32(r) * K + k; }, smem, acc);
  const int lane = tidx() & 63, w = tidx() >> 6;
  const int mb = (w / 4) * 128, nb = (w % 4) * 64;
#pragma unroll
  for (int jj = 0; jj < 2; jj++) {
    const int n = n0 + nb + jj * 32 + (lane >> 4) * 8;
#pragma unroll
    for (int i = 0; i < 8; i++) {
      const int m = m0 + mb + i * 16 + (lane & 15);
      float v[8];
#pragma unroll
      for (int r = 0; r < 4; r++) { v[r] = acc[i][2 * jj][r]; v[4 + r] = acc[i][2 * jj + 1][r]; }
      if (MODE == 1) {
#pragma unroll
        for (int r = 0; r < 8; r++) { v[r] = fmaxf(v[r], 0.f); v[r] *= v[r]; }
      }
      uint4 o;
      o.x = pack2(v[0], v[1]); o.y = pack2(v[2], v[3]); o.z = pack2(v[4], v[5]); o.w = pack2(v[6], v[7]);
      *(uint4*)(C + (size_t)m * N + n) = o;
    }
  }
}

template <int MODE, int NTL, int PN>
__device__ __forceinline__ void plain_gemm_chain(const bf16_t* A, const bf16_t* Bt, bf16_t* C, int K, int item, int next, bool has_next, bool preloaded, Stage& st, char* smem) {
  constexpr int N = NTL * 256;
  int mt, nt, mt2 = 0, nt2 = 0;
  tile_map<NTL, PN>(item, mt, nt);
  if (has_next) tile_map<NTL, PN>(next, mt2, nt2);
  const int m0 = mt * 256, n0 = nt * 256;
  const bf16_t* Ab = A + (size_t)m0 * K;
  const bf16_t* Bb = Bt + (size_t)n0 * K;
  const bf16_t* Ab2 = A + (size_t)mt2 * 256 * K;
  const bf16_t* Bb2 = Bt + (size_t)nt2 * 256 * K;
  f32x4 acc[8][4];
  zero_acc(acc);
  gemm_chain<256, 256, 2, 4, true>(K, [&](int r, int k) { return Ab + (size_t)r * K + k; }, [&](int r, int k) { return Bb + (size_t)perm32(r) * K + k; },
                                   preloaded, has_next, [&](int r, int k) { return Ab2 + (size_t)r * K + k; }, [&](int r, int k) { return Bb2 + (size_t)perm32(r) * K + k; }, st, smem, acc);
  const int lane = tidx() & 63, w = tidx() >> 6;
  const int mb = (w / 4) * 128, nb = (w % 4) * 64;
#pragma unroll
  for (int jj = 0; jj < 2; jj++) {
    const int n = n0 + nb + jj * 32 + (lane >> 4) * 8;
#pragma unroll
    for (int i = 0; i < 8; i++) {
      const int m = m0 + mb + i * 16 + (lane & 15);
      float v[8];
#pragma unroll
      for (int r = 0; r < 4; r++) { v[r] = acc[i][2 * jj][r]; v[4 + r] = acc[i][2 * jj + 1][r]; }
      if (MODE == 1) {
#pragma unroll
        for (int r = 0; r < 8; r++) { v[r] = fmaxf(v[r], 0.f); v[r] *= v[r]; }
      }
      uint4 o;
      o.x = pack2(v[0], v[1]); o.y = pack2(v[2], v[3]); o.z = pack2(v[4], v[5]); o.w = pack2(v[6], v[7]);
      *(uint4*)(C + (size_t)m * N + n) = o;
    }
  }
}

__device__ __forceinline__ void merge_item(const Params& p, int l, int item, char* smem) {
  int mt, nt;
  tile_map<8, 4>(item, mt, nt);
  const int m0 = mt * 256, n0 = nt * 128;
  char* ws = p.ws;
  const bf16_t* HB = (const bf16_t*)(ws + W_HBF) + (size_t)m0 * 1024;
  const bf16_t* HM = (const bf16_t*)(ws + W_HM) + (size_t)m0 * 512;
  const bf16_t* YF = (const bf16_t*)(ws + W_YF) + (size_t)m0 * 256;
  const bf16_t* YS = (const bf16_t*)(ws + W_YS) + (size_t)m0 * 256;
  const bf16_t* WG = (const bf16_t*)(ws + W_WIN) + (size_t)(OFF_GATE + n0) * 1024;
  const bf16_t* WUM = (const bf16_t*)(ws + W_WUPM) + (size_t)n0 * 512;
  const bf16_t* WUF = (const bf16_t*)(ws + W_WUPF) + (size_t)n0 * 256;
  const bf16_t* WGL = (const bf16_t*)(ws + W_WGLU) + (size_t)n0 * 256;
  const float* bin = p.in[I_BIN] + l * NIN + OFF_GATE;
  const float* bgl = p.in[I_BGLU] + l * 2048;
  uint2 mixp[4][4];
#pragma unroll
  for (int i = 0; i < 4; i++)
#pragma unroll
    for (int j = 0; j < 4; j++) mixp[i][j] = make_uint2(0u, 0u);
  bf16_t* MIX = (bf16_t*)(ws + W_MIX);
#pragma unroll 1
  for (int br = 0; br < 3; br++) {
    uint2 gp[4][4];
    {
      f32x4 acc[4][4];
      zero_acc(acc);
      const bf16_t* WGb = WG + (size_t)br * 1024 * 1024;
      gemm_acc<256, 128, 4, 2, true>(1024, [&](int r, int k) { return HB + (size_t)r * 1024 + k; }, [&](int r, int k) { return WGb + (size_t)r * 1024 + k; }, smem, acc);
#pragma unroll
      for (int j = 0; j < 4; j++) {
        const int n = n0 + ((tidx() >> 6) & 1) * 64 + j * 16 + ((tidx() >> 4) & 3) * 4;
        float4 bv = *(const float4*)(bin + br * 1024 + n);
#pragma unroll
        for (int i = 0; i < 4; i++)
          gp[i][j] = pack4(sigm(acc[i][j][0] + bv.x), sigm(acc[i][j][1] + bv.y), sigm(acc[i][j][2] + bv.z), sigm(acc[i][j][3] + bv.w));
      }
    }
    if (br == 2) {
      f32x4 a2[4][4];
      zero_acc(a2);
      gemm_acc<256, 128, 4, 2, true>(256, [&](int r, int k) { return YS + (size_t)r * 256 + k; }, [&](int r, int k) { return WGL + (size_t)(1024 + r) * 256 + k; }, smem, a2);
#pragma unroll
      for (int j = 0; j < 4; j++) {
        const int n = n0 + ((tidx() >> 6) & 1) * 64 + j * 16 + ((tidx() >> 4) & 3) * 4;
        float4 b2 = *(const float4*)(bgl + 1024 + n);
#pragma unroll
        for (int i = 0; i < 4; i++)
          gp[i][j] = pack4(lo16(gp[i][j].x) * sigm(a2[i][j][0] + b2.x), hi16(gp[i][j].x) * sigm(a2[i][j][1] + b2.y),
                           lo16(gp[i][j].y) * sigm(a2[i][j][2] + b2.z), hi16(gp[i][j].y) * sigm(a2[i][j][3] + b2.w));
      }
    }
    const bf16_t* A = br == 0 ? HM : (br == 1 ? YF : YS);
    const bf16_t* W = br == 0 ? WUM : (br == 1 ? WUF : WGL);
    const int KA = br == 0 ? 512 : 256;
    f32x4 acc[4][4];
    zero_acc(acc);
    gemm_acc<256, 128, 4, 2, true>(KA, [&](int r, int k) { return A + (size_t)r * KA + k; }, [&](int r, int k) { return W + (size_t)r * KA + k; }, smem, acc);
#pragma unroll
    for (int j = 0; j < 4; j++) {
      const int n = n0 + ((tidx() >> 6) & 1) * 64 + j * 16 + ((tidx() >> 4) & 3) * 4;
      float4 b1 = make_float4(0.f, 0.f, 0.f, 0.f);
      if (br == 2) b1 = *(const float4*)(bgl + n);
#pragma unroll
      for (int i = 0; i < 4; i++) {
        mixp[i][j] = pack4(lo16(mixp[i][j].x) + (acc[i][j][0] + b1.x) * lo16(gp[i][j].x), hi16(mixp[i][j].x) + (acc[i][j][1] + b1.y) * hi16(gp[i][j].x),
                           lo16(mixp[i][j].y) + (acc[i][j][2] + b1.z) * lo16(gp[i][j].y), hi16(mixp[i][j].y) + (acc[i][j][3] + b1.w) * hi16(gp[i][j].y));
      }
    }
  }
#pragma unroll
  for (int j = 0; j < 4; j++) {
    const int n = n0 + ((tidx() >> 6) & 1) * 64 + j * 16 + ((tidx() >> 4) & 3) * 4;
#pragma unroll
    for (int i = 0; i < 4; i++) {
      const int m = m0 + (tidx() >> 7) * 64 + i * 16 + (tidx() & 15);
      *(uint2*)(MIX + (size_t)m * 1024 + n) = mixp[i][j];
    }
  }
}

__device__ __forceinline__ void mergelite_item(const Params& p, int l, int item, char* smem) {
  int mt, nt;
  tile_map<8, 4>(item, mt, nt);
  const int m0 = mt * 256, n0 = nt * 128;
  char* ws = p.ws;
  const bf16_t* HM = (const bf16_t*)(ws + W_HM) + (size_t)m0 * 512;
  const bf16_t* YF = (const bf16_t*)(ws + W_YF) + (size_t)m0 * 256;
  const bf16_t* YS = (const bf16_t*)(ws + W_YS) + (size_t)m0 * 256;
  const bf16_t* WUM = (const bf16_t*)(ws + W_WUPM) + (size_t)n0 * 512;
  const bf16_t* WUF = (const bf16_t*)(ws + W_WUPF) + (size_t)n0 * 256;
  const bf16_t* WGL = (const bf16_t*)(ws + W_WGLU) + (size_t)n0 * 256;
  const bf16_t* WGL2 = WGL + (size_t)1024 * 256;
  const float* bgl = p.in[I_BGLU] + l * 2048;
  const bf16_t* G = (const bf16_t*)(ws + W_GATE);
  bf16_t* MIX = (bf16_t*)(ws + W_MIX);
#define MROW(i) (m0 + (tidx() >> 7) * 64 + (i) * 16 + (tidx() & 15))
#define NCOL8(jj) (n0 + ((tidx() >> 6) & 1) * 64 + (jj) * 32 + ((tidx() >> 4) & 3) * 8)
  Stage st; st.a0 = st.a1 = st.a2 = st.a3 = st.b0 = st.b1 = st.b2 = st.b3 = make_uint4(0, 0, 0, 0);
  uint2 mixp[4][4], tmpp[4][4];
#pragma unroll
  for (int i = 0; i < 4; i++)
#pragma unroll
    for (int j = 0; j < 4; j++) { mixp[i][j] = make_uint2(0u, 0u); tmpp[i][j] = make_uint2(0u, 0u); }
#pragma unroll 1
  for (int sg = 0; sg < 4; sg++) {
    const bf16_t* A = sg == 0 ? HM : (sg == 1 ? YF : YS);
    const bf16_t* W = sg == 0 ? WUM : (sg == 1 ? WUF : (sg == 2 ? WGL : WGL2));
    const int KA = sg == 0 ? 512 : 256;
    const bf16_t* A2 = sg == 0 ? YF : YS;
    const bf16_t* W2 = sg == 0 ? WUF : (sg == 1 ? WGL : WGL2);
    f32x4 acc[4][4];
    zero_acc(acc);
    gemm_chain<256, 128, 4, 2, true>(KA, [&](int r, int k) { return A + (size_t)r * KA + k; }, [&](int r, int k) { return W + (size_t)perm32(r) * KA + k; },
                                     sg > 0, sg < 3, [&](int r, int k) { return A2 + (size_t)r * 256 + k; }, [&](int r, int k) { return W2 + (size_t)perm32(r) * 256 + k; }, st, smem, acc);
    if (sg < 2) {
#pragma unroll
      for (int jj = 0; jj < 2; jj++)
#pragma unroll
        for (int i = 0; i < 4; i++) {
          const uint4 g = *(const uint4*)(G + (size_t)MROW(i) * 3072 + sg * 1024 + NCOL8(jj));
          const uint2 o0 = mixp[i][2 * jj], o1 = mixp[i][2 * jj + 1];
          mixp[i][2 * jj].x = pack2(lo16(o0.x) + acc[i][2 * jj][0] * lo16(g.x), hi16(o0.x) + acc[i][2 * jj][1] * hi16(g.x));
          mixp[i][2 * jj].y = pack2(lo16(o0.y) + acc[i][2 * jj][2] * lo16(g.y), hi16(o0.y) + acc[i][2 * jj][3] * hi16(g.y));
          mixp[i][2 * jj + 1].x = pack2(lo16(o1.x) + acc[i][2 * jj + 1][0] * lo16(g.z), hi16(o1.x) + acc[i][2 * jj + 1][1] * hi16(g.z));
          mixp[i][2 * jj + 1].y = pack2(lo16(o1.y) + acc[i][2 * jj + 1][2] * lo16(g.w), hi16(o1.y) + acc[i][2 * jj + 1][3] * hi16(g.w));
        }
    } else if (sg == 2) {
#pragma unroll
      for (int jj = 0; jj < 2; jj++) {
        const float4 b0 = *(const float4*)(bgl + NCOL8(jj)), b1 = *(const float4*)(bgl + NCOL8(jj) + 4);
#pragma unroll
        for (int i = 0; i < 4; i++) {
          tmpp[i][2 * jj].x = pack2(acc[i][2 * jj][0] + b0.x, acc[i][2 * jj][1] + b0.y);
          tmpp[i][2 * jj].y = pack2(acc[i][2 * jj][2] + b0.z, acc[i][2 * jj][3] + b0.w);
          tmpp[i][2 * jj + 1].x = pack2(acc[i][2 * jj + 1][0] + b1.x, acc[i][2 * jj + 1][1] + b1.y);
          tmpp[i][2 * jj + 1].y = pack2(acc[i][2 * jj + 1][2] + b1.z, acc[i][2 * jj + 1][3] + b1.w);
        }
      }
    } else {
#pragma unroll
      for (int jj = 0; jj < 2; jj++) {
        const float4 b0 = *(const float4*)(bgl + 1024 + NCOL8(jj)), b1 = *(const float4*)(bgl + 1024 + NCOL8(jj) + 4);
#pragma unroll
        for (int i = 0; i < 4; i++) {
          const uint4 g = *(const uint4*)(G + (size_t)MROW(i) * 3072 + 2048 + NCOL8(jj));
          const uint2 t0 = tmpp[i][2 * jj], t1 = tmpp[i][2 * jj + 1], o0 = mixp[i][2 * jj], o1 = mixp[i][2 * jj + 1];
          uint4 o;
          o.x = pack2(lo16(o0.x) + lo16(t0.x) * sigm(acc[i][2 * jj][0] + b0.x) * lo16(g.x), hi16(o0.x) + hi16(t0.x) * sigm(acc[i][2 * jj][1] + b0.y) * hi16(g.x));
          o.y = pack2(lo16(o0.y) + lo16(t0.y) * sigm(acc[i][2 * jj][2] + b0.z) * lo16(g.y), hi16(o0.y) + hi16(t0.y) * sigm(acc[i][2 * jj][3] + b0.w) * hi16(g.y));
          o.z = pack2(lo16(o1.x) + lo16(t1.x) * sigm(acc[i][2 * jj + 1][0] + b1.x) * lo16(g.z), hi16(o1.x) + hi16(t1.x) * sigm(acc[i][2 * jj + 1][1] + b1.y) * hi16(g.z));
          o.w = pack2(lo16(o1.y) + lo16(t1.y) * sigm(acc[i][2 * jj + 1][2] + b1.z) * lo16(g.w), hi16(o1.y) + hi16(t1.y) * sigm(acc[i][2 * jj + 1][3] + b1.w) * hi16(g.w));
          *(uint4*)(MIX + (size_t)MROW(i) * 1024 + NCOL8(jj)) = o;
        }
      }
    }
  }
#undef MROW
#undef NCOL8
}

__device__ __forceinline__ void four_g1(const Params& p, int item, char* smem) {
  const int g = item & 3, s2 = (item >> 2) & 63, b = item >> 8;
  char* ws = p.ws;
  const bf16_t* Z = (const bf16_t*)(ws + W_Z) + ((size_t)b * SEQ + s2) * ZS + OFF_F + g * 64;
  const bf16_t* F1T = (const bf16_t*)(ws + W_F1T);
  f32x4 acc[2][4];
  zero_acc(acc);
  gemm_acc<128, 128, 4, 2, false>(64, [&](int r, int k) { return Z + (size_t)r * 64 * ZS + k; }, [&](int r, int k) { return F1T + r * 64 + k; }, smem, acc);
  const int lane = tidx() & 63, w = tidx() >> 6;
  const int mb = (w / 2) * 32, nb = (w % 2) * 64;
  bf16_t* U1T = (bf16_t*)(ws + W_U1T);
#pragma unroll
  for (int i = 0; i < 2; i++) {
    const int s1 = mb + i * 16 + (lane >> 4) * 4;
#pragma unroll
    for (int j = 0; j < 4; j++) {
      const int n = nb + j * 16 + (lane & 15), c = n >> 6, jj = n & 63;
      size_t off = ((((size_t)(b * 256 + g * 64 + jj) * 64 + s2) * 2 + c) * 128) + s1;
      *(uint2*)(U1T + off) = pack4(acc[i][j][0], acc[i][j][1], acc[i][j][2], acc[i][j][3]);
    }
  }
}
__device__ __forceinline__ void four_g2(const Params& p, int item, char* smem) {
  const int mt = item >> 1, nt = item & 1;
  const int m0 = mt * 128, n0 = nt * 128;
  char* ws = p.ws;
  const bf16_t* A = (const bf16_t*)(ws + W_U1T) + (size_t)m0 * 256;
  const bf16_t* B = (const bf16_t*)(ws + W_F2T) + (size_t)n0 * 256;
  f32x4 acc[2][4];
  zero_acc(acc);
  gemm_acc<128, 128, 4, 2, false>(256, [&](int r, int k) { return A + (size_t)r * 256 + k; }, [&](int r, int k) { return B + (size_t)r * 256 + k; }, smem, acc);
  const int lane = tidx() & 63, w = tidx() >> 6;
  const int mb = (w / 2) * 32, nb = (w % 2) * 64;
  const float* TW = (const float*)(ws + W_TW);
  bf16_t* A2T = (bf16_t*)(ws + W_A2T);
#pragma unroll
  for (int i = 0; i < 2; i++) {
    const int m = m0 + mb + i * 16 + (lane >> 4) * 4;
    const int s2 = m & 63, col = (m >> 6) & 255, b = m >> 14;
#pragma unroll
    for (int jp = 0; jp < 2; jp++) {
      const int nn = n0 + nb + jp * 32;
      const int k1 = (nn >> 5) * 16 + (lane & 15);
      float re[4], im[4];
#pragma unroll
      for (int r = 0; r < 4; r++) {
        float c = TW[((s2 + r) * 128 + k1) * 2], s = TW[((s2 + r) * 128 + k1) * 2 + 1];
        float ar = acc[i][jp * 2][r], ai = acc[i][jp * 2 + 1][r];
        re[r] = ar * c + ai * s;
        im[r] = ai * c - ar * s;
      }
      size_t off = ((size_t)(b * 128 + k1) * 256 + col) * 128 + s2;
      *(uint2*)(A2T + off) = pack4(re[0], re[1], re[2], re[3]);
      *(uint2*)(A2T + off + 64) = pack4(im[0], im[1], im[2], im[3]);
    }
  }
}
__device__ __forceinline__ void four_g3(const Params& p, int item, char* smem) {
  const int m0 = item * 128;
  char* ws = p.ws;
  const bf16_t* A = (const bf16_t*)(ws + W_A2T) + (size_t)m0 * 128;
  const bf16_t* B = (const bf16_t*)(ws + W_F3T);
  f32x4 acc[2][2];
  zero_acc(acc);
  gemm_acc<128, 64, 4, 2, false>(128, [&](int r, int k) { return A + (size_t)r * 128 + k; }, [&](int r, int k) { return B + r * 128 + k; }, smem, acc);
  const int lane = tidx() & 63, w = tidx() >> 6;
  const int mb = (w / 2) * 32, nb = (w % 2) * 32;
  bf16_t* YF = (bf16_t*)(ws + W_YF);
#pragma unroll
  for (int i = 0; i < 2; i++) {
    const int m = m0 + mb + i * 16 + (lane >> 4) * 4;
    const int col = m & 255, k1 = (m >> 8) & 127, b = m >> 15;
#pragma unroll
    for (int j = 0; j < 2; j++) {
      const int k2 = nb + j * 16 + (lane & 15);
      size_t off = ((size_t)b * SEQ + k1 + 128 * k2) * 256 + col;
      *(uint2*)(YF + off) = pack4(acc[i][j][0], acc[i][j][1], acc[i][j][2], acc[i][j][3]);
    }
  }
}

__device__ __forceinline__ void s5_e(const Params& p, int item, char* smem) {
  const int g = item >> 3, mt = (item >> 1) & 3, nt = item & 1;
  const int m0 = mt * 128, n0 = nt * 128;
  char* ws = p.ws;
  const bf16_t* Z = (const bf16_t*)(ws + W_Z) + OFF_S + g * 16;
  const bf16_t* B = (const bf16_t*)(ws + W_ET) + ((size_t)g * 256 + n0) * 512;
  f32x4 acc[2][4];
  zero_acc(acc);
  gemm_acc<128, 128, 4, 2, true>(512,
      [&](int r, int k) { int m = m0 + r; int tok = (m >> 8) * SEQ + (m & 255) * 32 + (k >> 4); return Z + (size_t)tok * ZS + (k & 15); },
      [&](int r, int k) { return B + (size_t)r * 512 + k; }, smem, acc);
  const int lane = tidx() & 63, w = tidx() >> 6;
  const int mb = (w / 2) * 32, nb = (w % 2) * 64;
  bf16_t* XE = (bf16_t*)(ws + W_XEND);
#pragma unroll
  for (int i = 0; i < 2; i++) {
    const int m = m0 + mb + i * 16 + (lane & 15);
#pragma unroll
    for (int j = 0; j < 4; j++) {
      const int n = n0 + nb + j * 16 + (lane >> 4) * 4;
      *(uint2*)(XE + ((size_t)m * 16 + g) * 256 + n) = pack4(acc[i][j][0], acc[i][j][1], acc[i][j][2], acc[i][j][3]);
    }
  }
}
__device__ __forceinline__ void s5_carry(const Params& p, int blk) {
  const int gt = blk * NT + tidx();
  const int b = gt >> 11, g = (gt >> 7) & 15, d = (gt >> 6) & 1, pp = gt & 63;
  char* ws = p.ws;
  const float* LP = (const float*)(ws + W_LPOW) + ((d * 16 + g) * 64 + pp) * 2;
  const float lr = LP[0], li = LP[1];
  const uint32_t* XE = (const uint32_t*)(ws + W_XEND);
  uint32_t* XC = (uint32_t*)(ws + W_XCAR);
  float xr = 0.f, xi = 0.f;
  for (int c0 = 0; c0 < 256; c0 += 32) {
    uint32_t v[32];
#pragma unroll
    for (int u = 0; u < 32; u++) {
      int c = d == 0 ? c0 + u : 255 - (c0 + u);
      v[u] = XE[(((size_t)(b * 256 + c) * 16 + g) * 256 + d * 128 + pp * 2) >> 1];
    }
#pragma unroll
    for (int u = 0; u < 32; u++) {
      int c = d == 0 ? c0 + u : 255 - (c0 + u);
      float nr = lr * xr - li * xi + lo16(v[u]);
      float ni = lr * xi + li * xr + hi16(v[u]);
      xr = nr; xi = ni;
      XC[(((size_t)(b * 256 + c) * 16 + g) * 256 + d * 128 + pp * 2) >> 1] = pack2(xr, xi);
    }
  }
}
__device__ __forceinline__ void s5_tg(const Params& p, int item, char* smem) {
  const int g = item >> 4, mt = (item >> 2) & 3, nt = item & 3;
  const int m0 = mt * 128, n0 = nt * 128;
  char* ws = p.ws;
  const bf16_t* Z = (const bf16_t*)(ws + W_Z) + OFF_S + g * 16;
  const bf16_t* XC = (const bf16_t*)(ws + W_XCAR);
  const bf16_t* ZR = (const bf16_t*)(ws + W_ZERO);
  const bf16_t* B = (const bf16_t*)(ws + W_TG) + ((size_t)g * 512 + n0) * 768;
  f32x4 acc[2][4];
  zero_acc(acc);
  gemm_acc<128, 128, 4, 2, true>(768,
      [&](int r, int k) -> const bf16_t* {
        int m = m0 + r; int b = m >> 8, c = m & 255;
        if (k < 512) { int tok = b * SEQ + c * 32 + (k >> 4); return Z + (size_t)tok * ZS + (k & 15); }
        int kk = k - 512; int d = kk >> 7; int cc = d == 0 ? c - 1 : c + 1;
        if (cc < 0 || cc > 255) return ZR;
        return XC + ((size_t)(b * 256 + cc) * 16 + g) * 256 + kk;
      },
      [&](int r, int k) { return B + (size_t)r * 768 + k; }, smem, acc);
  const int lane = tidx() & 63, w = tidx() >> 6;
  const int mb = (w / 2) * 32, nb = (w % 2) * 64;
  bf16_t* YS = (bf16_t*)(ws + W_YS);
#pragma unroll
  for (int i = 0; i < 2; i++) {
    const int m = m0 + mb + i * 16 + (lane & 15);
    const int b = m >> 8, c = m & 255;
#pragma unroll
    for (int j = 0; j < 4; j++) {
      const int n = n0 + nb + j * 16 + (lane >> 4) * 4;
      const int t = n >> 4, co = n & 15;
      size_t off = ((size_t)b * SEQ + c * 32 + t) * 256 + g * 16 + co;
      *(uint2*)(YS + off) = pack4(gelu_tanh(acc[i][j][0]), gelu_tanh(acc[i][j][1]), gelu_tanh(acc[i][j][2]), gelu_tanh(acc[i][j][3]));
    }
  }
}

__device__ __forceinline__ void conv8(const bf16_t* __restrict__ Z, const float* __restrict__ cw, const float* __restrict__ cb,
                                      int b, int s, int zcol, int ch, float (&o)[8]) {
  float4 b0 = *(const float4*)(cb + ch), b1 = *(const float4*)(cb + ch + 4);
  o[0] = b0.x; o[1] = b0.y; o[2] = b0.z; o[3] = b0.w; o[4] = b1.x; o[5] = b1.y; o[6] = b1.z; o[7] = b1.w;
#pragma unroll
  for (int wq = 0; wq < 5; wq++) {
    int ss = s + wq - 2;
    if (ss >= 0 && ss < SEQ) {
      uint4 v = *(const uint4*)(Z + ((size_t)b * SEQ + ss) * ZS + zcol);
      float4 w0 = *(const float4*)(cw + wq * 1024 + ch), w1 = *(const float4*)(cw + wq * 1024 + ch + 4);
      o[0] += w0.x * lo16(v.x); o[1] += w0.y * hi16(v.x); o[2] += w0.z * lo16(v.y); o[3] += w0.w * hi16(v.y);
      o[4] += w1.x * lo16(v.z); o[5] += w1.y * hi16(v.z); o[6] += w1.z * lo16(v.w); o[7] += w1.w * hi16(v.w);
    }
  }
#pragma unroll
  for (int e = 0; e < 8; e++) o[e] = o[e] * sigm(o[e]);
}

template <class OUT>
__device__ __forceinline__ void conv4x8(const bf16_t* __restrict__ Z, const float* __restrict__ cw, const float* __restrict__ cb,
                                        int b, int s0, int i0, int zcol, int ch, OUT out) {
  float wt[5][8], o[4][8];
  {
    float4 b0 = *(const float4*)(cb + ch), b1 = *(const float4*)(cb + ch + 4);
#pragma unroll
    for (int t = 0; t < 4; t++) { o[t][0] = b0.x; o[t][1] = b0.y; o[t][2] = b0.z; o[t][3] = b0.w; o[t][4] = b1.x; o[t][5] = b1.y; o[t][6] = b1.z; o[t][7] = b1.w; }
  }
#pragma unroll
  for (int wq = 0; wq < 5; wq++) {
    float4 w0 = *(const float4*)(cw + wq * 1024 + ch), w1 = *(const float4*)(cw + wq * 1024 + ch + 4);
    wt[wq][0] = w0.x; wt[wq][1] = w0.y; wt[wq][2] = w0.z; wt[wq][3] = w0.w; wt[wq][4] = w1.x; wt[wq][5] = w1.y; wt[wq][6] = w1.z; wt[wq][7] = w1.w;
  }
#pragma unroll
  for (int r = 0; r < 8; r++) {
    const int ss = s0 + i0 - 2 + r;
    uint4 v = make_uint4(0u, 0u, 0u, 0u);
    if (ss >= 0 && ss < SEQ) v = *(const uint4*)(Z + ((size_t)b * SEQ + ss) * ZS + zcol);
    float rf[8];
    rf[0] = lo16(v.x); rf[1] = hi16(v.x); rf[2] = lo16(v.y); rf[3] = hi16(v.y); rf[4] = lo16(v.z); rf[5] = hi16(v.z); rf[6] = lo16(v.w); rf[7] = hi16(v.w);
#pragma unroll
    for (int t = 0; t < 4; t++) {
      const int wq = r - t;
      if (wq >= 0 && wq < 5) {
#pragma unroll
        for (int e = 0; e < 8; e++) o[t][e] += wt[wq][e] * rf[e];
      }
    }
  }
#pragma unroll
  for (int t = 0; t < 4; t++) {
#pragma unroll
    for (int e = 0; e < 8; e++) o[t][e] = o[t][e] * sigm(o[t][e]);
    out(t, o[t]);
  }
}

__device__ __forceinline__ void mlstm_local(const Params& p, int l, int item, char* smem) {
  const int co = item & 63, h = (item >> 6) & 3, b = item >> 8;
  char* ws = p.ws;
  bf16_t* KTs = (bf16_t*)smem;
  bf16_t* VTs = KTs + 128 * LDT;
  float* WV = (float*)(VTs + 128 * LDT);
  const int tid = tidx(), lane = tid & 63, w = tid >> 6;
  const int tok0 = b * SEQ + co * 128;
  const bf16_t* Z = (const bf16_t*)(ws + W_Z);
  const float* ZG = (const float*)(ws + W_ZG);
  if (w < 2) {
    const int d = w, dbh = d * 8 + b * 4 + h, cp = d ? 63 - co : co;
    const int l0 = 2 * lane, l1 = l0 + 1;
    const int i0 = d ? 127 - l0 : l0, i1 = d ? 127 - l1 : l1;
    float ig0 = ZG[(size_t)(tok0 + i0) * 16 + d * 4 + h], ig1 = ZG[(size_t)(tok0 + i1) * 16 + d * 4 + h];
    float f0 = logsig(ZG[(size_t)(tok0 + i0) * 16 + 8 + d * 4 + h]), f1 = logsig(ZG[(size_t)(tok0 + i1) * 16 + 8 + d * 4 + h]);
    float s1 = f0 + f1;
    float incl = wave_incl_sum(s1, lane);
    float excl = incl - s1;
    float b0 = excl + f0, b1 = incl;
    float gtot = __shfl(incl, 63);
    float a0 = gtot - b0 + ig0, a1 = gtot - b1 + ig1;
    float am = wave_max(fmaxf(a0, a1));
    WV[d * 128 + i0] = expf(a0 - am);
    WV[d * 128 + i1] = expf(a1 - am);
    if (lane == 0) {
      ((float*)(ws + W_AMAX))[dbh * 64 + cp] = am;
      ((float*)(ws + W_G))[dbh * 64 + cp] = gtot;
    }
  }
  const float* cw = p.in[I_CW] + l * 5 * 1024;
  const float* cb = p.in[I_CB] + l * 1024;
#pragma unroll 1
  for (int t = 0; t < 4; t++) {
    int c = tid + t * NT, i = c & 127, d8 = (c >> 7) * 8;
    float o[8];
    conv8(Z, cw, cb, b, co * 128 + i, OFF_K + h * 128 + d8, 512 + h * 128 + d8, o);
#pragma unroll
    for (int e = 0; e < 8; e++) KTs[(d8 + e) * LDT + i] = f2bf(o[e]);
  }
  __syncthreads();
  if (tid < 256) {
    const int d = tid >> 7, k = tid & 127;
    const int dbh = d * 8 + b * 4 + h, cp = d ? 63 - co : co;
    float s = 0.f;
    for (int i = 0; i < 128; i++) s += WV[d * 128 + i] * bf2f(KTs[k * LDT + i]);
    ((float*)(ws + W_NST))[(size_t)(dbh * 64 + cp) * 128 + k] = s;
  }
  bf16_t* CST = (bf16_t*)(ws + W_CST);
  const int mb = (w / 2) * 32, nb = (w % 2) * 64;
#pragma unroll 1
  for (int d = 0; d < 2; d++) {
    const int dbh = d * 8 + b * 4 + h, cp = d ? 63 - co : co;
#pragma unroll 1
    for (int t = 0; t < 4; t++) {
      int c = tid + t * NT, i = c & 127, e8 = (c >> 7) * 8;
      uint4 v = *(const uint4*)(Z + (size_t)(tok0 + i) * ZS + OFF_V + h * 128 + e8);
      float wv = WV[d * 128 + i];
      VTs[(e8 + 0) * LDT + i] = f2bf(lo16(v.x) * wv); VTs[(e8 + 1) * LDT + i] = f2bf(hi16(v.x) * wv);
      VTs[(e8 + 2) * LDT + i] = f2bf(lo16(v.y) * wv); VTs[(e8 + 3) * LDT + i] = f2bf(hi16(v.y) * wv);
      VTs[(e8 + 4) * LDT + i] = f2bf(lo16(v.z) * wv); VTs[(e8 + 5) * LDT + i] = f2bf(hi16(v.z) * wv);
      VTs[(e8 + 6) * LDT + i] = f2bf(lo16(v.w) * wv); VTs[(e8 + 7) * LDT + i] = f2bf(hi16(v.w) * wv);
    }
    __syncthreads();
    f32x4 acc[2][4];
    zero_acc(acc);
    mma_lds<2, 4, false>(KTs, VTs, 128, mb, nb, acc);
    bf16_t* C = CST + (size_t)(dbh * 64 + cp) * 16384;
#pragma unroll
    for (int i = 0; i < 2; i++) {
      const int k = mb + i * 16 + (lane >> 4) * 4;
#pragma unroll
      for (int j = 0; j < 4; j++) {
        const int e = nb + j * 16 + (lane & 15);
        *(uint2*)(C + e * 128 + k) = pack4(acc[i][j][0], acc[i][j][1], acc[i][j][2], acc[i][j][3]);
      }
    }
    __syncthreads();
  }
}

__device__ __forceinline__ void mlstm_scan(const Params& p, int blk) {
  char* ws = p.ws;
  const float* AM = (const float*)(ws + W_AMAX);
  const float* G = (const float*)(ws + W_G);
  if (blk < 128) {
    const int gt = blk * NT + tidx(), dbh = gt >> 12, e4 = gt & 4095;
    uint2* C = (uint2*)(ws + W_CST) + (size_t)dbh * 64 * 4096 + e4;
    float m = 0.f, c0 = 0.f, c1 = 0.f, c2 = 0.f, c3 = 0.f;
    for (int cc0 = 0; cc0 < 64; cc0 += 16) {
      uint2 v[16];
      float gg[16], aa[16];
#pragma unroll
      for (int u = 0; u < 16; u++) { v[u] = C[(size_t)(cc0 + u) * 4096]; gg[u] = G[dbh * 64 + cc0 + u]; aa[u] = AM[dbh * 64 + cc0 + u]; }
#pragma unroll
      for (int u = 0; u < 16; u++) {
        const int cc = cc0 + u;
        float g = gg[u], am = aa[u];
        float mn = fmaxf(g + m, am);
        float so = __expf(g + m - mn), sn = __expf(am - mn);
        C[(size_t)cc * 4096] = pack4(c0, c1, c2, c3);
        if (e4 == 0) ((float*)(ws + W_MPREV))[dbh * 64 + cc] = m;
        c0 = so * c0 + sn * lo16(v[u].x); c1 = so * c1 + sn * hi16(v[u].x);
        c2 = so * c2 + sn * lo16(v[u].y); c3 = so * c3 + sn * hi16(v[u].y);
        m = mn;
      }
    }
  } else {
    const int gt = (blk - 128) * NT + tidx(), dbh = gt >> 7, k = gt & 127;
    float* N = (float*)(ws + W_NST) + (size_t)dbh * 64 * 128 + k;
    float m = 0.f, n = 0.f;
    for (int cc = 0; cc < 64; cc++) {
      float g = G[dbh * 64 + cc], am = AM[dbh * 64 + cc];
      float mn = fmaxf(g + m, am);
      float so = expf(g + m - mn), sn = expf(am - mn);
      float v = N[cc * 128];
      N[cc * 128] = n;
      n = so * n + sn * v;
      m = mn;
    }
  }
}

__device__ __forceinline__ void mlstm_out(const Params& p, int l, int item, char* smem) {
  const int co = item & 63, h = (item >> 6) & 3, b = item >> 8;
  char* ws = p.ws;
  bf16_t* B0 = (bf16_t*)smem;
  bf16_t* B1 = B0 + 128 * LDT;
  bf16_t* B2 = B1 + 128 * LDT;
  bf16_t* B3 = B2 + 128 * LDT;
  float* FU = (float*)(B3 + 128 * LDT);
  float* FMM = FU + 256;
  float* FIW = FMM + 256;
  float* FEN = FIW + 256;
  float* FNP = FEN + 256;
  const int tid = tidx(), lane = tid & 63, w = tid >> 6;
  const int tok0 = b * SEQ + co * 128;
  const bf16_t* Z = (const bf16_t*)(ws + W_Z);
  const float* ZG = (const float*)(ws + W_ZG);
  const bf16_t* C0p = (const bf16_t*)(ws + W_CST) + (size_t)((0 * 8 + b * 4 + h) * 64 + co) * 16384;
  const bf16_t* C1p = (const bf16_t*)(ws + W_CST) + (size_t)((1 * 8 + b * 4 + h) * 64 + (63 - co)) * 16384;
#define PFV(t) (*(const uint4*)(Z + (size_t)(tok0 + ((tid + (t) * NT) & 127)) * ZS + OFF_V + h * 128 + ((tid + (t) * NT) >> 7) * 8))
#define PFC(P, t) (*(const uint4*)((P) + ((tid + (t) * NT) >> 4) * 128 + ((tid + (t) * NT) & 15) * 8))
  const uint4 vp0 = PFV(0), vp1 = PFV(1), vp2 = PFV(2), vp3 = PFV(3);
  const uint4 ca0 = PFC(C0p, 0), ca1 = PFC(C0p, 1), ca2 = PFC(C0p, 2), ca3 = PFC(C0p, 3);
  const uint4 cb0 = PFC(C1p, 0), cb1 = PFC(C1p, 1), cb2 = PFC(C1p, 2), cb3 = PFC(C1p, 3);
#undef PFV
#undef PFC
  if (w < 2) {
    const int d = w, dbh = d * 8 + b * 4 + h, cp = d ? 63 - co : co;
    const float mprev = ((const float*)(ws + W_MPREV))[dbh * 64 + cp];
    const int l0 = 2 * lane, l1 = l0 + 1;
    const int i0 = d ? 127 - l0 : l0, i1 = d ? 127 - l1 : l1;
    float ig0 = ZG[(size_t)(tok0 + i0) * 16 + d * 4 + h], ig1 = ZG[(size_t)(tok0 + i1) * 16 + d * 4 + h];
    float f0 = logsig(ZG[(size_t)(tok0 + i0) * 16 + 8 + d * 4 + h]), f1 = logsig(ZG[(size_t)(tok0 + i1) * 16 + 8 + d * 4 + h]);
    float s1 = f0 + f1;
    float incl = wave_incl_sum(s1, lane);
    float b0 = incl - s1 + f0, b1 = incl;
    float u0 = ig0 - b0, u1 = ig1 - b1;
    float pm1 = fmaxf(u0, u1);
    float inclm = wave_incl_max(pm1, lane);
    float exclm = __shfl_up(inclm, 1);
    if (lane == 0) exclm = -INFINITY;
    float r0 = fmaxf(exclm, u0), r1 = fmaxf(exclm, pm1);
    float mm0 = fmaxf(mprev, r0), mm1 = fmaxf(mprev, r1);
    FU[d * 128 + i0] = u0; FU[d * 128 + i1] = u1;
    FMM[d * 128 + i0] = mm0; FMM[d * 128 + i1] = mm1;
    FIW[d * 128 + i0] = expf(mprev - mm0); FIW[d * 128 + i1] = expf(mprev - mm1);
    FEN[d * 128 + i0] = expf(-(b0 + mm0)); FEN[d * 128 + i1] = expf(-(b1 + mm1));
  }
  if (tid < 256) {
    const int d = tid >> 7, k = tid & 127;
    const int dbh = d * 8 + b * 4 + h, cp = d ? 63 - co : co;
    FNP[tid] = ((const float*)(ws + W_NST))[(size_t)(dbh * 64 + cp) * 128 + k];
  }
  const float* cw = p.in[I_CW] + l * 5 * 1024;
  const float* cb = p.in[I_CB] + l * 1024;
  const float qscale = 0.08838834764831845f;
  const int mb = w * 16;
  const int irow = mb + (lane & 15);
  f32x4 hf[8];
  {
    const int d8 = (tid & 15) * 8, i0 = (tid >> 4) * 4;
    conv4x8(Z, cw, cb, b, co * 128, i0, h * 128 + d8, h * 128 + d8, [&](int t, const float (&o)[8]) {
      uint4 q;
      q.x = pack2(o[0] * qscale, o[1] * qscale); q.y = pack2(o[2] * qscale, o[3] * qscale);
      q.z = pack2(o[4] * qscale, o[5] * qscale); q.w = pack2(o[6] * qscale, o[7] * qscale);
      *(uint4*)&B0[(i0 + t) * LDT + d8] = q;
    });
    conv4x8(Z, cw, cb, b, co * 128, i0, OFF_K + h * 128 + d8, 512 + h * 128 + d8, [&](int t, const float (&o)[8]) {
      uint4 q;
      q.x = pack2(o[0], o[1]); q.y = pack2(o[2], o[3]); q.z = pack2(o[4], o[5]); q.w = pack2(o[6], o[7]);
      *(uint4*)&B1[(i0 + t) * LDT + d8] = q;
    });
  }
  __syncthreads();
  f32x4 accS[1][8];
  zero_acc(accS);
  mma_lds<1, 8, true>(B0, B1, 128, mb, 0, accS);
  float qn0 = 0.f, qn1 = 0.f;
  {
    const int kq0 = (lane >> 4) * 32;
#pragma unroll 8
    for (int k = 0; k < 32; k++) { float qv = bf2f(B0[irow * LDT + kq0 + k]); qn0 += qv * FNP[kq0 + k]; qn1 += qv * FNP[128 + kq0 + k]; }
  }
  qn0 += __shfl_xor(qn0, 16); qn0 += __shfl_xor(qn0, 32);
  qn1 += __shfl_xor(qn1, 16); qn1 += __shfl_xor(qn1, 32);
  __syncthreads();
#define VTS(t, v)                                                                                         \
  {                                                                                                       \
    const int c_ = tid + (t) * NT, j_ = c_ & 127, e8_ = (c_ >> 7) * 8;                                    \
    B1[(e8_ + 0) * LDT + j_] = (bf16_t)((v).x & 0xffff); B1[(e8_ + 1) * LDT + j_] = (bf16_t)((v).x >> 16); \
    B1[(e8_ + 2) * LDT + j_] = (bf16_t)((v).y & 0xffff); B1[(e8_ + 3) * LDT + j_] = (bf16_t)((v).y >> 16); \
    B1[(e8_ + 4) * LDT + j_] = (bf16_t)((v).z & 0xffff); B1[(e8_ + 5) * LDT + j_] = (bf16_t)((v).z >> 16); \
    B1[(e8_ + 6) * LDT + j_] = (bf16_t)((v).w & 0xffff); B1[(e8_ + 7) * LDT + j_] = (bf16_t)((v).w >> 16); \
  }
  VTS(0, vp0) VTS(1, vp1) VTS(2, vp2) VTS(3, vp3)
#undef VTS
#define CST_(t, v) { const int c_ = tid + (t) * NT; *(uint4*)&B3[(c_ >> 4) * LDT + (c_ & 15) * 8] = (v); }
#pragma unroll
  for (int d = 0; d < 2; d++) {
    if (d == 0) { CST_(0, ca0) CST_(1, ca1) CST_(2, ca2) CST_(3, ca3) }
    else { CST_(0, cb0) CST_(1, cb1) CST_(2, cb2) CST_(3, cb3) }
    const float mmi = FMM[d * 128 + irow];
    float rowsum = 0.f;
#pragma unroll
    for (int jt = 0; jt < 8; jt++) {
      const int j0 = jt * 16 + (lane >> 4) * 4;
      float pv[4];
#pragma unroll
      for (int r = 0; r < 4; r++) {
        const int j = j0 + r;
        const bool ok = d ? (j >= irow) : (j <= irow);
        float e = ok ? accS[0][jt][r] * __expf(FU[d * 128 + j] - mmi) : 0.f;
        pv[r] = e; rowsum += e;
      }
      *(uint2*)&B2[irow * LDT + j0] = pack4(pv[0], pv[1], pv[2], pv[3]);
    }
    rowsum += __shfl_xor(rowsum, 16); rowsum += __shfl_xor(rowsum, 32);
    const float iw = FIW[d * 128 + irow];
    const float den = rowsum + iw * (d ? qn1 : qn0);
    __syncthreads();
    f32x4 acc[1][8];
    zero_acc(acc);
    mma_lds<1, 8, true>(B0, B3, 128, mb, 0, acc);
#pragma unroll
    for (int jt = 0; jt < 8; jt++) { acc[0][jt][0] *= iw; acc[0][jt][1] *= iw; acc[0][jt][2] *= iw; acc[0][jt][3] *= iw; }
    mma_lds<1, 8, true>(B2, B1, 128, mb, 0, acc);
    const float dn = 1.f / fmaxf(fabsf(den), FEN[d * 128 + irow]);
    if (d == 0) {
#pragma unroll
      for (int jt = 0; jt < 8; jt++) hf[jt] = acc[0][jt] * dn;
      __syncthreads();
    } else {
#pragma unroll
      for (int jt = 0; jt < 8; jt++) hf[jt] += acc[0][jt] * dn;
    }
  }
#undef CST_
  float s = 0.f;
#pragma unroll
  for (int jt = 0; jt < 8; jt++) s += hf[jt][0] + hf[jt][1] + hf[jt][2] + hf[jt][3];
  s += __shfl_xor(s, 16); s += __shfl_xor(s, 32);
  const float mu = s * (1.f / 128.f);
  float v = 0.f;
#pragma unroll
  for (int jt = 0; jt < 8; jt++)
#pragma unroll
    for (int r = 0; r < 4; r++) { float dd = hf[jt][r] - mu; v += dd * dd; }
  v += __shfl_xor(v, 16); v += __shfl_xor(v, 32);
  const float rs = rsqrtf(v * (1.f / 128.f) + EPS);
  const float* ng = p.in[I_MNG] + l * 512 + h * 128;
  bf16_t* HM = (bf16_t*)(ws + W_HM);
  const size_t tok = (size_t)tok0 + irow;
#pragma unroll
  for (int jt = 0; jt < 8; jt++) {
    const int e = jt * 16 + (lane >> 4) * 4;
    float4 gv = *(const float4*)(ng + e);
    uint2 zo = *(const uint2*)(Z + tok * ZS + OFF_O + h * 128 + e);
    float o0 = (hf[jt][0] - mu) * rs * gv.x * sigm(lo16(zo.x));
    float o1 = (hf[jt][1] - mu) * rs * gv.y * sigm(hi16(zo.x));
    float o2 = (hf[jt][2] - mu) * rs * gv.z * sigm(lo16(zo.y));
    float o3 = (hf[jt][3] - mu) * rs * gv.w * sigm(hi16(zo.y));
    *(uint2*)(HM + tok * 512 + h * 128 + e) = pack4(o0, o1, o2, o3);
  }
  __syncthreads();
}

#define XB_TMO      128
#define XB_XCNT(j)  (256  + 64 * (j))
#define XB_XSUB(j)  (1280 + 64 * (j))
#define XB_XGEN(j)  (2304 + 64 * (j))
#define XB_TOP      3328
#define XB_TOPGEN   3392
#define XCD_BAR_WORDS 3456
#define XB_SPIN_CAP (1u << 22)
#define LAS __attribute__((address_space(3)))
__device__ __forceinline__ unsigned xb_ld(unsigned* p) { return __hip_atomic_load(p, __ATOMIC_RELAXED, __HIP_MEMORY_SCOPE_AGENT); }
__device__ __forceinline__ unsigned xb_add(unsigned* p, unsigned v) { return __hip_atomic_fetch_add(p, v, __ATOMIC_RELAXED, __HIP_MEMORY_SCOPE_AGENT); }
__device__ __forceinline__ unsigned xb_xcc_id() { return (unsigned)__builtin_amdgcn_s_getreg((3 << 11) | 20) & 0xFu; }
#define XB_SPIN(cond, bar) do { unsigned _sp = 0; while (cond) { __builtin_amdgcn_s_sleep(1); \
    if ((++_sp & 255u) == 0u) { if (xb_ld(&(bar)[XB_TMO])) break; if (_sp > XB_SPIN_CAP) { atomicAdd(&(bar)[XB_TMO], 1u); break; } } } } while (0)
struct XcdBarrier { unsigned* bar; unsigned x; volatile LAS unsigned* st; };
__device__ __forceinline__ XcdBarrier xcd_barrier_post(unsigned* bar, volatile LAS unsigned* st) {
  XcdBarrier b; b.bar = bar; b.x = xb_xcc_id(); b.st = st;
  if (threadIdx.x == 0) (void)xb_add(&bar[XB_XCNT(b.x)], 1u);
  return b;
}
__device__ __forceinline__ void xcd_barrier_complete(unsigned* bar, unsigned x, unsigned& nloc, unsigned& nx) {
  const unsigned G = gridDim.x * gridDim.y * gridDim.z;
  unsigned sum, cnt, mine, sp = 0u;
  for (;;) {
    sum = 0u; cnt = 0u; mine = 0u;
#pragma unroll
    for (unsigned j = 0; j < 16; ++j) { const unsigned c = xb_ld(&bar[XB_XCNT(j)]); sum += c; cnt += (c > 0u) ? 1u : 0u; mine = (j == x) ? c : mine; }
    if (sum == G) break;
    __builtin_amdgcn_s_sleep(1);
    if ((++sp & 255u) == 0u) { if (xb_ld(&bar[XB_TMO])) break; if (sp > XB_SPIN_CAP) { atomicAdd(&bar[XB_TMO], 1u); break; } }
  }
  nloc = mine > 0u ? mine : 1u; nx = cnt > 0u ? cnt : 1u;
}
__device__ __forceinline__ void xcd_barrier(const XcdBarrier& b) {
  asm volatile("s_waitcnt vmcnt(0)" ::: "memory");
  __syncthreads();
  if (threadIdx.x == 0) {
    unsigned* bar = b.bar;
    __builtin_amdgcn_s_waitcnt(0);
    unsigned nloc = b.st[0], nx = b.st[1];
    if (nloc == 0u) { xcd_barrier_complete(bar, b.x, nloc, nx); b.st[0] = nloc; b.st[1] = nx; }
    const unsigned old = xb_add(&bar[XB_XSUB(b.x)], 1u);
    const unsigned gen = old / nloc;
    if (old + 1u == (gen + 1u) * nloc) {
      __builtin_amdgcn_fence(__ATOMIC_RELEASE, "agent");
      asm volatile("s_waitcnt vmcnt(0)" ::: "memory");
      const unsigned og = xb_add(&bar[XB_TOP], 1u);
      const unsigned tg = og / nx;
      if (og + 1u == (tg + 1u) * nx) xb_add(&bar[XB_TOPGEN], 1u);
      else XB_SPIN(xb_ld(&bar[XB_TOPGEN]) == tg, bar);
      __builtin_amdgcn_fence(__ATOMIC_ACQUIRE, "agent");
      xb_add(&bar[XB_XGEN(b.x)], 1u);
      asm volatile("s_waitcnt vmcnt(0)" ::: "memory");
    } else {
      XB_SPIN(xb_ld(&bar[XB_XGEN(b.x)]) == gen, bar);
      __builtin_amdgcn_fence(__ATOMIC_ACQUIRE, "agent");
      asm volatile("s_waitcnt vmcnt(0)" ::: "memory");
    }
  }
  __syncthreads();
}

namespace pg8 {
#define PG8_LAS __attribute__((address_space(3)))
typedef unsigned short bf16_t;
typedef short bf16x8 __attribute__((ext_vector_type(8)));
typedef float f32x4 __attribute__((ext_vector_type(4)));
typedef unsigned u32x4 __attribute__((ext_vector_type(4)));
constexpr int BM = 256, BK = 64, HALF = 128, HTB = HALF * BK * 2  , STAGE_BYTES = 8 * HTB, NXCD = 8, WGM = 8;

__host__ __device__ __forceinline__ int lds_byte(int r, int c) { const int st = (r >> 4) * 2 + (c >> 5), rr = r & 15, cc = c & 31, ob = rr * 64 + cc * 2; return st * 1024 + (ob ^ (((ob >> 9) & 1) << 5)); }
__host__ __device__ __forceinline__ void stage_rc(int b, int& R, int& C) { const int st = b / 1024, sb = b % 1024, swz = sb ^ (((sb >> 9) & 1) << 5); R = (st >> 1) * 16 + swz / 64; C = (st & 1) * 32 + (swz % 64) / 2; }
__host__ __device__ __forceinline__ int perm32(int rho) { const int n = rho >> 4, i = rho & 15; return 8 * (i >> 2) + 4 * n + (i & 3); }

struct Unit { int pm, pn; };
struct Gemm { const bf16_t* A; const bf16_t* Bt; int M, N, K; };

struct StaticOrder {
    int nM, nN, nwg, G, c;
    __host__ __device__ void init(int M, int N, int G_, int c_) { nM = M / BM; nN = N / BM; nwg = nM * nN; G = G_; c = c_; }
    __host__ __device__ bool next(int i, Unit& u) const {
        const long L = (long)i * G + c; if (L >= nwg) return false;
        int wgid = (int)L; { const int q = nwg / NXCD, r = nwg % NXCD, xcd = wgid % NXCD, off = wgid / NXCD; wgid = (xcd < r ? xcd * (q + 1) : r * (q + 1) + (xcd - r) * q) + off; }
        const int nig = WGM * nN, gid = wgid / nig, fm = gid * WGM, gsz = (nM - fm) < WGM ? (nM - fm) : WGM;
        u.pm = fm + ((wgid % nig) % gsz); u.pn = (wgid % nig) / gsz; return true;
    }
    __device__ __forceinline__ void a_ready(const Unit&) const {}
    __device__ __forceinline__ void done(const Unit&) const {}
};

template <int MODE> struct EpiAct {
    static constexpr bool PERM = true, AFTER_DRAIN = false;
    bf16_t* O; int ldc; const float* bias;
    __device__ __forceinline__ unsigned pk(float lo, float hi) const {
        unsigned a = __float_as_uint(lo), b = __float_as_uint(hi);
        a += 0x7fffu + ((a >> 16) & 1u); b += 0x7fffu + ((b >> 16) & 1u);
        return (a >> 16) | (b & 0xffff0000u);
    }
    __device__ __forceinline__ float act(float v) const {
        if (MODE == 1) { v = fmaxf(v, 0.f); return v * v; }
        if (MODE == 2) return __frcp_rn(1.f + __expf(-v));
        return v;
    }
    __device__ __forceinline__ void operator()(const f32x4 (&acc)[2][2][4][2], const Unit& u, int wr, int wc, int fr, int fq) const {
        const int row0 = u.pm * BM + wr * 64 + fr, col0 = u.pn * BM + wc * 32 + 8 * fq;
        f32x4 bv[2][2];
#pragma unroll
        for (int bj = 0; bj < 2; ++bj)
#pragma unroll
            for (int n = 0; n < 2; ++n) bv[bj][n] = (MODE >= 2) ? *(const f32x4*)(bias + col0 + bj * HALF + 4 * n) : (f32x4){0.f, 0.f, 0.f, 0.f};
#pragma unroll
        for (int ai = 0; ai < 2; ++ai)
#pragma unroll
            for (int m = 0; m < 4; ++m) { bf16_t* rowp = O + (size_t)(row0 + ai * HALF + m * 16) * ldc + col0;
#pragma unroll
                for (int bj = 0; bj < 2; ++bj) { const f32x4 v0 = acc[ai][bj][m][0] + bv[bj][0], v1 = acc[ai][bj][m][1] + bv[bj][1];
                    u32x4 w; w.x = pk(act(v0[0]), act(v0[1])); w.y = pk(act(v0[2]), act(v0[3])); w.z = pk(act(v1[0]), act(v1[1])); w.w = pk(act(v1[2]), act(v1[3]));
                    *(u32x4*)(rowp + bj * HALF) = w; } }
    }
};

template <class Epi, class Sched, bool STAMP = false>
__device__ __forceinline__ void gemm_phase(PG8_LAS unsigned char* lds, const Gemm g, const Sched& S, const Epi& E, unsigned long long* stamps) {
    const int tid = tidx(), wid = __builtin_amdgcn_readfirstlane(tid >> 6), lane = tid & 63, wr = wid >> 2, wc = wid & 3, fr = lane & 15, fq = lane >> 4;
    const int K = g.K, nt = K / BK;
    int ts_lo = 0, ts_hi = 0, nts = 0; const unsigned long long rt_entry = STAMP ? (unsigned long long)wall_clock64() : 0ull;
#define PG8_STAMP() do { if (STAMP && wid == 0 && nts < 64) { const unsigned long long _c = (unsigned long long)clock64(); \
        ts_lo = (lane == nts) ? (int)(unsigned)_c : ts_lo; ts_hi = (lane == nts) ? (int)(unsigned)(_c >> 32) : ts_hi; ++nts; } } while (0)
    PG8_STAMP();
    unsigned voffA[2], voffB[2];
#pragma unroll
    for (int i = 0; i < 2; ++i) { int R, C; stage_rc(tid * 16 + i * 8192, R, C); const int Rb = Epi::PERM ? ((R & ~31) + perm32(R & 31)) : R;
        voffA[i] = (unsigned)(R * K + C) * 2u; voffB[i] = (unsigned)(Rb * K + C) * 2u; }
    const size_t kstep = (size_t)(BK * 2);
    const size_t hstep = (size_t)HALF * K * 2;
    const size_t tstep = 2 * hstep;
    const unsigned ldsw = (unsigned)wid * 1024u;
    const int aoff = lds_byte(wr * 64 + fr, fq * 8), boff = lds_byte(wc * 32 + fr, fq * 8);
#define PG8_SA(b, h) (((b) * 2 + (h)) * HTB)
#define PG8_SB(b, h) ((4 + (b) * 2 + (h)) * HTB)
#define PG8_STAGE(bufoff, gbase, voff) do { _Pragma("unroll") for (int _i = 0; _i < 2; ++_i) \
        __builtin_amdgcn_global_load_lds((const unsigned*)((const char*)(gbase) + (voff)[_i]), (PG8_LAS unsigned*)(lds + (bufoff) + ldsw + _i * 8192), 16, 0, 0); } while (0)
#define PG8_LDA(dst, b, h) do { _Pragma("unroll") for (int m = 0; m < 4; ++m) _Pragma("unroll") for (int k = 0; k < 2; ++k) dst[m][k] = *(const PG8_LAS bf16x8*)(lds + PG8_SA(b, h) + aoff + m * 2048 + k * 1024); } while (0)
#define PG8_LDB(dst, b, h) do { _Pragma("unroll") for (int n = 0; n < 2; ++n) _Pragma("unroll") for (int k = 0; k < 2; ++k) dst[n][k] = *(const PG8_LAS bf16x8*)(lds + PG8_SB(b, h) + boff + n * 2048 + k * 1024); } while (0)
#define PG8_MMA(ai, bj, At, Bt) do { __builtin_amdgcn_s_setprio(1); _Pragma("unroll") for (int m = 0; m < 4; ++m) _Pragma("unroll") for (int n = 0; n < 2; ++n) _Pragma("unroll") for (int k = 0; k < 2; ++k) \
        acc[ai][bj][m][n] = __builtin_amdgcn_mfma_f32_16x16x32_bf16(Bt[n][k], At[m][k], acc[ai][bj][m][n], 0, 0, 0); __builtin_amdgcn_s_setprio(0); } while (0)
#define PG8_WAIT_V(n) asm volatile("s_waitcnt vmcnt(" #n ")" ::: "memory")
#define PG8_WAIT_L(n) asm volatile("s_waitcnt lgkmcnt(" #n ")" ::: "memory")
#define PG8_BAR __builtin_amdgcn_s_barrier()
#define PG8_SCHED __builtin_amdgcn_sched_barrier(0)
    Unit cur, nxt; int ui = 0;
    if (!S.next(0, cur)) return;
    f32x4 acc[2][2][4][2];
#pragma unroll
    for (int a = 0; a < 2; ++a)
#pragma unroll
        for (int b = 0; b < 2; ++b)
#pragma unroll
            for (int m = 0; m < 4; ++m)
#pragma unroll
                for (int n = 0; n < 2; ++n) acc[a][b][m][n] = (f32x4){0.f, 0.f, 0.f, 0.f};
    bf16x8 At[4][2], B0[2][2], B1[2][2];
    const char* cA = (const char*)g.A + (size_t)cur.pm * tstep; const char* cB = (const char*)g.Bt + (size_t)cur.pn * tstep;
    S.a_ready(cur);
    PG8_STAGE(PG8_SB(0, 0), cB, voffB); PG8_STAGE(PG8_SA(0, 0), cA, voffA); PG8_STAGE(PG8_SB(0, 1), cB + hstep, voffB); PG8_STAGE(PG8_SA(0, 1), cA + hstep, voffA);
    if (wr == 1) PG8_BAR;
    PG8_WAIT_V(4); PG8_BAR;
    PG8_STAGE(PG8_SB(1, 0), cB + kstep, voffB); PG8_STAGE(PG8_SA(1, 0), cA + kstep, voffA); PG8_STAGE(PG8_SB(1, 1), cB + hstep + kstep, voffB);
    PG8_WAIT_V(6); PG8_BAR;
    PG8_STAMP();
    for (;;) {
        const bool has_next = S.next(ui + 1, nxt);
        const char* nA = has_next ? (const char*)g.A + (size_t)nxt.pm * tstep : cA; const char* nB = has_next ? (const char*)g.Bt + (size_t)nxt.pn * tstep : cB;
        for (int t = 0; t < nt; t += 2) {
            const bool last = (t == nt - 2);
            const char* a1 = cA + (size_t)(t + 1) * kstep;
            const char* a2 = last ? nA : cA + (size_t)(t + 2) * kstep; const char* b2 = last ? nB : cB + (size_t)(t + 2) * kstep;
            const char* a3 = a2 + kstep; const char* b3 = b2 + kstep;
            if (last && has_next) S.a_ready(nxt);
            PG8_LDB(B0, 0, 0); PG8_SCHED; PG8_LDA(At, 0, 0); PG8_STAGE(PG8_SA(1, 1), a1 + hstep, voffA);
            PG8_WAIT_L(8); PG8_BAR; PG8_WAIT_L(0); PG8_MMA(0, 0, At, B0); PG8_BAR; PG8_SCHED;
            PG8_LDB(B1, 0, 1); PG8_STAGE(PG8_SB(0, 0), b2, voffB);
            PG8_BAR; PG8_WAIT_L(0); PG8_MMA(0, 1, At, B1); PG8_BAR;
            PG8_LDA(At, 0, 1); PG8_STAGE(PG8_SA(0, 0), a2, voffA);
            PG8_BAR; PG8_WAIT_L(0); PG8_MMA(1, 0, At, B0); PG8_BAR; PG8_SCHED;
            PG8_STAGE(PG8_SB(0, 1), b2 + hstep, voffB);
            PG8_WAIT_V(6); PG8_BAR; PG8_MMA(1, 1, At, B1); PG8_BAR;
            PG8_LDB(B0, 1, 0); PG8_SCHED; PG8_LDA(At, 1, 0); PG8_STAGE(PG8_SA(0, 1), a2 + hstep, voffA);
            PG8_WAIT_L(8); PG8_BAR; PG8_WAIT_L(0); PG8_MMA(0, 0, At, B0); PG8_BAR; PG8_SCHED;
            PG8_LDB(B1, 1, 1); PG8_STAGE(PG8_SB(1, 0), b3, voffB);
            PG8_BAR; PG8_WAIT_L(0); PG8_MMA(0, 1, At, B1); PG8_BAR;
            PG8_LDA(At, 1, 1); PG8_STAGE(PG8_SA(1, 0), a3, voffA);
            PG8_BAR; PG8_WAIT_L(0); PG8_MMA(1, 0, At, B0); PG8_BAR; PG8_SCHED;
            PG8_STAGE(PG8_SB(1, 1), b3 + hstep, voffB);
            PG8_WAIT_V(6); PG8_BAR; PG8_MMA(1, 1, At, B1); PG8_BAR;
        }
        PG8_STAMP();
        if constexpr (!Epi::AFTER_DRAIN) { E(acc, cur, wr, wc, fr, fq); S.done(cur); }
        PG8_STAMP();
        if (!has_next) break;
#pragma unroll
        for (int a = 0; a < 2; ++a)
#pragma unroll
            for (int b = 0; b < 2; ++b)
#pragma unroll
                for (int m = 0; m < 4; ++m)
#pragma unroll
                    for (int n = 0; n < 2; ++n) acc[a][b][m][n] = (f32x4){0.f, 0.f, 0.f, 0.f};
        cur = nxt; cA = nA; cB = nB; ++ui;
    }
    PG8_WAIT_V(0);
    if (wr == 0) PG8_BAR;
    PG8_BAR;
    if constexpr (Epi::AFTER_DRAIN) { E.fused(acc, cur, wr, wc, fr, fq, lds, wid, lane); S.done(cur); }
    PG8_STAMP();
    if (STAMP && wid == 0) { stamps[lane] = lane < nts ? (((unsigned long long)(unsigned)ts_hi << 32) | (unsigned)ts_lo) : 0ull;
        if (lane == 62) stamps[62] = rt_entry; if (lane == 63) stamps[63] = (unsigned long long)wall_clock64(); }
#undef PG8_STAMP
#undef PG8_SA
#undef PG8_SB
#undef PG8_STAGE
#undef PG8_LDA
#undef PG8_LDB
#undef PG8_MMA
#undef PG8_WAIT_V
#undef PG8_WAIT_L
#undef PG8_BAR
#undef PG8_SCHED
}
}

#ifndef ONLY_PH
#define ONLY_PH -1
#endif
#define PHEN(x) (ONLY_PH < 0 || ONLY_PH == (x))
constexpr int NPL = 11;
constexpr int NPH = 2 * NPL + 1;

__device__ __forceinline__ void run_phase(const Params& p, int ph, char* smem) {
  const int l = ph / NPL, q = ph % NPL;
  const int bid = blockIdx.x, nb = gridDim.x;
  char* ws = p.ws;
  if (PHEN(11) && ph == NPH - 1) {
    for (int it = bid; it < 2048; it += nb) rms_item(p, 2, 1, it);
    return;
  }
  switch (q) {
    case 0: if (!PHEN(0)) break; {
      const int n_tab = (l == 0) ? 32 : 0;
      const int n_kt = (l == 0) ? 256 : 0;
      const int total = n_kt + n_tab + N_TR + 2048;
      for (int it = bid; it < total; it += nb) {
        int i = it;
        if (i < n_kt) { s5_kt(p, i, smem); continue; }
        i -= n_kt;
        if (i < n_tab) { gen_tables(p, i); continue; }
        i -= n_tab;
        if (i < N_TR) { transpose_item(p, l, i, smem); continue; }
        i -= N_TR;
        if (l == 0) rms_item(p, 0, 0, i); else rms_item(p, 2, l - 1, i);
      }
    } break;
    case 1: if (!PHEN(1)) break;
      {
        const float* bin = p.in[I_BIN] + l * NIN;
        {
          pg8::Gemm g{(const pg8::bf16_t*)(ws + W_HBF), (const pg8::bf16_t*)(ws + W_WIN), TOK, 2048, 1024};
          pg8::StaticOrder S; S.init(TOK, 2048, (int)gridDim.x, (int)blockIdx.x);
          pg8::EpiAct<3> E{(pg8::bf16_t*)(ws + W_Z), ZS, bin};
          pg8::gemm_phase<pg8::EpiAct<3>, pg8::StaticOrder, false>((PG8_LAS unsigned char*)smem, g, S, E, nullptr);
        }
        {
          pg8::Gemm g{(const pg8::bf16_t*)(ws + W_HBF), (const pg8::bf16_t*)(ws + W_WIN) + (size_t)2064 * 1024, TOK, 512, 1024};
          pg8::StaticOrder S; S.init(TOK, 512, (int)gridDim.x, (int)blockIdx.x);
          pg8::EpiAct<3> E{(pg8::bf16_t*)(ws + W_Z) + 2048, ZS, bin + 2064};
          pg8::gemm_phase<pg8::EpiAct<3>, pg8::StaticOrder, false>((PG8_LAS unsigned char*)smem, g, S, E, nullptr);
        }
        const int hb = nb / 2;
        if (bid >= hb) {
          for (int it = bid - hb; it < 64 + 128; it += nb - hb) {
            if (it < 64) ingate_item(p, l, it, smem);
            else s5_fill(p, l, it - 64, smem);
          }
        }
      }
      break;
    case 2: if (!PHEN(2)) break;
      for (int it = bid; it < 512 + 128 + 512; it += nb) {
        if (it < 512) mlstm_local(p, l, it, smem);
        else if (it < 640) s5_e(p, it - 512, smem);
        else four_g1(p, it - 640, smem);
      }
      break;
    case 3: if (!PHEN(3)) break;
      for (int it = bid; it < 8 + 132 + 512; it += nb) {
        if (it < 8) s5_carry(p, it);
        else if (it < 140) mlstm_scan(p, it - 8);
        else four_g2(p, it - 140, smem);
      }
      break;
    case 4: if (!PHEN(4)) break;
      for (int it = bid; it < 512 + 256 + 512; it += nb) {
        if (it < 512) mlstm_out(p, l, it, smem);
        else if (it < 768) s5_tg(p, it - 512, smem);
        else four_g3(p, it - 768, smem);
      }
      break;
    case 5: if (!PHEN(5)) break;
      {
        pg8::Gemm g{(const pg8::bf16_t*)(ws + W_HBF), (const pg8::bf16_t*)(ws + W_WIN) + (size_t)OFF_GATE * 1024, TOK, 3072, 1024};
        pg8::StaticOrder S; S.init(TOK, 3072, (int)gridDim.x, (int)blockIdx.x);
        pg8::EpiAct<2> E{(pg8::bf16_t*)(ws + W_GATE), 3072, p.in[I_BIN] + l * NIN + OFF_GATE};
        pg8::gemm_phase<pg8::EpiAct<2>, pg8::StaticOrder, false>((PG8_LAS unsigned char*)smem, g, S, E, nullptr);
      }
      break;
    case 6: if (!PHEN(6)) break;
      for (int it = bid; it < 512; it += nb) mergelite_item(p, l, it, smem);
      break;
    case 7: if (!PHEN(7)) break;
      {
        pg8::Gemm g{(const pg8::bf16_t*)(ws + W_MIX), (const pg8::bf16_t*)(ws + W_WOUT), TOK, 1024, 1024};
        pg8::StaticOrder S; S.init(TOK, 1024, (int)gridDim.x, (int)blockIdx.x);
        pg8::EpiAct<0> E{(pg8::bf16_t*)(ws + W_O), 1024, nullptr};
        pg8::gemm_phase<pg8::EpiAct<0>, pg8::StaticOrder, false>((PG8_LAS unsigned char*)smem, g, S, E, nullptr);
      }
      break;
    case 8: if (!PHEN(8)) break;
      for (int it = bid; it < 2048; it += nb) rms_item(p, 1, l, it);
      break;
    case 9: if (!PHEN(9)) break;
      {
        pg8::Gemm g{(const pg8::bf16_t*)(ws + W_HBF), (const pg8::bf16_t*)(ws + W_W1), TOK, 4096, 1024};
        pg8::StaticOrder S; S.init(TOK, 4096, (int)gridDim.x, (int)blockIdx.x);
        pg8::EpiAct<1> E{(pg8::bf16_t*)(ws + W_HID), 4096, nullptr};
        pg8::gemm_phase<pg8::EpiAct<1>, pg8::StaticOrder, false>((PG8_LAS unsigned char*)smem, g, S, E, nullptr);
      }
      break;
    case 10: if (!PHEN(10)) break;
      {
        pg8::Gemm g{(const pg8::bf16_t*)(ws + W_HID), (const pg8::bf16_t*)(ws + W_W2), TOK, 1024, 4096};
        pg8::StaticOrder S; S.init(TOK, 1024, (int)gridDim.x, (int)blockIdx.x);
        pg8::EpiAct<0> E{(pg8::bf16_t*)(ws + W_FO), 1024, nullptr};
        pg8::gemm_phase<pg8::EpiAct<0>, pg8::StaticOrder, false>((PG8_LAS unsigned char*)smem, g, S, E, nullptr);
      }
      break;
  }
}

__global__ void __launch_bounds__(NT) k_main(Params p, int ph_lo, int ph_hi) {
  extern __shared__ __attribute__((aligned(16))) char smem[];
#if COOP
  cg::grid_group grid = cg::this_grid();
  volatile LAS unsigned* st = (volatile LAS unsigned*)(smem + SMEM_BYTES - 16);
  if (threadIdx.x == 0) { st[0] = 0u; st[1] = 0u; }
  if (blockIdx.x == 0) { for (int i = threadIdx.x; i < 4096; i += NT) ((unsigned*)(p.ws + W_BAR))[i] = 0u; }
  __syncthreads();
  XcdBarrier xb; xb.bar = (unsigned*)(p.ws + W_BAR); xb.x = 0; xb.st = st;
#endif
#if PROBE_PH >= 0
  long long t0 = 0, t1 = 0;
#endif
  for (int ph = ph_lo; ph < ph_hi; ph++) {
#if PROBE_PH >= 0
    if (ph == PROBE_PH) t0 = wall_clock64();
    if (ph == PROBE_PH + PROBE_N) t1 = wall_clock64();
#endif
    run_phase(p, ph, smem);
#if COOP
    if (ph + 1 < ph_hi) {
      if (ph == ph_lo) { grid.sync(); xb = xcd_barrier_post((unsigned*)(p.ws + W_BAR), st); }
      else xcd_barrier(xb);
    }
#endif
  }
#if PROBE_PH >= 0
  xcd_barrier(xb);
  if (blockIdx.x == 0 && threadIdx.x == 0) { float us = (float)(t1 - t0) * 0.01f; p.out[0] += 0.1f + us * (1.f / PROBE_SCALE); }
#endif
}

extern "C" void kernel_launch(void* const* d_in, const int* in_sizes, int n_in, void* d_out, int out_size, void* d_ws, size_t ws_size,
                              hipStream_t stream) {
  static int grid = 0;
  if (grid == 0) {
    if (n_in != 25 || ws_size < W_END) { fprintf(stderr, "kernel_launch: bad inputs n_in=%d ws=%zu need %zu\n", n_in, ws_size, (size_t)W_END); grid = -1; return; }
    if (hipFuncSetAttribute((const void*)k_main, hipFuncAttributeMaxDynamicSharedMemorySize, SMEM_BYTES) != hipSuccess) { fprintf(stderr, "hipFuncSetAttribute failed\n"); grid = -1; return; }
    int dev = 0, cus = 0, per_cu = 0;
    hipGetDevice(&dev);
    hipDeviceGetAttribute(&cus, hipDeviceAttributeMultiprocessorCount, dev);
    hipOccupancyMaxActiveBlocksPerMultiprocessor(&per_cu, (const void*)k_main, NT, SMEM_BYTES);
    if (per_cu < 1) { fprintf(stderr, "occupancy query says 0 blocks/CU\n"); grid = -1; return; }
    grid = cus;
  }
  if (grid < 0) return;
  Params p{};
  for (int i = 0; i < 25; i++) p.in[i] = (const float*)d_in[i];
  p.out = (float*)d_out;
  p.ws = (char*)d_ws;
#if COOP
  int lo = 0, hi = NPH;
  void* args[] = {&p, &lo, &hi};
  hipError_t e = hipLaunchCooperativeKernel((const void*)k_main, dim3(grid), dim3(NT), args, SMEM_BYTES, stream);
  if (e != hipSuccess) fprintf(stderr, "cooperative launch failed: %s\n", hipGetErrorString(e));
#else
  for (int ph = 0; ph < NPH; ph++) hipLaunchKernelGGL(k_main, dim3(grid), dim3(NT), SMEM_BYTES, stream, p, ph, ph + 1);
#endif
}
```

```cpp
#include <hip/hip_runtime.h>
#include <hip/hip_cooperative_groups.h>
#include <stdint.h>
#include <stdio.h>
#include <math.h>
namespace cg = cooperative_groups;

#ifndef REP_MASK
#define REP_MASK 0
#endif
#ifndef PROBE_PH
#define PROBE_PH -1
#endif
#ifndef PROBE_N
#define PROBE_N 1
#endif
#ifndef PROBE_SCALE
#define PROBE_SCALE 1000.f
#endif
#ifndef COOP
#define COOP 1
#endif

typedef unsigned short bf16_t;
typedef __attribute__((ext_vector_type(8))) short bf16x8;
typedef __attribute__((ext_vector_type(4))) float f32x4;

#define NT 512
constexpr int SEQ = 8192, TOK = 16384, DM = 1024, NIN = 5648, ZS = 2560, DFF = 4096;
constexpr int OFF_K = 512, OFF_V = 1024, OFF_O = 1536, OFF_IG = 2048  , OFF_F = 2048, OFF_S = 2304  , OFF_GATE = 2576  ;
constexpr float EPS = 1e-6f;

enum { I_X = 0, I_GMPRE, I_GMPOST, I_GFPRE, I_GFPOST, I_WIN, I_BIN, I_CW, I_CB, I_MNG, I_WUPM, I_WUPF, I_LRE, I_LIM, I_LDT,
       I_BRE, I_BIM, I_CRE, I_CIM, I_SD, I_WGLU, I_BGLU, I_WOUT, I_W1, I_W2 };

constexpr size_t W_WIN = 0;
constexpr size_t W_WUPM = W_WIN + (size_t)NIN * 1024 * 2;
constexpr size_t W_WUPF = W_WUPM + 1024 * 512 * 2;
constexpr size_t W_WGLU = W_WUPF + 1024 * 256 * 2;
constexpr size_t W_WOUT = W_WGLU + 2048 * 256 * 2;
constexpr size_t W_W1 = W_WOUT + 1024 * 1024 * 2;
constexpr size_t W_W2 = W_W1 + 4096 * 1024 * 2;
constexpr size_t W_ET = W_W2 + 4096 * 1024 * 2;
constexpr size_t W_TG = W_ET + 16 * 256 * 512 * 2;
constexpr size_t W_F1T = W_TG + 16 * 512 * 768 * 2;
constexpr size_t W_F2T = W_F1T + 128 * 64 * 2;
constexpr size_t W_F3T = W_F2T + 256 * 256 * 2;
constexpr size_t W_TW = W_F3T + 64 * 128 * 2;
constexpr size_t W_LPOW = W_TW + 64 * 128 * 2 * 4;
constexpr size_t W_ZERO = W_LPOW + 2 * 16 * 64 * 2 * 4;
constexpr size_t W_AMAX = W_ZERO + 256;
constexpr size_t W_G = W_AMAX + 4096;
constexpr size_t W_MPREV = W_G + 4096;
constexpr size_t W_NST = W_MPREV + 4096;
constexpr size_t W_ZG = W_NST + 16 * 64 * 128 * 4;
constexpr size_t W_HBF = W_ZG + (size_t)TOK * 16 * 4;
constexpr size_t W_Z = W_HBF + (size_t)TOK * 1024 * 2;
constexpr size_t W_CST = W_Z + (size_t)TOK * ZS * 2;
constexpr size_t W_U1T = W_CST + (size_t)16 * 64 * 16384 * 2;
constexpr size_t W_A2T = W_U1T + (size_t)TOK * 512 * 2;
constexpr size_t W_YF = W_A2T + (size_t)TOK * 512 * 2;
constexpr size_t W_YS = W_YF + (size_t)TOK * 256 * 2;
constexpr size_t W_XEND = W_YS + (size_t)TOK * 256 * 2;
constexpr size_t W_XCAR = W_XEND + (size_t)512 * 16 * 256 * 2;
constexpr size_t W_BAR = W_XCAR + (size_t)512 * 16 * 256 * 2;
constexpr size_t W_KTG = W_BAR + 16384;
constexpr size_t W_END = W_KTG + (size_t)2 * 16 * 16384 * 4;
constexpr size_t W_HM = W_U1T;
constexpr size_t W_MIX = W_HBF;
constexpr size_t W_GATE = W_Z;
constexpr size_t W_O = W_Z + (size_t)TOK * 1024 * 2;
constexpr size_t W_HID = W_Z;
constexpr size_t W_FO = W_A2T;
static_assert(W_U1T + (size_t)TOK * 512 * 2 - W_Z >= (size_t)TOK * 4096 * 2, "hid alias");
static_assert(W_U1T - W_Z >= (size_t)TOK * 3072 * 2, "gate alias");

constexpr int SMEM_BYTES = 153600 + 16;

struct Params { const float* in[25]; float* out; char* ws; };

__device__ __forceinline__ int tidx() { int t = threadIdx.x; asm volatile("" : "+v"(t)); return t; }
__device__ __forceinline__ bf16_t f2bf(float f) {
  uint32_t u = __float_as_uint(f);
  u += 0x7fffu + ((u >> 16) & 1u);
  return (bf16_t)(u >> 16);
}
__device__ __forceinline__ float bf2f(bf16_t h) { return __uint_as_float(((uint32_t)h) << 16); }
__device__ __forceinline__ uint32_t pack2(float a, float b) { return (uint32_t)f2bf(a) | ((uint32_t)f2bf(b) << 16); }
__device__ __forceinline__ uint2 pack4(float a, float b, float c, float d) { uint2 r; r.x = pack2(a, b); r.y = pack2(c, d); return r; }
__device__ __forceinline__ float lo16(uint32_t u) { return __uint_as_float(u << 16); }
__device__ __forceinline__ float hi16(uint32_t u) { return __uint_as_float(u & 0xffff0000u); }
__device__ __forceinline__ float sigm(float x) { return __frcp_rn(1.f + __expf(-x)); }
__device__ __forceinline__ float logsig(float x) { return fminf(x, 0.f) - log1pf(expf(-fabsf(x))); }
__device__ __forceinline__ float gelu_tanh(float x) { float u = 0.7978845608028654f * (x + 0.044715f * x * x * x); return 0.5f * x * (1.f + tanhf(u)); }
__device__ __forceinline__ float wave_sum(float v) {
#pragma unroll
  for (int o = 32; o >= 1; o >>= 1) v += __shfl_xor(v, o);
  return v;
}
__device__ __forceinline__ float wave_max(float v) {
#pragma unroll
  for (int o = 32; o >= 1; o >>= 1) v = fmaxf(v, __shfl_xor(v, o));
  return v;
}
__device__ __forceinline__ float wave_incl_sum(float v, int lane) {
#pragma unroll
  for (int o = 1; o < 64; o <<= 1) { float t = __shfl_up(v, o); if (lane >= o) v += t; }
  return v;
}
__device__ __forceinline__ float wave_incl_max(float v, int lane) {
#pragma unroll
  for (int o = 1; o < 64; o <<= 1) { float t = __shfl_up(v, o); if (lane >= o) v = fmaxf(v, t); }
  return v;
}
__device__ __forceinline__ f32x4 mfma16(bf16x8 a, bf16x8 b, f32x4 c) { return __builtin_amdgcn_mfma_f32_16x16x32_bf16(a, b, c, 0, 0, 0); }

constexpr int BK = 64, LDK = 64;
template <int BM, int BN, int WM, int WN, bool SWAP, class AF, class BF>
__device__ __forceinline__ void gemm_acc(int K, AF aptr, BF bptr, char* smem, f32x4 (&acc)[BM / WM / 16][BN / WN / 16]) {
  constexpr int TM = BM / WM / 16, TN = BN / WN / 16;
  constexpr int CA = BM * 8 / NT, CB = BN * 8 / NT;
  static_assert(CA >= 1 && CB >= 1, "tile too small");
  bf16_t* As = (bf16_t*)smem;
  bf16_t* Bs = As + 2 * BM * LDK;
  const int tid = tidx(), lane = tid & 63, w = tid >> 6;
  const int mb = (w / WN) * (BM / WM), nb = (w % WN) * (BN / WN);
  const int r16 = lane & 15, fx = (r16 >> 1) & 7;
  uint4 ra0, ra1, ra2, ra3, rb0, rb1, rb2, rb3;
  ra0 = ra1 = ra2 = ra3 = rb0 = rb1 = rb2 = rb3 = make_uint4(0, 0, 0, 0);
  static_assert(CA <= 4 && CB <= 4, "chunks");
#define GLOAD(K0)                                                                                         \
  {                                                                                                       \
    { int c = tid; ra0 = *(const uint4*)aptr(c >> 3, (K0) + (c & 7) * 8); }                               \
    if (CA > 1) { int c = tid + NT; ra1 = *(const uint4*)aptr(c >> 3, (K0) + (c & 7) * 8); }              \
    if (CA > 2) { int c = tid + 2 * NT; ra2 = *(const uint4*)aptr(c >> 3, (K0) + (c & 7) * 8); }          \
    if (CA > 3) { int c = tid + 3 * NT; ra3 = *(const uint4*)aptr(c >> 3, (K0) + (c & 7) * 8); }          \
    { int c = tid; rb0 = *(const uint4*)bptr(c >> 3, (K0) + (c & 7) * 8); }                               \
    if (CB > 1) { int c = tid + NT; rb1 = *(const uint4*)bptr(c >> 3, (K0) + (c & 7) * 8); }              \
    if (CB > 2) { int c = tid + 2 * NT; rb2 = *(const uint4*)bptr(c >> 3, (K0) + (c & 7) * 8); }          \
    if (CB > 3) { int c = tid + 3 * NT; rb3 = *(const uint4*)bptr(c >> 3, (K0) + (c & 7) * 8); }          \
  }
#define SSTORE(AP, BP)                                                                                    \
  {                                                                                                       \
    { int c = tid; *(uint4*)&(AP)[(c >> 3) * LDK + (((c & 7) ^ ((c >> 4) & 7)) << 3)] = ra0; }                                  \
    if (CA > 1) { int c = tid + NT; *(uint4*)&(AP)[(c >> 3) * LDK + (((c & 7) ^ ((c >> 4) & 7)) << 3)] = ra1; }                 \
    if (CA > 2) { int c = tid + 2 * NT; *(uint4*)&(AP)[(c >> 3) * LDK + (((c & 7) ^ ((c >> 4) & 7)) << 3)] = ra2; }             \
    if (CA > 3) { int c = tid + 3 * NT; *(uint4*)&(AP)[(c >> 3) * LDK + (((c & 7) ^ ((c >> 4) & 7)) << 3)] = ra3; }             \
    { int c = tid; *(uint4*)&(BP)[(c >> 3) * LDK + (((c & 7) ^ ((c >> 4) & 7)) << 3)] = rb0; }                                  \
    if (CB > 1) { int c = tid + NT; *(uint4*)&(BP)[(c >> 3) * LDK + (((c & 7) ^ ((c >> 4) & 7)) << 3)] = rb1; }                 \
    if (CB > 2) { int c = tid + 2 * NT; *(uint4*)&(BP)[(c >> 3) * LDK + (((c & 7) ^ ((c >> 4) & 7)) << 3)] = rb2; }             \
    if (CB > 3) { int c = tid + 3 * NT; *(uint4*)&(BP)[(c >> 3) * LDK + (((c & 7) ^ ((c >> 4) & 7)) << 3)] = rb3; }             \
  }
  GLOAD(0);
  SSTORE(As, Bs);
  const int nk = K / BK;
  if (nk > 1) { GLOAD(BK); }
  __syncthreads();
#pragma unroll 1
  for (int kt = 0; kt < nk; kt++) {
    const int buf = kt & 1;
    if (kt + 1 < nk) {
      bf16_t* An = As + (buf ^ 1) * BM * LDK;
      bf16_t* Bn = Bs + (buf ^ 1) * BN * LDK;
      SSTORE(An, Bn);
      if (kt + 2 < nk) { GLOAD((kt + 2) * BK); }
    }
    const bf16_t* Ab = As + buf * BM * LDK;
    const bf16_t* Bb = Bs + buf * BN * LDK;
#pragma unroll
    for (int kk = 0; kk < 2; kk++) {
      bf16x8 af[TM], bfr[TN];
#pragma unroll
      for (int i = 0; i < TM; i++) af[i] = *(const bf16x8*)&Ab[(mb + i * 16 + r16) * LDK + (((kk * 4 + (lane >> 4)) ^ fx) << 3)];
#pragma unroll
      for (int j = 0; j < TN; j++) bfr[j] = *(const bf16x8*)&Bb[(nb + j * 16 + r16) * LDK + (((kk * 4 + (lane >> 4)) ^ fx) << 3)];
      __builtin_amdgcn_s_setprio(1);
#pragma unroll
      for (int i = 0; i < TM; i++)
#pragma unroll
        for (int j = 0; j < TN; j++) acc[i][j] = SWAP ? mfma16(bfr[j], af[i], acc[i][j]) : mfma16(af[i], bfr[j], acc[i][j]);
      __builtin_amdgcn_s_setprio(0);
    }
    __syncthreads();
  }
#undef GLOAD
#undef SSTORE
}

struct Stage { uint4 a0, a1, a2, a3, b0, b1, b2, b3; };
template <int BM, int BN, int WM, int WN, bool SWAP, class AF, class BF, class NAF, class NBF>
__device__ __forceinline__ void gemm_chain(int K, AF aptr, BF bptr, bool preloaded, bool has_next, NAF naptr, NBF nbptr, Stage& st, char* smem,
                                           f32x4 (&acc)[BM / WM / 16][BN / WN / 16]) {
  constexpr int TM = BM / WM / 16, TN = BN / WN / 16;
  constexpr int CA = BM * 8 / NT, CB = BN * 8 / NT;
  static_assert(CA >= 1 && CB >= 1 && CA <= 4 && CB <= 4, "chunks");
  bf16_t* As = (bf16_t*)smem;
  bf16_t* Bs = As + 2 * BM * LDK;
  const int tid = tidx(), lane = tid & 63, w = tid >> 6;
  const int mb = (w / WN) * (BM / WM), nb = (w % WN) * (BN / WN);
  const int r16 = lane & 15, fx = (r16 >> 1) & 7;
#define GLOADF(AP_, BP_, K0)                                                                              \
  {                                                                                                       \
    { int c = tid; st.a0 = *(const uint4*)AP_(c >> 3, (K0) + (c & 7) * 8); }                              \
    if (CA > 1) { int c = tid + NT; st.a1 = *(const uint4*)AP_(c >> 3, (K0) + (c & 7) * 8); }             \
    if (CA > 2) { int c = tid + 2 * NT; st.a2 = *(const uint4*)AP_(c >> 3, (K0) + (c & 7) * 8); }         \
    if (CA > 3) { int c = tid + 3 * NT; st.a3 = *(const uint4*)AP_(c >> 3, (K0) + (c & 7) * 8); }         \
    { int c = tid; st.b0 = *(const uint4*)BP_(c >> 3, (K0) + (c & 7) * 8); }                              \
    if (CB > 1) { int c = tid + NT; st.b1 = *(const uint4*)BP_(c >> 3, (K0) + (c & 7) * 8); }             \
    if (CB > 2) { int c = tid + 2 * NT; st.b2 = *(const uint4*)BP_(c >> 3, (K0) + (c & 7) * 8); }         \
    if (CB > 3) { int c = tid + 3 * NT; st.b3 = *(const uint4*)BP_(c >> 3, (K0) + (c & 7) * 8); }         \
  }
#define SOFFC(c) (((c) >> 3) * LDK + ((((c) & 7) ^ (((c) >> 4) & 7)) << 3))
#define SSTOREC(AP, BP)                                                                                   \
  {                                                                                                       \
    *(uint4*)&(AP)[SOFFC(tid)] = st.a0;                                                                   \
    if (CA > 1) *(uint4*)&(AP)[SOFFC(tid + NT)] = st.a1;                                                  \
    if (CA > 2) *(uint4*)&(AP)[SOFFC(tid + 2 * NT)] = st.a2;                                              \
    if (CA > 3) *(uint4*)&(AP)[SOFFC(tid + 3 * NT)] = st.a3;                                              \
    *(uint4*)&(BP)[SOFFC(tid)] = st.b0;                                                                   \
    if (CB > 1) *(uint4*)&(BP)[SOFFC(tid + NT)] = st.b1;                                                  \
    if (CB > 2) *(uint4*)&(BP)[SOFFC(tid + 2 * NT)] = st.b2;                                              \
    if (CB > 3) *(uint4*)&(BP)[SOFFC(tid + 3 * NT)] = st.b3;                                              \
  }
  const int nk = K / BK;
  if (!preloaded) { GLOADF(aptr, bptr, 0); }
  SSTOREC(As, Bs);
  GLOADF(aptr, bptr, BK);
  __syncthreads();
#pragma unroll 1
  for (int kt = 0; kt < nk; kt++) {
    const int buf = kt & 1;
    if (kt + 1 < nk) {
      bf16_t* An = As + (buf ^ 1) * BM * LDK;
      bf16_t* Bn = Bs + (buf ^ 1) * BN * LDK;
      SSTOREC(An, Bn);
      if (kt + 2 < nk) { GLOADF(aptr, bptr, (kt + 2) * BK); }
      else if (has_next) { GLOADF(naptr, nbptr, 0); }
    }
    const bf16_t* Ab = As + buf * BM * LDK;
    const bf16_t* Bb = Bs + buf * BN * LDK;
#pragma unroll
    for (int kk = 0; kk < 2; kk++) {
      bf16x8 af[TM], bfr[TN];
#pragma unroll
      for (int i = 0; i < TM; i++) af[i] = *(const bf16x8*)&Ab[(mb + i * 16 + r16) * LDK + (((kk * 4 + (lane >> 4)) ^ fx) << 3)];
#pragma unroll
      for (int j = 0; j < TN; j++) bfr[j] = *(const bf16x8*)&Bb[(nb + j * 16 + r16) * LDK + (((kk * 4 + (lane >> 4)) ^ fx) << 3)];
      __builtin_amdgcn_s_setprio(1);
#pragma unroll
      for (int i = 0; i < TM; i++)
#pragma unroll
        for (int j = 0; j < TN; j++) acc[i][j] = SWAP ? mfma16(bfr[j], af[i], acc[i][j]) : mfma16(af[i], bfr[j], acc[i][j]);
      __builtin_amdgcn_s_setprio(0);
    }
    __syncthreads();
  }
#undef GLOADF
#undef SOFFC
#undef SSTOREC
}

__device__ __forceinline__ int perm32(int r) { return (r & ~31) + 8 * ((r & 15) >> 2) + 4 * ((r >> 4) & 1) + (r & 3); }

template <int TM, int TN>
__device__ __forceinline__ void zero_acc(f32x4 (&acc)[TM][TN]) {
#pragma unroll
  for (int i = 0; i < TM; i++)
#pragma unroll
    for (int j = 0; j < TN; j++) acc[i][j] = f32x4{0.f, 0.f, 0.f, 0.f};
}

constexpr int LDT = 144;
template <int TM, int TN, bool SWAP>
__device__ __forceinline__ void mma_lds(const bf16_t* A, const bf16_t* B, int K, int mb, int nb, f32x4 (&acc)[TM][TN]) {
  const int lane = tidx() & 63, r16 = lane & 15, kq = (lane >> 4) * 8;
  for (int k0 = 0; k0 < K; k0 += 32) {
    bf16x8 af[TM], bfr[TN];
#pragma unroll
    for (int i = 0; i < TM; i++) af[i] = *(const bf16x8*)&A[(mb + i * 16 + r16) * LDT + k0 + kq];
#pragma unroll
    for (int j = 0; j < TN; j++) bfr[j] = *(const bf16x8*)&B[(nb + j * 16 + r16) * LDT + k0 + kq];
    __builtin_amdgcn_s_setprio(1);
#pragma unroll
    for (int i = 0; i < TM; i++)
#pragma unroll
      for (int j = 0; j < TN; j++) acc[i][j] = SWAP ? mfma16(bfr[j], af[i], acc[i][j]) : mfma16(af[i], bfr[j], acc[i][j]);
    __builtin_amdgcn_s_setprio(0);
  }
}

__device__ __forceinline__ void transpose_tile(const float* __restrict__ src, bf16_t* __restrict__ dst, int K, int N, int tile, char* smem) {
  float* sm = (float*)smem;
  const int ntn = (N + 255) >> 8;
  const int k0 = (tile / ntn) * 64, n0 = (tile % ntn) * 256;
  const int tid = tidx();
  {
    float4 v[8];
#pragma unroll
    for (int t = 0; t < 8; t++) {
      int idx = tid + t * NT, r = idx >> 6, c = (idx & 63) * 4;
      v[t] = (n0 + c < N) ? *(const float4*)(src + (size_t)(k0 + r) * N + n0 + c) : make_float4(0.f, 0.f, 0.f, 0.f);
    }
#pragma unroll
    for (int t = 0; t < 8; t++) {
      int idx = tid + t * NT, r = idx >> 6, c = (idx & 63) * 4;
      sm[r * 257 + c] = v[t].x; sm[r * 257 + c + 1] = v[t].y; sm[r * 257 + c + 2] = v[t].z; sm[r * 257 + c + 3] = v[t].w;
    }
  }
  __syncthreads();
#pragma unroll 8
  for (int t = 0; t < 16; t++) {
    int idx = tid + t * NT, r = idx >> 5, c = (idx & 31) * 2;
    if (n0 + r < N) *(uint32_t*)(dst + (size_t)(n0 + r) * K + k0 + c) = pack2(sm[c * 257 + r], sm[(c + 1) * 257 + r]);
  }
  __syncthreads();
}

__device__ __forceinline__ void transpose_item(const Params& p, int l, int i, char* smem) {
  char* ws = p.ws;
  if (i < 368) { transpose_tile(p.in[I_WIN] + (size_t)l * 1024 * NIN, (bf16_t*)(ws + W_WIN), 1024, NIN, i, smem); return; }
  i -= 368;
  if (i < 32) { transpose_tile(p.in[I_WUPM] + (size_t)l * 512 * 1024, (bf16_t*)(ws + W_WUPM), 512, 1024, i, smem); return; }
  i -= 32;
  if (i < 16) { transpose_tile(p.in[I_WUPF] + (size_t)l * 256 * 1024, (bf16_t*)(ws + W_WUPF), 256, 1024, i, smem); return; }
  i -= 16;
  if (i < 32) { transpose_tile(p.in[I_WGLU] + (size_t)l * 256 * 2048, (bf16_t*)(ws + W_WGLU), 256, 2048, i, smem); return; }
  i -= 32;
  if (i < 64) { transpose_tile(p.in[I_WOUT] + (size_t)l * 1024 * 1024, (bf16_t*)(ws + W_WOUT), 1024, 1024, i, smem); return; }
  i -= 64;
  if (i < 256) { transpose_tile(p.in[I_W1] + (size_t)l * 1024 * 4096, (bf16_t*)(ws + W_W1), 1024, 4096, i, smem); return; }
  i -= 256;
  transpose_tile(p.in[I_W2] + (size_t)l * 4096 * 1024, (bf16_t*)(ws + W_W2), 4096, 1024, i, smem);
}
constexpr int N_TR = 368 + 32 + 16 + 32 + 64 + 256 + 256;

__device__ __forceinline__ void gen_tables(const Params& p, int item) {
  char* ws = p.ws;
  bf16_t* F1T = (bf16_t*)(ws + W_F1T);
  bf16_t* F2T = (bf16_t*)(ws + W_F2T);
  bf16_t* F3T = (bf16_t*)(ws + W_F3T);
  float* TW = (float*)(ws + W_TW);
  uint32_t* ZR = (uint32_t*)(ws + W_ZERO);
  constexpr int E1 = 8192, E2 = 65536, E3 = 8192, E4 = 8192, E5 = 64;
  for (int e = item * NT + tidx(); e < E1 + E2 + E3 + E4 + E5; e += 32 * NT) {
    int i = e;
    if (i < E1) {
      int n = i >> 6, d = i & 63, c = n >> 6, j = n & 63;
      float s, co; sincospif((float)((j * d) & 63) / 32.f, &s, &co);
      F1T[i] = f2bf(c == 0 ? co : -s);
      continue;
    }
    i -= E1;
    if (i < E2) {
      int n = i >> 8, k = i & 255;
      int k1 = (n >> 5) * 16 + (n & 15), cp = (n >> 4) & 1, c = k >> 7, s1 = k & 127;
      float s, co; sincospif((float)((s1 * k1) & 127) / 64.f, &s, &co);
      float v = (cp == 0) ? (c == 0 ? co : s) : (c == 0 ? -s : co);
      F2T[i] = f2bf(v);
      continue;
    }
    i -= E2;
    if (i < E3) {
      int k2 = i >> 7, k = i & 127, cp = k >> 6, s2 = k & 63;
      float s, co; sincospif((float)((s2 * k2) & 63) / 32.f, &s, &co);
      const float scale = 0.0013810679320049757f;
      F3T[i] = f2bf((cp == 0 ? co : s) * scale);
      continue;
    }
    i -= E3;
    if (i < E4) {
      int s2 = i >> 7, k1 = i & 127;
      float s, co; sincospif((float)(s2 * k1) / 4096.f, &s, &co);
      TW[2 * i] = co; TW[2 * i + 1] = s;
      continue;
    }
    i -= E4;
    ZR[i] = 0u;
  }
}

__device__ __forceinline__ void s5_setup(const Params& p, int l, int g, float* POW, float* BB, float* CC) {
  const int tid = tidx();
  for (int e = tid; e < 2 * 64 * 33; e += NT) {
    int d = e / (64 * 33), r = e - d * 64 * 33, tau = r >> 6, pp = r & 63;
    int gi = ((l * 2 + d) * 16 + g);
    float dt = expf(p.in[I_LDT][gi]);
    float lr = p.in[I_LRE][gi * 64 + pp], li = p.in[I_LIM][gi * 64 + pp];
    float m2 = expf(lr * dt * (float)tau);
    float s2, c2; sincosf(li * dt * (float)tau, &s2, &c2);
    POW[((d * 33 + tau) * 64 + pp) * 2] = m2 * c2;
    POW[((d * 33 + tau) * 64 + pp) * 2 + 1] = m2 * s2;
  }
  for (int e = tid; e < 2048; e += NT) {
    int d = e >> 10, pp = (e >> 4) & 63, ci = e & 15;
    int gi = ((l * 2 + d) * 16 + g);
    float dt = expf(p.in[I_LDT][gi]);
    float lr = p.in[I_LRE][gi * 64 + pp], li = p.in[I_LIM][gi * 64 + pp];
    float mag = expf(lr * dt);
    float sn, cs; sincosf(li * dt, &sn, &cs);
    float lbr = mag * cs, lbi = mag * sn;
    float den = lr * lr + li * li;
    float fr = ((lbr - 1.f) * lr + lbi * li) / den;
    float fi = (lbi * lr - (lbr - 1.f) * li) / den;
    float br = p.in[I_BRE][(gi * 64 + pp) * 16 + ci], bi = p.in[I_BIM][(gi * 64 + pp) * 16 + ci];
    BB[e * 2] = fr * br - fi * bi;
    BB[e * 2 + 1] = fr * bi + fi * br;
  }
  for (int e = tid; e < 2048; e += NT) {
    int d = e >> 10, r = e & 1023;
    int gi = ((l * 2 + d) * 16 + g);
    CC[e * 2] = p.in[I_CRE][gi * 1024 + r];
    CC[e * 2 + 1] = p.in[I_CIM][gi * 1024 + r];
  }
  __syncthreads();
}
__device__ __forceinline__ void s5_kt(const Params& p, int item, char* smem) {
  float* POW = (float*)smem;
  float* BB = POW + 2 * 33 * 64 * 2;
  float* CC = BB + 2 * 64 * 16 * 2;
  const int part = item & 7, g = (item >> 3) & 15, l = item >> 7;
  s5_setup(p, l, g, POW, BB, CC);
  float* KTG = (float*)(p.ws + W_KTG) + (size_t)(l * 16 + g) * 16384;
  const int tid = tidx();
  for (int e = part * 2048 + tid; e < part * 2048 + 2048; e += NT) {
    int d = e >> 13, tau = (e >> 8) & 31, co = (e >> 4) & 15, ci = e & 15;
    float s = 0.f;
    for (int pp = 0; pp < 64; pp++) {
      float cr = CC[((d * 16 + co) * 64 + pp) * 2], cim = CC[((d * 16 + co) * 64 + pp) * 2 + 1];
      float pr = POW[((d * 33 + tau) * 64 + pp) * 2], pi = POW[((d * 33 + tau) * 64 + pp) * 2 + 1];
      float xr = cr * pr - cim * pi, xi = cr * pi + cim * pr;
      float br = BB[((d * 64 + pp) * 16 + ci) * 2], bi = BB[((d * 64 + pp) * 16 + ci) * 2 + 1];
      s += xr * br - xi * bi;
    }
    KTG[e] = s;
  }
  __syncthreads();
}
__device__ __forceinline__ void s5_fill(const Params& p, int l, int item, char* smem) {
  float* POW = (float*)smem;
  float* BB = POW + 2 * 33 * 64 * 2;
  float* CC = BB + 2 * 64 * 16 * 2;
  float* KT = CC + 2 * 16 * 64 * 2;
  const int part = item & 7, g = item >> 3;
  const int tid = tidx();
  char* ws = p.ws;
  const float* KTG = (const float*)(ws + W_KTG) + (size_t)(l * 16 + g) * 16384;
  for (int e = tid; e < 4096; e += NT) ((float4*)KT)[e] = ((const float4*)KTG)[e];
  s5_setup(p, l, g, POW, BB, CC);
  if (part == 0 && tid < 128) {
    int d = tid >> 6, pp = tid & 63;
    float* LP = (float*)(ws + W_LPOW);
    LP[((d * 16 + g) * 64 + pp) * 2] = POW[((d * 33 + 32) * 64 + pp) * 2];
    LP[((d * 16 + g) * 64 + pp) * 2 + 1] = POW[((d * 33 + 32) * 64 + pp) * 2 + 1];
  }
  bf16_t* TG = (bf16_t*)(ws + W_TG) + (size_t)g * 512 * 768;
  const float* dsk = p.in[I_SD] + (l * 16 + g) * 16;
  for (int e = part * 64 * 768 + tid; e < (part + 1) * 64 * 768; e += NT) {
    int n = e / 768, k = e - n * 768;
    int t = n >> 4, co = n & 15;
    float v;
    if (k < 512) {
      int s = k >> 4, ci = k & 15;
      if (t > s) v = KT[((0 * 32 + (t - s)) * 16 + co) * 16 + ci];
      else if (t < s) v = KT[((1 * 32 + (s - t)) * 16 + co) * 16 + ci];
      else v = KT[(co)*16 + ci] + KT[((32) * 16 + co) * 16 + ci] + (co == ci ? dsk[co] : 0.f);
    } else {
      int kk = k - 512, d = kk >> 7, pp = (kk & 127) >> 1, c = kk & 1;
      int tau = d == 0 ? t + 1 : 32 - t;
      float cr = CC[((d * 16 + co) * 64 + pp) * 2], cim = CC[((d * 16 + co) * 64 + pp) * 2 + 1];
      float pr = POW[((d * 33 + tau) * 64 + pp) * 2], pi = POW[((d * 33 + tau) * 64 + pp) * 2 + 1];
      float xr = cr * pr - cim * pi, xi = cr * pi + cim * pr;
      v = c == 0 ? xr : -xi;
    }
    TG[e] = f2bf(v);
  }
  bf16_t* ET = (bf16_t*)(ws + W_ET) + (size_t)g * 256 * 512;
  for (int e = part * 32 * 512 + tid; e < (part + 1) * 32 * 512; e += NT) {
    int n = e >> 9, k = e & 511;
    int d = n >> 7, pp = (n & 127) >> 1, c = n & 1, s = k >> 4, ci = k & 15;
    int tau = d == 0 ? 31 - s : s;
    float pr = POW[((d * 33 + tau) * 64 + pp) * 2], pi = POW[((d * 33 + tau) * 64 + pp) * 2 + 1];
    float br = BB[((d * 64 + pp) * 16 + ci) * 2], bi = BB[((d * 64 + pp) * 16 + ci) * 2 + 1];
    float v = c == 0 ? (pr * br - pi * bi) : (pr * bi + pi * br);
    ET[e] = f2bf(v);
  }
  __syncthreads();
}

__device__ __forceinline__ void rms_item(const Params& p, int mode, int l, int item) {
  const int lane = tidx() & 63, w = tidx() >> 6;
  const int row = item * 8 + w;
  char* ws = p.ws;
  const float* xin = (mode == 2 || l > 0) ? p.out : p.in[I_X];
  float xv[16];
#pragma unroll
  for (int t = 0; t < 4; t++) {
    float4 v = *(const float4*)(xin + (size_t)row * 1024 + t * 256 + lane * 4);
    xv[t * 4] = v.x; xv[t * 4 + 1] = v.y; xv[t * 4 + 2] = v.z; xv[t * 4 + 3] = v.w;
  }
  if (mode >= 1) {
    const bf16_t* y = (const bf16_t*)(ws + (mode == 1 ? W_O : W_FO)) + (size_t)row * 1024;
    const float* gp = (mode == 1 ? p.in[I_GMPOST] : p.in[I_GFPOST]) + l * 1024;
    float yv[16];
    float ss = 0.f;
#pragma unroll
    for (int t = 0; t < 4; t++) {
      uint2 u = *(const uint2*)(y + t * 256 + lane * 4);
      yv[t * 4] = lo16(u.x); yv[t * 4 + 1] = hi16(u.x); yv[t * 4 + 2] = lo16(u.y); yv[t * 4 + 3] = hi16(u.y);
    }
#pragma unroll
    for (int e = 0; e < 16; e++) ss += yv[e] * yv[e];
    ss = wave_sum(ss);
    float r = rsqrtf(ss * (1.f / 1024.f) + EPS);
#pragma unroll
    for (int t = 0; t < 4; t++) {
      float4 gv = *(const float4*)(gp + t * 256 + lane * 4);
      xv[t * 4] += yv[t * 4] * r * gv.x; xv[t * 4 + 1] += yv[t * 4 + 1] * r * gv.y;
      xv[t * 4 + 2] += yv[t * 4 + 2] * r * gv.z; xv[t * 4 + 3] += yv[t * 4 + 3] * r * gv.w;
      *(float4*)(p.out + (size_t)row * 1024 + t * 256 + lane * 4) = make_float4(xv[t * 4], xv[t * 4 + 1], xv[t * 4 + 2], xv[t * 4 + 3]);
    }
  }
  const bool wh = (mode != 2) || (l + 1 < 2);
  if (wh) {
    const float* gh = (mode == 0 ? p.in[I_GMPRE] + l * 1024 : (mode == 1 ? p.in[I_GFPRE] + l * 1024 : p.in[I_GMPRE] + (l + 1) * 1024));
    float ss = 0.f;
#pragma unroll
    for (int e = 0; e < 16; e++) ss += xv[e] * xv[e];
    ss = wave_sum(ss);
    float r = rsqrtf(ss * (1.f / 1024.f) + EPS);
    bf16_t* h = (bf16_t*)(ws + W_HBF) + (size_t)row * 1024;
#pragma unroll
    for (int t = 0; t < 4; t++) {
      float4 gv = *(const float4*)(gh + t * 256 + lane * 4);
      *(uint2*)(h + t * 256 + lane * 4) = pack4(xv[t * 4] * r * gv.x, xv[t * 4 + 1] * r * gv.y, xv[t * 4 + 2] * r * gv.z, xv[t * 4 + 3] * r * gv.w);
    }
  }
}

__device__ __forceinline__ void rms_loop(const Params& p, int mode, int l) {
  const int lane = tidx() & 63, w = tidx() >> 6;
  const int nb = gridDim.x;
  char* ws = p.ws;
  const float* xin = (mode == 2 || l > 0) ? p.out : p.in[I_X];
  const bf16_t* y = (const bf16_t*)(ws + (mode == 1 ? W_O : W_FO));
  const float* gp = (mode == 1 ? p.in[I_GMPOST] : p.in[I_GFPOST]) + l * 1024;
  const bool wh = (mode != 2) || (l + 1 < 2);
  const float* gh = (mode == 0 ? p.in[I_GMPRE] + l * 1024 : (mode == 1 ? p.in[I_GFPRE] + l * 1024 : p.in[I_GMPRE] + (l + 1 < 2 ? l + 1 : l) * 1024));
  float4 xc[4], xn[4];
  uint2 yc[4], yn[4];
  int it = blockIdx.x;
#pragma unroll
  for (int t = 0; t < 4; t++) { xc[t] = make_float4(0.f, 0.f, 0.f, 0.f); xn[t] = xc[t]; yc[t] = make_uint2(0u, 0u); yn[t] = yc[t]; }
  if (it < 2048) {
    const size_t row = (size_t)it * 8 + w;
#pragma unroll
    for (int t = 0; t < 4; t++) {
      xc[t] = *(const float4*)(xin + row * 1024 + t * 256 + lane * 4);
      if (mode >= 1) yc[t] = *(const uint2*)(y + row * 1024 + t * 256 + lane * 4);
    }
  }
#pragma unroll 1
  while (it < 2048) {
    const int nx = it + nb;
    if (nx < 2048) {
      const size_t rown = (size_t)nx * 8 + w;
#pragma unroll
      for (int t = 0; t < 4; t++) {
        xn[t] = *(const float4*)(xin + rown * 1024 + t * 256 + lane * 4);
        if (mode >= 1) yn[t] = *(const uint2*)(y + rown * 1024 + t * 256 + lane * 4);
      }
    }
    const size_t row = (size_t)it * 8 + w;
    float xv[16];
#pragma unroll
    for (int t = 0; t < 4; t++) { xv[t * 4] = xc[t].x; xv[t * 4 + 1] = xc[t].y; xv[t * 4 + 2] = xc[t].z; xv[t * 4 + 3] = xc[t].w; }
    if (mode >= 1) {
      float yv[16];
      float ss = 0.f;
#pragma unroll
      for (int t = 0; t < 4; t++) { yv[t * 4] = lo16(yc[t].x); yv[t * 4 + 1] = hi16(yc[t].x); yv[t * 4 + 2] = lo16(yc[t].y); yv[t * 4 + 3] = hi16(yc[t].y); }
#pragma unroll
      for (int e = 0; e < 16; e++) ss += yv[e] * yv[e];
      ss = wave_sum(ss);
      const float r = rsqrtf(ss * (1.f / 1024.f) + EPS);
#pragma unroll
      for (int t = 0; t < 4; t++) {
        float4 gv = *(const float4*)(gp + t * 256 + lane * 4);
        xv[t * 4] += yv[t * 4] * r * gv.x; xv[t * 4 + 1] += yv[t * 4 + 1] * r * gv.y;
        xv[t * 4 + 2] += yv[t * 4 + 2] * r * gv.z; xv[t * 4 + 3] += yv[t * 4 + 3] * r * gv.w;
        *(float4*)(p.out + row * 1024 + t * 256 + lane * 4) = make_float4(xv[t * 4], xv[t * 4 + 1], xv[t * 4 + 2], xv[t * 4 + 3]);
      }
    }
    if (wh) {
      float ss = 0.f;
#pragma unroll
      for (int e = 0; e < 16; e++) ss += xv[e] * xv[e];
      ss = wave_sum(ss);
      const float r = rsqrtf(ss * (1.f / 1024.f) + EPS);
      bf16_t* h = (bf16_t*)(ws + W_HBF) + row * 1024;
#pragma unroll
      for (int t = 0; t < 4; t++) {
        float4 gv = *(const float4*)(gh + t * 256 + lane * 4);
        *(uint2*)(h + t * 256 + lane * 4) = pack4(xv[t * 4] * r * gv.x, xv[t * 4 + 1] * r * gv.y, xv[t * 4 + 2] * r * gv.z, xv[t * 4 + 3] * r * gv.w);
      }
    }
#pragma unroll
    for (int t = 0; t < 4; t++) { xc[t] = xn[t]; yc[t] = yn[t]; }
    it = nx;
  }
}

template <int NTL, int PN>
__device__ __forceinline__ void tile_map(int it, int& mt, int& nt) {
  constexpr int PM = 32 / PN, NPN = NTL / PN;
  constexpr int total = 64 * NTL, full = (total / 256) * 256;
  int gp, within;
  if (it < full) { int xcd = it & 7, loc = it >> 3; gp = (loc >> 5) * 8 + xcd; within = loc & 31; }
  else { int rem = it - full; gp = full / 32 + (rem >> 5); within = rem & 31; }
  const int mp = gp / NPN, np = gp - mp * NPN;
  mt = mp * PM + within / PN;
  nt = np * PN + within % PN;
}

__device__ __forceinline__ void inproj_item(const Params& p, int l, int item, char* smem) {
  int mt, nt;
  tile_map<10, 2>(item, mt, nt);
  const int m0 = mt * 256, n0 = nt * 256;
  const int nsh = n0 >= 2048 ? 16 : 0;
  char* ws = p.ws;
  const bf16_t* A = (const bf16_t*)(ws + W_HBF) + (size_t)m0 * 1024;
  const bf16_t* B = (const bf16_t*)(ws + W_WIN) + (size_t)(n0 + nsh) * 1024;
  f32x4 acc[8][4];
  zero_acc(acc);
  gemm_acc<256, 256, 2, 4, true>(1024, [&](int r, int k) { return A + (size_t)r * 1024 + k; }, [&](int r, int k) { return B + (size_t)perm32(r) * 1024 + k; }, smem, acc);
  const int lane = tidx() & 63, w = tidx() >> 6;
  const int mb = (w / 4) * 128, nb = (w % 4) * 64;
  bf16_t* Z = (bf16_t*)(ws + W_Z);
  const float* bin = p.in[I_BIN] + l * NIN;
#pragma unroll
  for (int jj = 0; jj < 2; jj++) {
    const int n = n0 + nsh + nb + jj * 32 + (lane >> 4) * 8;
    float4 b0 = *(const float4*)(bin + n), b1 = *(const float4*)(bin + n + 4);
#pragma unroll
    for (int i = 0; i < 8; i++) {
      const int m = m0 + mb + i * 16 + (lane & 15);
      uint4 o;
      o.x = pack2(acc[i][2 * jj][0] + b0.x, acc[i][2 * jj][1] + b0.y); o.y = pack2(acc[i][2 * jj][2] + b0.z, acc[i][2 * jj][3] + b0.w);
      o.z = pack2(acc[i][2 * jj + 1][0] + b1.x, acc[i][2 * jj + 1][1] + b1.y); o.w = pack2(acc[i][2 * jj + 1][2] + b1.z, acc[i][2 * jj + 1][3] + b1.w);
      *(uint4*)(Z + (size_t)m * ZS + (n - nsh)) = o;
    }
  }
}
__device__ __forceinline__ void inproj_half_item(const Params& p, int l, int item, char* smem) {
  const int big = 512 + (item >> 1), half = item & 1;
  int mt, nt;
  tile_map<10, 2>(big, mt, nt);
  const int m0 = mt * 256, n0 = nt * 256 + half * 128;
  const int nsh = n0 >= 2048 ? 16 : 0;
  char* ws = p.ws;
  const bf16_t* A = (const bf16_t*)(ws + W_HBF) + (size_t)m0 * 1024;
  const bf16_t* B = (const bf16_t*)(ws + W_WIN) + (size_t)(n0 + nsh) * 1024;
  f32x4 acc[4][4];
  zero_acc(acc);
  gemm_acc<256, 128, 4, 2, true>(1024, [&](int r, int k) { return A + (size_t)r * 1024 + k; }, [&](int r, int k) { return B + (size_t)perm32(r) * 1024 + k; }, smem, acc);
  const int lane = tidx() & 63, w = tidx() >> 6;
  const int mb = (w / 2) * 64, nb = (w % 2) * 64;
  bf16_t* Z = (bf16_t*)(ws + W_Z);
  const float* bin = p.in[I_BIN] + l * NIN;
#pragma unroll
  for (int jj = 0; jj < 2; jj++) {
    const int n = n0 + nsh + nb + jj * 32 + (lane >> 4) * 8;
    float4 b0 = *(const float4*)(bin + n), b1 = *(const float4*)(bin + n + 4);
#pragma unroll
    for (int i = 0; i < 4; i++) {
      const int m = m0 + mb + i * 16 + (lane & 15);
      uint4 o;
      o.x = pack2(acc[i][2 * jj][0] + b0.x, acc[i][2 * jj][1] + b0.y); o.y = pack2(acc[i][2 * jj][2] + b0.z, acc[i][2 * jj][3] + b0.w);
      o.z = pack2(acc[i][2 * jj + 1][0] + b1.x, acc[i][2 * jj + 1][1] + b1.y); o.w = pack2(acc[i][2 * jj + 1][2] + b1.z, acc[i][2 * jj + 1][3] + b1.w);
      *(uint4*)(Z + (size_t)m * ZS + (n - nsh)) = o;
    }
  }
}
__device__ __forceinline__ void ingate_item(const Params& p, int l, int item, char* smem) {
  const int m0 = item * 256;
  char* ws = p.ws;
  const bf16_t* A = (const bf16_t*)(ws + W_HBF) + (size_t)m0 * 1024;
  const bf16_t* B = (const bf16_t*)(ws + W_WIN) + (size_t)OFF_IG * 1024;
  f32x4 acc[4][2];
  zero_acc(acc);
  gemm_acc<256, 64, 4, 2, true>(1024, [&](int r, int k) { return A + (size_t)r * 1024 + k; }, [&](int r, int k) { int rr = r < 16 ? r : 15; return B + (size_t)rr * 1024 + k; }, smem, acc);
  const int lane = tidx() & 63, w = tidx() >> 6;
  const int mb = (w / 2) * 64;
  float* ZG = (float*)(ws + W_ZG);
  const float* bin = p.in[I_BIN] + l * NIN + OFF_IG;
  if ((w & 1) == 0) {
    const int n = (lane >> 4) * 4;
    float4 bv = *(const float4*)(bin + n);
#pragma unroll
    for (int i = 0; i < 4; i++) {
      const int m = m0 + mb + i * 16 + (lane & 15);
      *(float4*)(ZG + (size_t)m * 16 + n) = make_float4(acc[i][0][0] + bv.x, acc[i][0][1] + bv.y, acc[i][0][2] + bv.z, acc[i][0][3] + bv.w);
    }
  }
}

template <int MODE, int NTL, int PN>
__device__ __forceinline__ void plain_gemm_item(const bf16_t* A, const bf16_t* Bt, bf16_t* C, int K, int item, char* smem) {
  constexpr int N = NTL * 256;
  int mt, nt;
  tile_map<NTL, PN>(item, mt, nt);
  const int m0 = mt * 256, n0 = nt * 256;
  const bf16_t* Ab = A + (size_t)m0 * K;
  const bf16_t* Bb = Bt + (size_t)n0 * K;
  f32x4 acc[8][4];
  zero_acc(acc);
  gemm_acc<256, 256, 2, 4, true>(K, [&](int r, int k) { return Ab + (size_t)r * K + k; }, [&](int r, int k) { return Bb + (size_t)perm32(r) * K + k; }, smem, acc);
  const int lane = tidx() & 63, w = tidx() >> 6;
  const int mb = (w / 4) * 128, nb = (w % 4) * 64;
#pragma unroll
  for (int jj = 0; jj < 2; jj++) {
    const int n = n0 + nb + jj * 32 + (lane >> 4) * 8;
#pragma unroll
    for (int i = 0; i < 8; i++) {
      const int m = m0 + mb + i * 16 + (lane & 15);
      float v[8];
#pragma unroll
      for (int r = 0; r < 4; r++) { v[r] = acc[i][2 * jj][r]; v[4 + r] = acc[i][2 * jj + 1][r]; }
      if (MODE == 1) {
#pragma unroll
        for (int r = 0; r < 8; r++) { v[r] = fmaxf(v[r], 0.f); v[r] *= v[r]; }
      }
      uint4 o;
      o.x = pack2(v[0], v[1]); o.y = pack2(v[2], v[3]); o.z = pack2(v[4], v[5]); o.w = pack2(v[6], v[7]);
      *(uint4*)(C + (size_t)m * N + n) = o;
    }
  }
}

template <int MODE, int NTL, int PN>
__device__ __forceinline__ void plain_gemm_chain(const bf16_t* A, const bf16_t* Bt, bf16_t* C, int K, int item, int next, bool has_next, bool preloaded, Stage& st, char* smem) {
  constexpr int N = NTL * 256;
  int mt, nt, mt2 = 0, nt2 = 0;
  tile_map<NTL, PN>(item, mt, nt);
  if (has_next) tile_map<NTL, PN>(next, mt2, nt2);
  const int m0 = mt * 256, n0 = nt * 256;
  const bf16_t* Ab = A + (size_t)m0 * K;
  const bf16_t* Bb = Bt + (size_t)n0 * K;
  const bf16_t* Ab2 = A + (size_t)mt2 * 256 * K;
  const bf16_t* Bb2 = Bt + (size_t)nt2 * 256 * K;
  f32x4 acc[8][4];
  zero_acc(acc);
  gemm_chain<256, 256, 2, 4, true>(K, [&](int r, int k) { return Ab + (size_t)r * K + k; }, [&](int r, int k) { return Bb + (size_t)perm32(r) * K + k; },
                                   preloaded, has_next, [&](int r, int k) { return Ab2 + (size_t)r * K + k; }, [&](int r, int k) { return Bb2 + (size_t)perm32(r) * K + k; }, st, smem, acc);
  const int lane = tidx() & 63, w = tidx() >> 6;
  const int mb = (w / 4) * 128, nb = (w % 4) * 64;
#pragma unroll
  for (int jj = 0; jj < 2; jj++) {
    const int n = n0 + nb + jj * 32 + (lane >> 4) * 8;
#pragma unroll
    for (int i = 0; i < 8; i++) {
      const int m = m0 + mb + i * 16 + (lane & 15);
      float v[8];
#pragma unroll
      for (int r = 0; r < 4; r++) { v[r] = acc[i][2 * jj][r]; v[4 + r] = acc[i][2 * jj + 1][r]; }
      if (MODE == 1) {
#pragma unroll
        for (int r = 0; r < 8; r++) { v[r] = fmaxf(v[r], 0.f); v[r] *= v[r]; }
      }
      uint4 o;
      o.x = pack2(v[0], v[1]); o.y = pack2(v[2], v[3]); o.z = pack2(v[4], v[5]); o.w = pack2(v[6], v[7]);
      *(uint4*)(C + (size_t)m * N + n) = o;
    }
  }
}

__device__ __forceinline__ void merge_item(const Params& p, int l, int item, char* smem) {
  int mt, nt;
  tile_map<8, 4>(item, mt, nt);
  const int m0 = mt * 256, n0 = nt * 128;
  char* ws = p.ws;
  const bf16_t* HB = (const bf16_t*)(ws + W_HBF) + (size_t)m0 * 1024;
  const bf16_t* HM = (const bf16_t*)(ws + W_HM) + (size_t)m0 * 512;
  const bf16_t* YF = (const bf16_t*)(ws + W_YF) + (size_t)m0 * 256;
  const bf16_t* YS = (const bf16_t*)(ws + W_YS) + (size_t)m0 * 256;
  const bf16_t* WG = (const bf16_t*)(ws + W_WIN) + (size_t)(OFF_GATE + n0) * 1024;
  const bf16_t* WUM = (const bf16_t*)(ws + W_WUPM) + (size_t)n0 * 512;
  const bf16_t* WUF = (const bf16_t*)(ws + W_WUPF) + (size_t)n0 * 256;
  const bf16_t* WGL = (const bf16_t*)(ws + W_WGLU) + (size_t)n0 * 256;
  const float* bin = p.in[I_BIN] + l * NIN + OFF_GATE;
  const float* bgl = p.in[I_BGLU] + l * 2048;
  uint2 mixp[4][4];
#pragma unroll
  for (int i = 0; i < 4; i++)
#pragma unroll
    for (int j = 0; j < 4; j++) mixp[i][j] = make_uint2(0u, 0u);
  bf16_t* MIX = (bf16_t*)(ws + W_MIX);
#pragma unroll 1
  for (int br = 0; br < 3; br++) {
    uint2 gp[4][4];
    {
      f32x4 acc[4][4];
      zero_acc(acc);
      const bf16_t* WGb = WG + (size_t)br * 1024 * 1024;
      gemm_acc<256, 128, 4, 2, true>(1024, [&](int r, int k) { return HB + (size_t)r * 1024 + k; }, [&](int r, int k) { return WGb + (size_t)r * 1024 + k; }, smem, acc);
#pragma unroll
      for (int j = 0; j < 4; j++) {
        const int n = n0 + ((tidx() >> 6) & 1) * 64 + j * 16 + ((tidx() >> 4) & 3) * 4;
        float4 bv = *(const float4*)(bin + br * 1024 + n);
#pragma unroll
        for (int i = 0; i < 4; i++)
          gp[i][j] = pack4(sigm(acc[i][j][0] + bv.x), sigm(acc[i][j][1] + bv.y), sigm(acc[i][j][2] + bv.z), sigm(acc[i][j][3] + bv.w));
      }
    }
    if (br == 2) {
      f32x4 a2[4][4];
      zero_acc(a2);
      gemm_acc<256, 128, 4, 2, true>(256, [&](int r, int k) { return YS + (size_t)r * 256 + k; }, [&](int r, int k) { return WGL + (size_t)(1024 + r) * 256 + k; }, smem, a2);
#pragma unroll
      for (int j = 0; j < 4; j++) {
        const int n = n0 + ((tidx() >> 6) & 1) * 64 + j * 16 + ((tidx() >> 4) & 3) * 4;
        float4 b2 = *(const float4*)(bgl + 1024 + n);
#pragma unroll
        for (int i = 0; i < 4; i++)
          gp[i][j] = pack4(lo16(gp[i][j].x) * sigm(a2[i][j][0] + b2.x), hi16(gp[i][j].x) * sigm(a2[i][j][1] + b2.y),
                           lo16(gp[i][j].y) * sigm(a2[i][j][2] + b2.z), hi16(gp[i][j].y) * sigm(a2[i][j][3] + b2.w));
      }
    }
    const bf16_t* A = br == 0 ? HM : (br == 1 ? YF : YS);
    const bf16_t* W = br == 0 ? WUM : (br == 1 ? WUF : WGL);
    const int KA = br == 0 ? 512 : 256;
    f32x4 acc[4][4];
    zero_acc(acc);
    gemm_acc<256, 128, 4, 2, true>(KA, [&](int r, int k) { return A + (size_t)r * KA + k; }, [&](int r, int k) { return W + (size_t)r * KA + k; }, smem, acc);
#pragma unroll
    for (int j = 0; j < 4; j++) {
      const int n = n0 + ((tidx() >> 6) & 1) * 64 + j * 16 + ((tidx() >> 4) & 3) * 4;
      float4 b1 = make_float4(0.f, 0.f, 0.f, 0.f);
      if (br == 2) b1 = *(const float4*)(bgl + n);
#pragma unroll
      for (int i = 0; i < 4; i++) {
        mixp[i][j] = pack4(lo16(mixp[i][j].x) + (acc[i][j][0] + b1.x) * lo16(gp[i][j].x), hi16(mixp[i][j].x) + (acc[i][j][1] + b1.y) * hi16(gp[i][j].x),
                           lo16(mixp[i][j].y) + (acc[i][j][2] + b1.z) * lo16(gp[i][j].y), hi16(mixp[i][j].y) + (acc[i][j][3] + b1.w) * hi16(gp[i][j].y));
      }
    }
  }
#pragma unroll
  for (int j = 0; j < 4; j++) {
    const int n = n0 + ((tidx() >> 6) & 1) * 64 + j * 16 + ((tidx() >> 4) & 3) * 4;
#pragma unroll
    for (int i = 0; i < 4; i++) {
      const int m = m0 + (tidx() >> 7) * 64 + i * 16 + (tidx() & 15);
      *(uint2*)(MIX + (size_t)m * 1024 + n) = mixp[i][j];
    }
  }
}

__device__ __forceinline__ void mergelite_item(const Params& p, int l, int item, char* smem) {
  int mt, nt;
  tile_map<8, 4>(item, mt, nt);
  const int m0 = mt * 256, n0 = nt * 128;
  char* ws = p.ws;
  const bf16_t* HM = (const bf16_t*)(ws + W_HM) + (size_t)m0 * 512;
  const bf16_t* YF = (const bf16_t*)(ws + W_YF) + (size_t)m0 * 256;
  const bf16_t* YS = (const bf16_t*)(ws + W_YS) + (size_t)m0 * 256;
  const bf16_t* WUM = (const bf16_t*)(ws + W_WUPM) + (size_t)n0 * 512;
  const bf16_t* WUF = (const bf16_t*)(ws + W_WUPF) + (size_t)n0 * 256;
  const bf16_t* WGL = (const bf16_t*)(ws + W_WGLU) + (size_t)n0 * 256;
  const bf16_t* WGL2 = WGL + (size_t)1024 * 256;
  const float* bgl = p.in[I_BGLU] + l * 2048;
  const bf16_t* G = (const bf16_t*)(ws + W_GATE);
  bf16_t* MIX = (bf16_t*)(ws + W_MIX);
#define MROW(i) (m0 + (tidx() >> 7) * 64 + (i) * 16 + (tidx() & 15))
#define NCOL8(jj) (n0 + ((tidx() >> 6) & 1) * 64 + (jj) * 32 + ((tidx() >> 4) & 3) * 8)
  Stage st; st.a0 = st.a1 = st.a2 = st.a3 = st.b0 = st.b1 = st.b2 = st.b3 = make_uint4(0, 0, 0, 0);
  uint2 mixp[4][4], tmpp[4][4];
#pragma unroll
  for (int i = 0; i < 4; i++)
#pragma unroll
    for (int j = 0; j < 4; j++) { mixp[i][j] = make_uint2(0u, 0u); tmpp[i][j] = make_uint2(0u, 0u); }
#pragma unroll 1
  for (int sg = 0; sg < 4; sg++) {
    const bf16_t* A = sg == 0 ? HM : (sg == 1 ? YF : YS);
    const bf16_t* W = sg == 0 ? WUM : (sg == 1 ? WUF : (sg == 2 ? WGL : WGL2));
    const int KA = sg == 0 ? 512 : 256;
    const bf16_t* A2 = sg == 0 ? YF : YS;
    const bf16_t* W2 = sg == 0 ? WUF : (sg == 1 ? WGL : WGL2);
    f32x4 acc[4][4];
    zero_acc(acc);
    gemm_chain<256, 128, 4, 2, true>(KA, [&](int r, int k) { return A + (size_t)r * KA + k; }, [&](int r, int k) { return W + (size_t)perm32(r) * KA + k; },
                                     sg > 0, sg < 3, [&](int r, int k) { return A2 + (size_t)r * 256 + k; }, [&](int r, int k) { return W2 + (size_t)perm32(r) * 256 + k; }, st, smem, acc);
    if (sg < 2) {
#pragma unroll
      for (int jj = 0; jj < 2; jj++)
#pragma unroll
        for (int i = 0; i < 4; i++) {
          const uint4 g = *(const uint4*)(G + (size_t)MROW(i) * 3072 + sg * 1024 + NCOL8(jj));
          const uint2 o0 = mixp[i][2 * jj], o1 = mixp[i][2 * jj + 1];
          mixp[i][2 * jj].x = pack2(lo16(o0.x) + acc[i][2 * jj][0] * lo16(g.x), hi16(o0.x) + acc[i][2 * jj][1] * hi16(g.x));
          mixp[i][2 * jj].y = pack2(lo16(o0.y) + acc[i][2 * jj][2] * lo16(g.y), hi16(o0.y) + acc[i][2 * jj][3] * hi16(g.y));
          mixp[i][2 * jj + 1].x = pack2(lo16(o1.x) + acc[i][2 * jj + 1][0] * lo16(g.z), hi16(o1.x) + acc[i][2 * jj + 1][1] * hi16(g.z));
          mixp[i][2 * jj + 1].y = pack2(lo16(o1.y) + acc[i][2 * jj + 1][2] * lo16(g.w), hi16(o1.y) + acc[i][2 * jj + 1][3] * hi16(g.w));
        }
    } else if (sg == 2) {
#pragma unroll
      for (int jj = 0; jj < 2; jj++) {
        const float4 b0 = *(const float4*)(bgl + NCOL8(jj)), b1 = *(const float4*)(bgl + NCOL8(jj) + 4);
#pragma unroll
        for (int i = 0; i < 4; i++) {
          tmpp[i][2 * jj].x = pack2(acc[i][2 * jj][0] + b0.x, acc[i][2 * jj][1] + b0.y);
          tmpp[i][2 * jj].y = pack2(acc[i][2 * jj][2] + b0.z, acc[i][2 * jj][3] + b0.w);
          tmpp[i][2 * jj + 1].x = pack2(acc[i][2 * jj + 1][0] + b1.x, acc[i][2 * jj + 1][1] + b1.y);
          tmpp[i][2 * jj + 1].y = pack2(acc[i][2 * jj + 1][2] + b1.z, acc[i][2 * jj + 1][3] + b1.w);
        }
      }
    } else {
#pragma unroll
      for (int jj = 0; jj < 2; jj++) {
        const float4 b0 = *(const float4*)(bgl + 1024 + NCOL8(jj)), b1 = *(const float4*)(bgl + 1024 + NCOL8(jj) + 4);
#pragma unroll
        for (int i = 0; i < 4; i++) {
          const uint4 g = *(const uint4*)(G + (size_t)MROW(i) * 3072 + 2048 + NCOL8(jj));
          const uint2 t0 = tmpp[i][2 * jj], t1 = tmpp[i][2 * jj + 1], o0 = mixp[i][2 * jj], o1 = mixp[i][2 * jj + 1];
          uint4 o;
          o.x = pack2(lo16(o0.x) + lo16(t0.x) * sigm(acc[i][2 * jj][0] + b0.x) * lo16(g.x), hi16(o0.x) + hi16(t0.x) * sigm(acc[i][2 * jj][1] + b0.y) * hi16(g.x));
          o.y = pack2(lo16(o0.y) + lo16(t0.y) * sigm(acc[i][2 * jj][2] + b0.z) * lo16(g.y), hi16(o0.y) + hi16(t0.y) * sigm(acc[i][2 * jj][3] + b0.w) * hi16(g.y));
          o.z = pack2(lo16(o1.x) + lo16(t1.x) * sigm(acc[i][2 * jj + 1][0] + b1.x) * lo16(g.z), hi16(o1.x) + hi16(t1.x) * sigm(acc[i][2 * jj + 1][1] + b1.y) * hi16(g.z));
          o.w = pack2(lo16(o1.y) + lo16(t1.y) * sigm(acc[i][2 * jj + 1][2] + b1.z) * lo16(g.w), hi16(o1.y) + hi16(t1.y) * sigm(acc[i][2 * jj + 1][3] + b1.w) * hi16(g.w));
          *(uint4*)(MIX + (size_t)MROW(i) * 1024 + NCOL8(jj)) = o;
        }
      }
    }
  }
#undef MROW
#undef NCOL8
}

__device__ __forceinline__ void four_g1(const Params& p, int item, char* smem) {
  const int g = item & 3, s2 = (item >> 2) & 63, b = item >> 8;
  char* ws = p.ws;
  const bf16_t* Z = (const bf16_t*)(ws + W_Z) + ((size_t)b * SEQ + s2) * ZS + OFF_F + g * 64;
  const bf16_t* F1T = (const bf16_t*)(ws + W_F1T);
  f32x4 acc[2][4];
  zero_acc(acc);
  gemm_acc<128, 128, 4, 2, false>(64, [&](int r, int k) { return Z + (size_t)r * 64 * ZS + k; }, [&](int r, int k) { return F1T + r * 64 + k; }, smem, acc);
  const int lane = tidx() & 63, w = tidx() >> 6;
  const int mb = (w / 2) * 32, nb = (w % 2) * 64;
  bf16_t* U1T = (bf16_t*)(ws + W_U1T);
#pragma unroll
  for (int i = 0; i < 2; i++) {
    const int s1 = mb + i * 16 + (lane >> 4) * 4;
#pragma unroll
    for (int j = 0; j < 4; j++) {
      const int n = nb + j * 16 + (lane & 15), c = n >> 6, jj = n & 63;
      size_t off = ((((size_t)(b * 256 + g * 64 + jj) * 64 + s2) * 2 + c) * 128) + s1;
      *(uint2*)(U1T + off) = pack4(acc[i][j][0], acc[i][j][1], acc[i][j][2], acc[i][j][3]);
    }
  }
}
__device__ __forceinline__ void four_g2(const Params& p, int item, char* smem) {
  const int mt = item >> 1, nt = item & 1;
  const int m0 = mt * 128, n0 = nt * 128;
  char* ws = p.ws;
  const bf16_t* A = (const bf16_t*)(ws + W_U1T) + (size_t)m0 * 256;
  const bf16_t* B = (const bf16_t*)(ws + W_F2T) + (size_t)n0 * 256;
  f32x4 acc[2][4];
  zero_acc(acc);
  gemm_acc<128, 128, 4, 2, false>(256, [&](int r, int k) { return A + (size_t)r * 256 + k; }, [&](int r, int k) { return B + (size_t)r * 256 + k; }, smem, acc);
  const int lane = tidx() & 63, w = tidx() >> 6;
  const int mb = (w / 2) * 32, nb = (w % 2) * 64;
  const float* TW = (const float*)(ws + W_TW);
  bf16_t* A2T = (bf16_t*)(ws + W_A2T);
#pragma unroll
  for (int i = 0; i < 2; i++) {
    const int m = m0 + mb + i * 16 + (lane >> 4) * 4;
    const int s2 = m & 63, col = (m >> 6) & 255, b = m >> 14;
#pragma unroll
    for (int jp = 0; jp < 2; jp++) {
      const int nn = n0 + nb + jp * 32;
      const int k1 = (nn >> 5) * 16 + (lane & 15);
      float re[4], im[4];
#pragma unroll
      for (int r = 0; r < 4; r++) {
        float c = TW[((s2 + r) * 128 + k1) * 2], s = TW[((s2 + r) * 128 + k1) * 2 + 1];
        float ar = acc[i][jp * 2][r], ai = acc[i][jp * 2 + 1][r];
        re[r] = ar * c + ai * s;
        im[r] = ai * c - ar * s;
      }
      size_t off = ((size_t)(b * 128 + k1) * 256 + col) * 128 + s2;
      *(uint2*)(A2T + off) = pack4(re[0], re[1], re[2], re[3]);
      *(uint2*)(A2T + off + 64) = pack4(im[0], im[1], im[2], im[3]);
    }
  }
}
__device__ __forceinline__ void four_g3(const Params& p, int item, char* smem) {
  const int m0 = item * 128;
  char* ws = p.ws;
  const bf16_t* A = (const bf16_t*)(ws + W_A2T) + (size_t)m0 * 128;
  const bf16_t* B = (const bf16_t*)(ws + W_F3T);
  f32x4 acc[2][2];
  zero_acc(acc);
  gemm_acc<128, 64, 4, 2, false>(128, [&](int r, int k) { return A + (size_t)r * 128 + k; }, [&](int r, int k) { return B + r * 128 + k; }, smem, acc);
  const int lane = tidx() & 63, w = tidx() >> 6;
  const int mb = (w / 2) * 32, nb = (w % 2) * 32;
  bf16_t* YF = (bf16_t*)(ws + W_YF);
#pragma unroll
  for (int i = 0; i < 2; i++) {
    const int m = m0 + mb + i * 16 + (lane >> 4) * 4;
    const int col = m & 255, k1 = (m >> 8) & 127, b = m >> 15;
#pragma unroll
    for (int j = 0; j < 2; j++) {
      const int k2 = nb + j * 16 + (lane & 15);
      size_t off = ((size_t)b * SEQ + k1 + 128 * k2) * 256 + col;
      *(uint2*)(YF + off) = pack4(acc[i][j][0], acc[i][j][1], acc[i][j][2], acc[i][j][3]);
    }
  }
}

__device__ __forceinline__ void s5_e(const Params& p, int item, char* smem) {
  const int g = item >> 3, mt = (item >> 1) & 3, nt = item & 1;
  const int m0 = mt * 128, n0 = nt * 128;
  char* ws = p.ws;
  const bf16_t* Z = (const bf16_t*)(ws + W_Z) + OFF_S + g * 16;
  const bf16_t* B = (const bf16_t*)(ws + W_ET) + ((size_t)g * 256 + n0) * 512;
  f32x4 acc[2][4];
  zero_acc(acc);
  gemm_acc<128, 128, 4, 2, true>(512,
      [&](int r, int k) { int m = m0 + r; int tok = (m >> 8) * SEQ + (m & 255) * 32 + (k >> 4); return Z + (size_t)tok * ZS + (k & 15); },
      [&](int r, int k) { return B + (size_t)r * 512 + k; }, smem, acc);
  const int lane = tidx() & 63, w = tidx() >> 6;
  const int mb = (w / 2) * 32, nb = (w % 2) * 64;
  bf16_t* XE = (bf16_t*)(ws + W_XEND);
#pragma unroll
  for (int i = 0; i < 2; i++) {
    const int m = m0 + mb + i * 16 + (lane & 15);
#pragma unroll
    for (int j = 0; j < 4; j++) {
      const int n = n0 + nb + j * 16 + (lane >> 4) * 4;
      *(uint2*)(XE + ((size_t)m * 16 + g) * 256 + n) = pack4(acc[i][j][0], acc[i][j][1], acc[i][j][2], acc[i][j][3]);
    }
  }
}
__device__ __forceinline__ void s5_carry(const Params& p, int blk) {
  const int gt = blk * NT + tidx();
  const int b = gt >> 11, g = (gt >> 7) & 15, d = (gt >> 6) & 1, pp = gt & 63;
  char* ws = p.ws;
  const float* LP = (const float*)(ws + W_LPOW) + ((d * 16 + g) * 64 + pp) * 2;
  const float lr = LP[0], li = LP[1];
  const uint32_t* XE = (const uint32_t*)(ws + W_XEND);
  uint32_t* XC = (uint32_t*)(ws + W_XCAR);
  float xr = 0.f, xi = 0.f;
  for (int c0 = 0; c0 < 256; c0 += 32) {
    uint32_t v[32];
#pragma unroll
    for (int u = 0; u < 32; u++) {
      int c = d == 0 ? c0 + u : 255 - (c0 + u);
      v[u] = XE[(((size_t)(b * 256 + c) * 16 + g) * 256 + d * 128 + pp * 2) >> 1];
    }
#pragma unroll
    for (int u = 0; u < 32; u++) {
      int c = d == 0 ? c0 + u : 255 - (c0 + u);
      float nr = lr * xr - li * xi + lo16(v[u]);
      float ni = lr * xi + li * xr + hi16(v[u]);
      xr = nr; xi = ni;
      XC[(((size_t)(b * 256 + c) * 16 + g) * 256 + d * 128 + pp * 2) >> 1] = pack2(xr, xi);
    }
  }
}
__device__ __forceinline__ void s5_tg(const Params& p, int item, char* smem) {
  const int g = item >> 4, mt = (item >> 2) & 3, nt = item & 3;
  const int m0 = mt * 128, n0 = nt * 128;
  char* ws = p.ws;
  const bf16_t* Z = (const bf16_t*)(ws + W_Z) + OFF_S + g * 16;
  const bf16_t* XC = (const bf16_t*)(ws + W_XCAR);
  const bf16_t* ZR = (const bf16_t*)(ws + W_ZERO);
  const bf16_t* B = (const bf16_t*)(ws + W_TG) + ((size_t)g * 512 + n0) * 768;
  f32x4 acc[2][4];
  zero_acc(acc);
  gemm_acc<128, 128, 4, 2, true>(768,
      [&](int r, int k) -> const bf16_t* {
        int m = m0 + r; int b = m >> 8, c = m & 255;
        if (k < 512) { int tok = b * SEQ + c * 32 + (k >> 4); return Z + (size_t)tok * ZS + (k & 15); }
        int kk = k - 512; int d = kk >> 7; int cc = d == 0 ? c - 1 : c + 1;
        if (cc < 0 || cc > 255) return ZR;
        return XC + ((size_t)(b * 256 + cc) * 16 + g) * 256 + kk;
      },
      [&](int r, int k) { return B + (size_t)r * 768 + k; }, smem, acc);
  const int lane = tidx() & 63, w = tidx() >> 6;
  const int mb = (w / 2) * 32, nb = (w % 2) * 64;
  bf16_t* YS = (bf16_t*)(ws + W_YS);
#pragma unroll
  for (int i = 0; i < 2; i++) {
    const int m = m0 + mb + i * 16 + (lane & 15);
    const int b = m >> 8, c = m & 255;
#pragma unroll
    for (int j = 0; j < 4; j++) {
      const int n = n0 + nb + j * 16 + (lane >> 4) * 4;
      const int t = n >> 4, co = n & 15;
      size_t off = ((size_t)b * SEQ + c * 32 + t) * 256 + g * 16 + co;
      *(uint2*)(YS + off) = pack4(gelu_tanh(acc[i][j][0]), gelu_tanh(acc[i][j][1]), gelu_tanh(acc[i][j][2]), gelu_tanh(acc[i][j][3]));
    }
  }
}

__device__ __forceinline__ void conv8(const bf16_t* __restrict__ Z, const float* __restrict__ cw, const float* __restrict__ cb,
                                      int b, int s, int zcol, int ch, float (&o)[8]) {
  float4 b0 = *(const float4*)(cb + ch), b1 = *(const float4*)(cb + ch + 4);
  o[0] = b0.x; o[1] = b0.y; o[2] = b0.z; o[3] = b0.w; o[4] = b1.x; o[5] = b1.y; o[6] = b1.z; o[7] = b1.w;
#pragma unroll
  for (int wq = 0; wq < 5; wq++) {
    int ss = s + wq - 2;
    if (ss >= 0 && ss < SEQ) {
      uint4 v = *(const uint4*)(Z + ((size_t)b * SEQ + ss) * ZS + zcol);
      float4 w0 = *(const float4*)(cw + wq * 1024 + ch), w1 = *(const float4*)(cw + wq * 1024 + ch + 4);
      o[0] += w0.x * lo16(v.x); o[1] += w0.y * hi16(v.x); o[2] += w0.z * lo16(v.y); o[3] += w0.w * hi16(v.y);
      o[4] += w1.x * lo16(v.z); o[5] += w1.y * hi16(v.z); o[6] += w1.z * lo16(v.w); o[7] += w1.w * hi16(v.w);
    }
  }
#pragma unroll
  for (int e = 0; e < 8; e++) o[e] = o[e] * sigm(o[e]);
}

template <class OUT>
__device__ __forceinline__ void conv4x8(const bf16_t* __restrict__ Z, const float* __restrict__ cw, const float* __restrict__ cb,
                                        int b, int s0, int i0, int zcol, int ch, OUT out) {
  float wt[5][8], o[4][8];
  {
    float4 b0 = *(const float4*)(cb + ch), b1 = *(const float4*)(cb + ch + 4);
#pragma unroll
    for (int t = 0; t < 4; t++) { o[t][0] = b0.x; o[t][1] = b0.y; o[t][2] = b0.z; o[t][3] = b0.w; o[t][4] = b1.x; o[t][5] = b1.y; o[t][6] = b1.z; o[t][7] = b1.w; }
  }
#pragma unroll
  for (int wq = 0; wq < 5; wq++) {
    float4 w0 = *(const float4*)(cw + wq * 1024 + ch), w1 = *(const float4*)(cw + wq * 1024 + ch + 4);
    wt[wq][0] = w0.x; wt[wq][1] = w0.y; wt[wq][2] = w0.z; wt[wq][3] = w0.w; wt[wq][4] = w1.x; wt[wq][5] = w1.y; wt[wq][6] = w1.z; wt[wq][7] = w1.w;
  }
#pragma unroll
  for (int r = 0; r < 8; r++) {
    const int ss = s0 + i0 - 2 + r;
    uint4 v = make_uint4(0u, 0u, 0u, 0u);
    if (ss >= 0 && ss < SEQ) v = *(const uint4*)(Z + ((size_t)b * SEQ + ss) * ZS + zcol);
    float rf[8];
    rf[0] = lo16(v.x); rf[1] = hi16(v.x); rf[2] = lo16(v.y); rf[3] = hi16(v.y); rf[4] = lo16(v.z); rf[5] = hi16(v.z); rf[6] = lo16(v.w); rf[7] = hi16(v.w);
#pragma unroll
    for (int t = 0; t < 4; t++) {
      const int wq = r - t;
      if (wq >= 0 && wq < 5) {
#pragma unroll
        for (int e = 0; e < 8; e++) o[t][e] += wt[wq][e] * rf[e];
      }
    }
  }
#pragma unroll
  for (int t = 0; t < 4; t++) {
#pragma unroll
    for (int e = 0; e < 8; e++) o[t][e] = o[t][e] * sigm(o[t][e]);
    out(t, o[t]);
  }
}

__device__ __forceinline__ void mlstm_local(const Params& p, int l, int item, char* smem) {
  const int co = item & 63, h = (item >> 6) & 3, b = item >> 8;
  char* ws = p.ws;
  bf16_t* KTs = (bf16_t*)smem;
  bf16_t* VTs = KTs + 128 * LDT;
  float* WV = (float*)(VTs + 128 * LDT);
  const int tid = tidx(), lane = tid & 63, w = tid >> 6;
  const int tok0 = b * SEQ + co * 128;
  const bf16_t* Z = (const bf16_t*)(ws + W_Z);
  const float* ZG = (const float*)(ws + W_ZG);
  if (w < 2) {
    const int d = w, dbh = d * 8 + b * 4 + h, cp = d ? 63 - co : co;
    const int l0 = 2 * lane, l1 = l0 + 1;
    const int i0 = d ? 127 - l0 : l0, i1 = d ? 127 - l1 : l1;
    float ig0 = ZG[(size_t)(tok0 + i0) * 16 + d * 4 + h], ig1 = ZG[(size_t)(tok0 + i1) * 16 + d * 4 + h];
    float f0 = logsig(ZG[(size_t)(tok0 + i0) * 16 + 8 + d * 4 + h]), f1 = logsig(ZG[(size_t)(tok0 + i1) * 16 + 8 + d * 4 + h]);
    float s1 = f0 + f1;
    float incl = wave_incl_sum(s1, lane);
    float excl = incl - s1;
    float b0 = excl + f0, b1 = incl;
    float gtot = __shfl(incl, 63);
    float a0 = gtot - b0 + ig0, a1 = gtot - b1 + ig1;
    float am = wave_max(fmaxf(a0, a1));
    WV[d * 128 + i0] = expf(a0 - am);
    WV[d * 128 + i1] = expf(a1 - am);
    if (lane == 0) {
      ((float*)(ws + W_AMAX))[dbh * 64 + cp] = am;
      ((float*)(ws + W_G))[dbh * 64 + cp] = gtot;
    }
  }
  const float* cw = p.in[I_CW] + l * 5 * 1024;
  const float* cb = p.in[I_CB] + l * 1024;
  {
    const int i0 = (tid & 31) * 4, d8 = (tid >> 5) * 8;
    conv4x8(Z, cw, cb, b, co * 128, i0, OFF_K + h * 128 + d8, 512 + h * 128 + d8, [&](int t, const float (&o)[8]) {
#pragma unroll
      for (int e = 0; e < 8; e++) KTs[(d8 + e) * LDT + i0 + t] = f2bf(o[e]);
    });
  }
  __syncthreads();
  if (tid < 256) {
    const int d = tid >> 7, k = tid & 127;
    const int dbh = d * 8 + b * 4 + h, cp = d ? 63 - co : co;
    float s = 0.f;
    for (int i = 0; i < 128; i++) s += WV[d * 128 + i] * bf2f(KTs[k * LDT + i]);
    ((float*)(ws + W_NST))[(size_t)(dbh * 64 + cp) * 128 + k] = s;
  }
  bf16_t* CST = (bf16_t*)(ws + W_CST);
  const int mb = (w / 2) * 32, nb = (w % 2) * 64;
#pragma unroll 1
  for (int d = 0; d < 2; d++) {
    const int dbh = d * 8 + b * 4 + h, cp = d ? 63 - co : co;
#pragma unroll 1
    for (int t = 0; t < 4; t++) {
      int c = tid + t * NT, i = c & 127, e8 = (c >> 7) * 8;
      uint4 v = *(const uint4*)(Z + (size_t)(tok0 + i) * ZS + OFF_V + h * 128 + e8);
      float wv = WV[d * 128 + i];
      VTs[(e8 + 0) * LDT + i] = f2bf(lo16(v.x) * wv); VTs[(e8 + 1) * LDT + i] = f2bf(hi16(v.x) * wv);
      VTs[(e8 + 2) * LDT + i] = f2bf(lo16(v.y) * wv); VTs[(e8 + 3) * LDT + i] = f2bf(hi16(v.y) * wv);
      VTs[(e8 + 4) * LDT + i] = f2bf(lo16(v.z) * wv); VTs[(e8 + 5) * LDT + i] = f2bf(hi16(v.z) * wv);
      VTs[(e8 + 6) * LDT + i] = f2bf(lo16(v.w) * wv); VTs[(e8 + 7) * LDT + i] = f2bf(hi16(v.w) * wv);
    }
    __syncthreads();
    f32x4 acc[2][4];
    zero_acc(acc);
    mma_lds<2, 4, false>(KTs, VTs, 128, mb, nb, acc);
    bf16_t* C = CST + (size_t)(dbh * 64 + cp) * 16384;
#pragma unroll
    for (int i = 0; i < 2; i++) {
      const int k = mb + i * 16 + (lane >> 4) * 4;
#pragma unroll
      for (int j = 0; j < 4; j++) {
        const int e = nb + j * 16 + (lane & 15);
        *(uint2*)(C + e * 128 + k) = pack4(acc[i][j][0], acc[i][j][1], acc[i][j][2], acc[i][j][3]);
      }
    }
    __syncthreads();
  }
}

__device__ __forceinline__ void mlstm_scan(const Params& p, int blk) {
  char* ws = p.ws;
  const float* AM = (const float*)(ws + W_AMAX);
  const float* G = (const float*)(ws + W_G);
  if (blk < 128) {
    const int gt = blk * NT + tidx(), dbh = gt >> 12, e4 = gt & 4095;
    uint2* C = (uint2*)(ws + W_CST) + (size_t)dbh * 64 * 4096 + e4;
    float m = 0.f, c0 = 0.f, c1 = 0.f, c2 = 0.f, c3 = 0.f;
    for (int cc0 = 0; cc0 < 64; cc0 += 16) {
      uint2 v[16];
      float gg[16], aa[16];
#pragma unroll
      for (int u = 0; u < 16; u++) { v[u] = C[(size_t)(cc0 + u) * 4096]; gg[u] = G[dbh * 64 + cc0 + u]; aa[u] = AM[dbh * 64 + cc0 + u]; }
#pragma unroll
      for (int u = 0; u < 16; u++) {
        const int cc = cc0 + u;
        float g = gg[u], am = aa[u];
        float mn = fmaxf(g + m, am);
        float so = __expf(g + m - mn), sn = __expf(am - mn);
        C[(size_t)cc * 4096] = pack4(c0, c1, c2, c3);
        if (e4 == 0) ((float*)(ws + W_MPREV))[dbh * 64 + cc] = m;
        c0 = so * c0 + sn * lo16(v[u].x); c1 = so * c1 + sn * hi16(v[u].x);
        c2 = so * c2 + sn * lo16(v[u].y); c3 = so * c3 + sn * hi16(v[u].y);
        m = mn;
      }
    }
  } else {
    const int gt = (blk - 128) * NT + tidx(), dbh = gt >> 7, k = gt & 127;
    float* N = (float*)(ws + W_NST) + (size_t)dbh * 64 * 128 + k;
    float m = 0.f, n = 0.f;
    for (int cc = 0; cc < 64; cc++) {
      float g = G[dbh * 64 + cc], am = AM[dbh * 64 + cc];
      float mn = fmaxf(g + m, am);
      float so = expf(g + m - mn), sn = expf(am - mn);
      float v = N[cc * 128];
      N[cc * 128] = n;
      n = so * n + sn * v;
      m = mn;
    }
  }
}

__device__ __forceinline__ void mlstm_out(const Params& p, int l, int item, char* smem) {
  const int co = item & 63, h = (item >> 6) & 3, b = item >> 8;
  char* ws = p.ws;
  bf16_t* B0 = (bf16_t*)smem;
  bf16_t* B1 = B0 + 128 * LDT;
  bf16_t* B2 = B1 + 128 * LDT;
  bf16_t* B3 = B2 + 128 * LDT;
  float* FU = (float*)(B3 + 128 * LDT);
  float* FMM = FU + 256;
  float* FIW = FMM + 256;
  float* FEN = FIW + 256;
  float* FNP = FEN + 256;
  const int tid = tidx(), lane = tid & 63, w = tid >> 6;
  const int tok0 = b * SEQ + co * 128;
  const bf16_t* Z = (const bf16_t*)(ws + W_Z);
  const float* ZG = (const float*)(ws + W_ZG);
  const bf16_t* C0p = (const bf16_t*)(ws + W_CST) + (size_t)((0 * 8 + b * 4 + h) * 64 + co) * 16384;
  const bf16_t* C1p = (const bf16_t*)(ws + W_CST) + (size_t)((1 * 8 + b * 4 + h) * 64 + (63 - co)) * 16384;
#define PFV(t) (*(const uint4*)(Z + (size_t)(tok0 + ((tid + (t) * NT) & 127)) * ZS + OFF_V + h * 128 + ((tid + (t) * NT) >> 7) * 8))
#define PFC(P, t) (*(const uint4*)((P) + ((tid + (t) * NT) >> 4) * 128 + ((tid + (t) * NT) & 15) * 8))
  const uint4 vp0 = PFV(0), vp1 = PFV(1), vp2 = PFV(2), vp3 = PFV(3);
  const uint4 ca0 = PFC(C0p, 0), ca1 = PFC(C0p, 1), ca2 = PFC(C0p, 2), ca3 = PFC(C0p, 3);
  const uint4 cb0 = PFC(C1p, 0), cb1 = PFC(C1p, 1), cb2 = PFC(C1p, 2), cb3 = PFC(C1p, 3);
#undef PFV
#undef PFC
  if (w < 2) {
    const int d = w, dbh = d * 8 + b * 4 + h, cp = d ? 63 - co : co;
    const float mprev = ((const float*)(ws + W_MPREV))[dbh * 64 + cp];
    const int l0 = 2 * lane, l1 = l0 + 1;
    const int i0 = d ? 127 - l0 : l0, i1 = d ? 127 - l1 : l1;
    float ig0 = ZG[(size_t)(tok0 + i0) * 16 + d * 4 + h], ig1 = ZG[(size_t)(tok0 + i1) * 16 + d * 4 + h];
    float f0 = logsig(ZG[(size_t)(tok0 + i0) * 16 + 8 + d * 4 + h]), f1 = logsig(ZG[(size_t)(tok0 + i1) * 16 + 8 + d * 4 + h]);
    float s1 = f0 + f1;
    float incl = wave_incl_sum(s1, lane);
    float b0 = incl - s1 + f0, b1 = incl;
    float u0 = ig0 - b0, u1 = ig1 - b1;
    float pm1 = fmaxf(u0, u1);
    float inclm = wave_incl_max(pm1, lane);
    float exclm = __shfl_up(inclm, 1);
    if (lane == 0) exclm = -INFINITY;
    float r0 = fmaxf(exclm, u0), r1 = fmaxf(exclm, pm1);
    float mm0 = fmaxf(mprev, r0), mm1 = fmaxf(mprev, r1);
    FU[d * 128 + i0] = u0; FU[d * 128 + i1] = u1;
    FMM[d * 128 + i0] = mm0; FMM[d * 128 + i1] = mm1;
    FIW[d * 128 + i0] = expf(mprev - mm0); FIW[d * 128 + i1] = expf(mprev - mm1);
    FEN[d * 128 + i0] = expf(-(b0 + mm0)); FEN[d * 128 + i1] = expf(-(b1 + mm1));
  }
  if (tid < 256) {
    const int d = tid >> 7, k = tid & 127;
    const int dbh = d * 8 + b * 4 + h, cp = d ? 63 - co : co;
    FNP[tid] = ((const float*)(ws + W_NST))[(size_t)(dbh * 64 + cp) * 128 + k];
  }
  const float* cw = p.in[I_CW] + l * 5 * 1024;
  const float* cb = p.in[I_CB] + l * 1024;
  const float qscale = 0.08838834764831845f;
  const int mb = w * 16;
  const int irow = mb + (lane & 15);
  f32x4 hf[8];
  {
    const int d8 = (tid & 15) * 8, i0 = (tid >> 4) * 4;
    conv4x8(Z, cw, cb, b, co * 128, i0, h * 128 + d8, h * 128 + d8, [&](int t, const float (&o)[8]) {
      uint4 q;
      q.x = pack2(o[0] * qscale, o[1] * qscale); q.y = pack2(o[2] * qscale, o[3] * qscale);
      q.z = pack2(o[4] * qscale, o[5] * qscale); q.w = pack2(o[6] * qscale, o[7] * qscale);
      *(uint4*)&B0[(i0 + t) * LDT + d8] = q;
    });
    conv4x8(Z, cw, cb, b, co * 128, i0, OFF_K + h * 128 + d8, 512 + h * 128 + d8, [&](int t, const float (&o)[8]) {
      uint4 q;
      q.x = pack2(o[0], o[1]); q.y = pack2(o[2], o[3]); q.z = pack2(o[4], o[5]); q.w = pack2(o[6], o[7]);
      *(uint4*)&B1[(i0 + t) * LDT + d8] = q;
    });
  }
  __syncthreads();
  f32x4 accS[1][8];
  zero_acc(accS);
  mma_lds<1, 8, true>(B0, B1, 128, mb, 0, accS);
  float qn0 = 0.f, qn1 = 0.f;
  {
    const int kq0 = (lane >> 4) * 32;
#pragma unroll 8
    for (int k = 0; k < 32; k++) { float qv = bf2f(B0[irow * LDT + kq0 + k]); qn0 += qv * FNP[kq0 + k]; qn1 += qv * FNP[128 + kq0 + k]; }
  }
  qn0 += __shfl_xor(qn0, 16); qn0 += __shfl_xor(qn0, 32);
  qn1 += __shfl_xor(qn1, 16); qn1 += __shfl_xor(qn1, 32);
  __syncthreads();
#define VTS(t, v)                                                                                         \
  {                                                                                                       \
    const int c_ = tid + (t) * NT, j_ = c_ & 127, e8_ = (c_ >> 7) * 8;                                    \
    B1[(e8_ + 0) * LDT + j_] = (bf16_t)((v).x & 0xffff); B1[(e8_ + 1) * LDT + j_] = (bf16_t)((v).x >> 16); \
    B1[(e8_ + 2) * LDT + j_] = (bf16_t)((v).y & 0xffff); B1[(e8_ + 3) * LDT + j_] = (bf16_t)((v).y >> 16); \
    B1[(e8_ + 4) * LDT + j_] = (bf16_t)((v).z & 0xffff); B1[(e8_ + 5) * LDT + j_] = (bf16_t)((v).z >> 16); \
    B1[(e8_ + 6) * LDT + j_] = (bf16_t)((v).w & 0xffff); B1[(e8_ + 7) * LDT + j_] = (bf16_t)((v).w >> 16); \
  }
  VTS(0, vp0) VTS(1, vp1) VTS(2, vp2) VTS(3, vp3)
#undef VTS
#define CST_(t, v) { const int c_ = tid + (t) * NT; *(uint4*)&B3[(c_ >> 4) * LDT + (c_ & 15) * 8] = (v); }
#pragma unroll
  for (int d = 0; d < 2; d++) {
    if (d == 0) { CST_(0, ca0) CST_(1, ca1) CST_(2, ca2) CST_(3, ca3) }
    else { CST_(0, cb0) CST_(1, cb1) CST_(2, cb2) CST_(3, cb3) }
    const float mmi = FMM[d * 128 + irow];
    float rowsum = 0.f;
#pragma unroll
    for (int jt = 0; jt < 8; jt++) {
      const int j0 = jt * 16 + (lane >> 4) * 4;
      float pv[4];
#pragma unroll
      for (int r = 0; r < 4; r++) {
        const int j = j0 + r;
        const bool ok = d ? (j >= irow) : (j <= irow);
        float e = ok ? accS[0][jt][r] * __expf(FU[d * 128 + j] - mmi) : 0.f;
        pv[r] = e; rowsum += e;
      }
      *(uint2*)&B2[irow * LDT + j0] = pack4(pv[0], pv[1], pv[2], pv[3]);
    }
    rowsum += __shfl_xor(rowsum, 16); rowsum += __shfl_xor(rowsum, 32);
    const float iw = FIW[d * 128 + irow];
    const float den = rowsum + iw * (d ? qn1 : qn0);
    __syncthreads();
    f32x4 acc[1][8];
    zero_acc(acc);
    mma_lds<1, 8, true>(B0, B3, 128, mb, 0, acc);
#pragma unroll
    for (int jt = 0; jt < 8; jt++) { acc[0][jt][0] *= iw; acc[0][jt][1] *= iw; acc[0][jt][2] *= iw; acc[0][jt][3] *= iw; }
    mma_lds<1, 8, true>(B2, B1, 128, mb, 0, acc);
    const float dn = 1.f / fmaxf(fabsf(den), FEN[d * 128 + irow]);
    if (d == 0) {
#pragma unroll
      for (int jt = 0; jt < 8; jt++) hf[jt] = acc[0][jt] * dn;
      __syncthreads();
    } else {
#pragma unroll
      for (int jt = 0; jt < 8; jt++) hf[jt] += acc[0][jt] * dn;
    }
  }
#undef CST_
  float s = 0.f;
#pragma unroll
  for (int jt = 0; jt < 8; jt++) s += hf[jt][0] + hf[jt][1] + hf[jt][2] + hf[jt][3];
  s += __shfl_xor(s, 16); s += __shfl_xor(s, 32);
  const float mu = s * (1.f / 128.f);
  float v = 0.f;
#pragma unroll
  for (int jt = 0; jt < 8; jt++)
#pragma unroll
    for (int r = 0; r < 4; r++) { float dd = hf[jt][r] - mu; v += dd * dd; }
  v += __shfl_xor(v, 16); v += __shfl_xor(v, 32);
  const float rs = rsqrtf(v * (1.f / 128.f) + EPS);
  const float* ng = p.in[I_MNG] + l * 512 + h * 128;
  bf16_t* HM = (bf16_t*)(ws + W_HM);
  const size_t tok = (size_t)tok0 + irow;
#pragma unroll
  for (int jt = 0; jt < 8; jt++) {
    const int e = jt * 16 + (lane >> 4) * 4;
    float4 gv = *(const float4*)(ng + e);
    uint2 zo = *(const uint2*)(Z + tok * ZS + OFF_O + h * 128 + e);
    float o0 = (hf[jt][0] - mu) * rs * gv.x * sigm(lo16(zo.x));
    float o1 = (hf[jt][1] - mu) * rs * gv.y * sigm(hi16(zo.x));
    float o2 = (hf[jt][2] - mu) * rs * gv.z * sigm(lo16(zo.y));
    float o3 = (hf[jt][3] - mu) * rs * gv.w * sigm(hi16(zo.y));
    *(uint2*)(HM + tok * 512 + h * 128 + e) = pack4(o0, o1, o2, o3);
  }
  __syncthreads();
}

#define XB_TMO      128
#define XB_XCNT(j)  (256  + 64 * (j))
#define XB_XSUB(j)  (1280 + 64 * (j))
#define XB_XGEN(j)  (2304 + 64 * (j))
#define XB_TOP      3328
#define XB_TOPGEN   3392
#define XCD_BAR_WORDS 3456
#define XB_SPIN_CAP (1u << 22)
#define LAS __attribute__((address_space(3)))
__device__ __forceinline__ unsigned xb_ld(unsigned* p) { return __hip_atomic_load(p, __ATOMIC_RELAXED, __HIP_MEMORY_SCOPE_AGENT); }
__device__ __forceinline__ unsigned xb_add(unsigned* p, unsigned v) { return __hip_atomic_fetch_add(p, v, __ATOMIC_RELAXED, __HIP_MEMORY_SCOPE_AGENT); }
__device__ __forceinline__ unsigned xb_xcc_id() { return (unsigned)__builtin_amdgcn_s_getreg((3 << 11) | 20) & 0xFu; }
#define XB_SPIN(cond, bar) do { unsigned _sp = 0; while (cond) { __builtin_amdgcn_s_sleep(1); \
    if ((++_sp & 255u) == 0u) { if (xb_ld(&(bar)[XB_TMO])) break; if (_sp > XB_SPIN_CAP) { atomicAdd(&(bar)[XB_TMO], 1u); break; } } } } while (0)
struct XcdBarrier { unsigned* bar; unsigned x; volatile LAS unsigned* st; };
__device__ __forceinline__ XcdBarrier xcd_barrier_post(unsigned* bar, volatile LAS unsigned* st) {
  XcdBarrier b; b.bar = bar; b.x = xb_xcc_id(); b.st = st;
  if (threadIdx.x == 0) (void)xb_add(&bar[XB_XCNT(b.x)], 1u);
  return b;
}
__device__ __forceinline__ void xcd_barrier_complete(unsigned* bar, unsigned x, unsigned& nloc, unsigned& nx) {
  const unsigned G = gridDim.x * gridDim.y * gridDim.z;
  unsigned sum, cnt, mine, sp = 0u;
  for (;;) {
    sum = 0u; cnt = 0u; mine = 0u;
#pragma unroll
    for (unsigned j = 0; j < 16; ++j) { const unsigned c = xb_ld(&bar[XB_XCNT(j)]); sum += c; cnt += (c > 0u) ? 1u : 0u; mine = (j == x) ? c : mine; }
    if (sum == G) break;
    __builtin_amdgcn_s_sleep(1);
    if ((++sp & 255u) == 0u) { if (xb_ld(&bar[XB_TMO])) break; if (sp > XB_SPIN_CAP) { atomicAdd(&bar[XB_TMO], 1u); break; } }
  }
  nloc = mine > 0u ? mine : 1u; nx = cnt > 0u ? cnt : 1u;
}
__device__ __forceinline__ void xcd_barrier(const XcdBarrier& b) {
  asm volatile("s_waitcnt vmcnt(0)" ::: "memory");
  __syncthreads();
  if (threadIdx.x == 0) {
    unsigned* bar = b.bar;
    __builtin_amdgcn_s_waitcnt(0);
    unsigned nloc = b.st[0], nx = b.st[1];
    if (nloc == 0u) { xcd_barrier_complete(bar, b.x, nloc, nx); b.st[0] = nloc; b.st[1] = nx; }
    const unsigned old = xb_add(&bar[XB_XSUB(b.x)], 1u);
    const unsigned gen = old / nloc;
    if (old + 1u == (gen + 1u) * nloc) {
      __builtin_amdgcn_fence(__ATOMIC_RELEASE, "agent");
      asm volatile("s_waitcnt vmcnt(0)" ::: "memory");
      const unsigned og = xb_add(&bar[XB_TOP], 1u);
      const unsigned tg = og / nx;
      if (og + 1u == (tg + 1u) * nx) xb_add(&bar[XB_TOPGEN], 1u);
      else XB_SPIN(xb_ld(&bar[XB_TOPGEN]) == tg, bar);
      __builtin_amdgcn_fence(__ATOMIC_ACQUIRE, "agent");
      xb_add(&bar[XB_XGEN(b.x)], 1u);
      asm volatile("s_waitcnt vmcnt(0)" ::: "memory");
    } else {
      XB_SPIN(xb_ld(&bar[XB_XGEN(b.x)]) == gen, bar);
      __builtin_amdgcn_fence(__ATOMIC_ACQUIRE, "agent");
      asm volatile("s_waitcnt vmcnt(0)" ::: "memory");
    }
  }
  __syncthreads();
}

namespace pg8 {
#define PG8_LAS __attribute__((address_space(3)))
typedef unsigned short bf16_t;
typedef short bf16x8 __attribute__((ext_vector_type(8)));
typedef float f32x4 __attribute__((ext_vector_type(4)));
typedef unsigned u32x4 __attribute__((ext_vector_type(4)));
constexpr int BM = 256, BK = 64, HALF = 128, HTB = HALF * BK * 2  , STAGE_BYTES = 8 * HTB, NXCD = 8, WGM = 8;

__host__ __device__ __forceinline__ int lds_byte(int r, int c) { const int st = (r >> 4) * 2 + (c >> 5), rr = r & 15, cc = c & 31, ob = rr * 64 + cc * 2; return st * 1024 + (ob ^ (((ob >> 9) & 1) << 5)); }
__host__ __device__ __forceinline__ void stage_rc(int b, int& R, int& C) { const int st = b / 1024, sb = b % 1024, swz = sb ^ (((sb >> 9) & 1) << 5); R = (st >> 1) * 16 + swz / 64; C = (st & 1) * 32 + (swz % 64) / 2; }
__host__ __device__ __forceinline__ int perm32(int rho) { const int n = rho >> 4, i = rho & 15; return 8 * (i >> 2) + 4 * n + (i & 3); }

struct Unit { int pm, pn; };
struct Gemm { const bf16_t* A; const bf16_t* Bt; int M, N, K; };

struct StaticOrder {
    int nM, nN, nwg, G, c;
    __host__ __device__ void init(int M, int N, int G_, int c_) { nM = M / BM; nN = N / BM; nwg = nM * nN; G = G_; c = c_; }
    __host__ __device__ bool next(int i, Unit& u) const {
        const long L = (long)i * G + c; if (L >= nwg) return false;
        int wgid = (int)L; { const int q = nwg / NXCD, r = nwg % NXCD, xcd = wgid % NXCD, off = wgid / NXCD; wgid = (xcd < r ? xcd * (q + 1) : r * (q + 1) + (xcd - r) * q) + off; }
        const int nig = WGM * nN, gid = wgid / nig, fm = gid * WGM, gsz = (nM - fm) < WGM ? (nM - fm) : WGM;
        u.pm = fm + ((wgid % nig) % gsz); u.pn = (wgid % nig) / gsz; return true;
    }
    __device__ __forceinline__ void a_ready(const Unit&) const {}
    __device__ __forceinline__ void done(const Unit&) const {}
};

template <int MODE> struct EpiAct {
    static constexpr bool PERM = true, AFTER_DRAIN = false;
    bf16_t* O; int ldc; const float* bias;
    __device__ __forceinline__ unsigned pk(float lo, float hi) const {
        unsigned a = __float_as_uint(lo), b = __float_as_uint(hi);
        a += 0x7fffu + ((a >> 16) & 1u); b += 0x7fffu + ((b >> 16) & 1u);
        return (a >> 16) | (b & 0xffff0000u);
    }
    __device__ __forceinline__ float act(float v) const {
        if (MODE == 1) { v = fmaxf(v, 0.f); return v * v; }
        if (MODE == 2) return __frcp_rn(1.f + __expf(-v));
        return v;
    }
    __device__ __forceinline__ void operator()(const f32x4 (&acc)[2][2][4][2], const Unit& u, int wr, int wc, int fr, int fq) const {
        const int row0 = u.pm * BM + wr * 64 + fr, col0 = u.pn * BM + wc * 32 + 8 * fq;
        f32x4 bv[2][2];
#pragma unroll
        for (int bj = 0; bj < 2; ++bj)
#pragma unroll
            for (int n = 0; n < 2; ++n) bv[bj][n] = (MODE >= 2) ? *(const f32x4*)(bias + col0 + bj * HALF + 4 * n) : (f32x4){0.f, 0.f, 0.f, 0.f};
#pragma unroll
        for (int ai = 0; ai < 2; ++ai)
#pragma unroll
            for (int m = 0; m < 4; ++m) { bf16_t* rowp = O + (size_t)(row0 + ai * HALF + m * 16) * ldc + col0;
#pragma unroll
                for (int bj = 0; bj < 2; ++bj) { const f32x4 v0 = acc[ai][bj][m][0] + bv[bj][0], v1 = acc[ai][bj][m][1] + bv[bj][1];
                    u32x4 w; w.x = pk(act(v0[0]), act(v0[1])); w.y = pk(act(v0[2]), act(v0[3])); w.z = pk(act(v1[0]), act(v1[1])); w.w = pk(act(v1[2]), act(v1[3]));
                    *(u32x4*)(rowp + bj * HALF) = w; } }
    }
};

template <class Epi, class Sched, bool STAMP = false>
__device__ __forceinline__ void gemm_phase(PG8_LAS unsigned char* lds, const Gemm g, const Sched& S, const Epi& E, unsigned long long* stamps) {
    const int tid = tidx(), wid = __builtin_amdgcn_readfirstlane(tid >> 6), lane = tid & 63, wr = wid >> 2, wc = wid & 3, fr = lane & 15, fq = lane >> 4;
    const int K = g.K, nt = K / BK;
    int ts_lo = 0, ts_hi = 0, nts = 0; const unsigned long long rt_entry = STAMP ? (unsigned long long)wall_clock64() : 0ull;
#define PG8_STAMP() do { if (STAMP && wid == 0 && nts < 64) { const unsigned long long _c = (unsigned long long)clock64(); \
        ts_lo = (lane == nts) ? (int)(unsigned)_c : ts_lo; ts_hi = (lane == nts) ? (int)(unsigned)(_c >> 32) : ts_hi; ++nts; } } while (0)
    PG8_STAMP();
    unsigned voffA[2], voffB[2];
#pragma unroll
    for (int i = 0; i < 2; ++i) { int R, C; stage_rc(tid * 16 + i * 8192, R, C); const int Rb = Epi::PERM ? ((R & ~31) + perm32(R & 31)) : R;
        voffA[i] = (unsigned)(R * K + C) * 2u; voffB[i] = (unsigned)(Rb * K + C) * 2u; }
    const size_t kstep = (size_t)(BK * 2);
    const size_t hstep = (size_t)HALF * K * 2;
    const size_t tstep = 2 * hstep;
    const unsigned ldsw = (unsigned)wid * 1024u;
    const int aoff = lds_byte(wr * 64 + fr, fq * 8), boff = lds_byte(wc * 32 + fr, fq * 8);
#define PG8_SA(b, h) (((b) * 2 + (h)) * HTB)
#define PG8_SB(b, h) ((4 + (b) * 2 + (h)) * HTB)
#define PG8_STAGE(bufoff, gbase, voff) do { _Pragma("unroll") for (int _i = 0; _i < 2; ++_i) \
        __builtin_amdgcn_global_load_lds((const unsigned*)((const char*)(gbase) + (voff)[_i]), (PG8_LAS unsigned*)(lds + (bufoff) + ldsw + _i * 8192), 16, 0, 0); } while (0)
#define PG8_LDA(dst, b, h) do { _Pragma("unroll") for (int m = 0; m < 4; ++m) _Pragma("unroll") for (int k = 0; k < 2; ++k) dst[m][k] = *(const PG8_LAS bf16x8*)(lds + PG8_SA(b, h) + aoff + m * 2048 + k * 1024); } while (0)
#define PG8_LDB(dst, b, h) do { _Pragma("unroll") for (int n = 0; n < 2; ++n) _Pragma("unroll") for (int k = 0; k < 2; ++k) dst[n][k] = *(const PG8_LAS bf16x8*)(lds + PG8_SB(b, h) + boff + n * 2048 + k * 1024); } while (0)
#define PG8_MMA(ai, bj, At, Bt) do { __builtin_amdgcn_s_setprio(1); _Pragma("unroll") for (int m = 0; m < 4; ++m) _Pragma("unroll") for (int n = 0; n < 2; ++n) _Pragma("unroll") for (int k = 0; k < 2; ++k) \
        acc[ai][bj][m][n] = __builtin_amdgcn_mfma_f32_16x16x32_bf16(Bt[n][k], At[m][k], acc[ai][bj][m][n], 0, 0, 0); __builtin_amdgcn_s_setprio(0); } while (0)
#define PG8_WAIT_V(n) asm volatile("s_waitcnt vmcnt(" #n ")" ::: "memory")
#define PG8_WAIT_L(n) asm volatile("s_waitcnt lgkmcnt(" #n ")" ::: "memory")
#define PG8_BAR __builtin_amdgcn_s_barrier()
#define PG8_SCHED __builtin_amdgcn_sched_barrier(0)
    Unit cur, nxt; int ui = 0;
    if (!S.next(0, cur)) return;
    f32x4 acc[2][2][4][2];
#pragma unroll
    for (int a = 0; a < 2; ++a)
#pragma unroll
        for (int b = 0; b < 2; ++b)
#pragma unroll
            for (int m = 0; m < 4; ++m)
#pragma unroll
                for (int n = 0; n < 2; ++n) acc[a][b][m][n] = (f32x4){0.f, 0.f, 0.f, 0.f};
    bf16x8 At[4][2], B0[2][2], B1[2][2];
    const char* cA = (const char*)g.A + (size_t)cur.pm * tstep; const char* cB = (const char*)g.Bt + (size_t)cur.pn * tstep;
    S.a_ready(cur);
    PG8_STAGE(PG8_SB(0, 0), cB, voffB); PG8_STAGE(PG8_SA(0, 0), cA, voffA); PG8_STAGE(PG8_SB(0, 1), cB + hstep, voffB); PG8_STAGE(PG8_SA(0, 1), cA + hstep, voffA);
    if (wr == 1) PG8_BAR;
    PG8_WAIT_V(4); PG8_BAR;
    PG8_STAGE(PG8_SB(1, 0), cB + kstep, voffB); PG8_STAGE(PG8_SA(1, 0), cA + kstep, voffA); PG8_STAGE(PG8_SB(1, 1), cB + hstep + kstep, voffB);
    PG8_WAIT_V(6); PG8_BAR;
    PG8_STAMP();
    for (;;) {
        const bool has_next = S.next(ui + 1, nxt);
        const char* nA = has_next ? (const char*)g.A + (size_t)nxt.pm * tstep : cA; const char* nB = has_next ? (const char*)g.Bt + (size_t)nxt.pn * tstep : cB;
        for (int t = 0; t < nt; t += 2) {
            const bool last = (t == nt - 2);
            const char* a1 = cA + (size_t)(t + 1) * kstep;
            const char* a2 = last ? nA : cA + (size_t)(t + 2) * kstep; const char* b2 = last ? nB : cB + (size_t)(t + 2) * kstep;
            const char* a3 = a2 + kstep; const char* b3 = b2 + kstep;
            if (last && has_next) S.a_ready(nxt);
            PG8_LDB(B0, 0, 0); PG8_SCHED; PG8_LDA(At, 0, 0); PG8_STAGE(PG8_SA(1, 1), a1 + hstep, voffA);
            PG8_WAIT_L(8); PG8_BAR; PG8_WAIT_L(0); PG8_MMA(0, 0, At, B0); PG8_BAR; PG8_SCHED;
            PG8_LDB(B1, 0, 1); PG8_STAGE(PG8_SB(0, 0), b2, voffB);
            PG8_BAR; PG8_WAIT_L(0); PG8_MMA(0, 1, At, B1); PG8_BAR;
            PG8_LDA(At, 0, 1); PG8_STAGE(PG8_SA(0, 0), a2, voffA);
            PG8_BAR; PG8_WAIT_L(0); PG8_MMA(1, 0, At, B0); PG8_BAR; PG8_SCHED;
            PG8_STAGE(PG8_SB(0, 1), b2 + hstep, voffB);
            PG8_WAIT_V(6); PG8_BAR; PG8_MMA(1, 1, At, B1); PG8_BAR;
            PG8_LDB(B0, 1, 0); PG8_SCHED; PG8_LDA(At, 1, 0); PG8_STAGE(PG8_SA(0, 1), a2 + hstep, voffA);
            PG8_WAIT_L(8); PG8_BAR; PG8_WAIT_L(0); PG8_MMA(0, 0, At, B0); PG8_BAR; PG8_SCHED;
            PG8_LDB(B1, 1, 1); PG8_STAGE(PG8_SB(1, 0), b3, voffB);
            PG8_BAR; PG8_WAIT_L(0); PG8_MMA(0, 1, At, B1); PG8_BAR;
            PG8_LDA(At, 1, 1); PG8_STAGE(PG8_SA(1, 0), a3, voffA);
            PG8_BAR; PG8_WAIT_L(0); PG8_MMA(1, 0, At, B0); PG8_BAR; PG8_SCHED;
            PG8_STAGE(PG8_SB(1, 1), b3 + hstep, voffB);
            PG8_WAIT_V(6); PG8_BAR; PG8_MMA(1, 1, At, B1); PG8_BAR;
        }
        PG8_STAMP();
        if constexpr (!Epi::AFTER_DRAIN) { E(acc, cur, wr, wc, fr, fq); S.done(cur); }
        PG8_STAMP();
        if (!has_next) break;
#pragma unroll
        for (int a = 0; a < 2; ++a)
#pragma unroll
            for (int b = 0; b < 2; ++b)
#pragma unroll
                for (int m = 0; m < 4; ++m)
#pragma unroll
                    for (int n = 0; n < 2; ++n) acc[a][b][m][n] = (f32x4){0.f, 0.f, 0.f, 0.f};
        cur = nxt; cA = nA; cB = nB; ++ui;
    }
    PG8_WAIT_V(0);
    if (wr == 0) PG8_BAR;
    PG8_BAR;
    if constexpr (Epi::AFTER_DRAIN) { E.fused(acc, cur, wr, wc, fr, fq, lds, wid, lane); S.done(cur); }
    PG8_STAMP();
    if (STAMP && wid == 0) { stamps[lane] = lane < nts ? (((unsigned long long)(unsigned)ts_hi << 32) | (unsigned)ts_lo) : 0ull;
        if (lane == 62) stamps[62] = rt_entry; if (lane == 63) stamps[63] = (unsigned long long)wall_clock64(); }
#undef PG8_STAMP
#undef PG8_SA
#undef PG8_SB
#undef PG8_STAGE
#undef PG8_LDA
#undef PG8_LDB
#undef PG8_MMA
#undef PG8_WAIT_V
#undef PG8_WAIT_L
#undef PG8_BAR
#undef PG8_SCHED
}
}

#ifndef ONLY_PH
#define ONLY_PH -1
#endif
#define PHEN(x) (ONLY_PH < 0 || ONLY_PH == (x))
constexpr int NPL = 11;
constexpr int NPH = 2 * NPL + 1;

__device__ __forceinline__ void run_phase(const Params& p, int ph, char* smem) {
  const int l = ph / NPL, q = ph % NPL;
  const int bid = blockIdx.x, nb = gridDim.x;
  char* ws = p.ws;
  if (PHEN(11) && ph == NPH - 1) {
    rms_loop(p, 2, 1);
    return;
  }
  switch (q) {
    case 0: if (!PHEN(0)) break; {
      const int n_tab = (l == 0) ? 32 : 0;
      const int n_kt = (l == 0) ? 256 : 0;
      const int total = n_kt + n_tab + N_TR;
      for (int it = bid; it < total; it += nb) {
        int i = it;
        if (i < n_kt) { s5_kt(p, i, smem); continue; }
        i -= n_kt;
        if (i < n_tab) { gen_tables(p, i); continue; }
        i -= n_tab;
        transpose_item(p, l, i, smem);
      }
      if (l == 0) rms_loop(p, 0, 0); else rms_loop(p, 2, l - 1);
    } break;
    case 1: if (!PHEN(1)) break;
      {
        const float* bin = p.in[I_BIN] + l * NIN;
        {
          pg8::Gemm g{(const pg8::bf16_t*)(ws + W_HBF), (const pg8::bf16_t*)(ws + W_WIN), TOK, 2048, 1024};
          pg8::StaticOrder S; S.init(TOK, 2048, (int)gridDim.x, (int)blockIdx.x);
          pg8::EpiAct<3> E{(pg8::bf16_t*)(ws + W_Z), ZS, bin};
          pg8::gemm_phase<pg8::EpiAct<3>, pg8::StaticOrder, false>((PG8_LAS unsigned char*)smem, g, S, E, nullptr);
        }
        {
          pg8::Gemm g{(const pg8::bf16_t*)(ws + W_HBF), (const pg8::bf16_t*)(ws + W_WIN) + (size_t)2064 * 1024, TOK, 512, 1024};
          pg8::StaticOrder S; S.init(TOK, 512, (int)gridDim.x, (int)blockIdx.x);
          pg8::EpiAct<3> E{(pg8::bf16_t*)(ws + W_Z) + 2048, ZS, bin + 2064};
          pg8::gemm_phase<pg8::EpiAct<3>, pg8::StaticOrder, false>((PG8_LAS unsigned char*)smem, g, S, E, nullptr);
        }
        const int hb = nb / 2;
        if (bid >= hb) {
          for (int it = bid - hb; it < 64 + 128; it += nb - hb) {
            if (it < 64) ingate_item(p, l, it, smem);
            else s5_fill(p, l, it - 64, smem);
          }
        }
      }
      break;
    case 2: if (!PHEN(2)) break;
      for (int it = bid; it < 512 + 128 + 512; it += nb) {
        if (it < 512) mlstm_local(p, l, it, smem);
        else if (it < 640) s5_e(p, it - 512, smem);
        else four_g1(p, it - 640, smem);
      }
      break;
    case 3: if (!PHEN(3)) break;
      for (int it = bid; it < 8 + 132 + 512; it += nb) {
        if (it < 8) s5_carry(p, it);
        else if (it < 140) mlstm_scan(p, it - 8);
        else four_g2(p, it - 140, smem);
      }
      break;
    case 4: if (!PHEN(4)) break;
      for (int it = bid; it < 512 + 256 + 512; it += nb) {
        if (it < 512) mlstm_out(p, l, it, smem);
        else if (it < 768) s5_tg(p, it - 512, smem);
        else four_g3(p, it - 768, smem);
      }
      break;
    case 5: if (!PHEN(5)) break;
      {
        pg8::Gemm g{(const pg8::bf16_t*)(ws + W_HBF), (const pg8::bf16_t*)(ws + W_WIN) + (size_t)OFF_GATE * 1024, TOK, 3072, 1024};
        pg8::StaticOrder S; S.init(TOK, 3072, (int)gridDim.x, (int)blockIdx.x);
        pg8::EpiAct<2> E{(pg8::bf16_t*)(ws + W_GATE), 3072, p.in[I_BIN] + l * NIN + OFF_GATE};
        pg8::gemm_phase<pg8::EpiAct<2>, pg8::StaticOrder, false>((PG8_LAS unsigned char*)smem, g, S, E, nullptr);
      }
      break;
    case 6: if (!PHEN(6)) break;
      for (int it = bid; it < 512; it += nb) mergelite_item(p, l, it, smem);
      break;
    case 7: if (!PHEN(7)) break;
      {
        pg8::Gemm g{(const pg8::bf16_t*)(ws + W_MIX), (const pg8::bf16_t*)(ws + W_WOUT), TOK, 1024, 1024};
        pg8::StaticOrder S; S.init(TOK, 1024, (int)gridDim.x, (int)blockIdx.x);
        pg8::EpiAct<0> E{(pg8::bf16_t*)(ws + W_O), 1024, nullptr};
        pg8::gemm_phase<pg8::EpiAct<0>, pg8::StaticOrder, false>((PG8_LAS unsigned char*)smem, g, S, E, nullptr);
      }
      break;
    case 8: if (!PHEN(8)) break;
      rms_loop(p, 1, l);
      break;
    case 9: if (!PHEN(9)) break;
      {
        pg8::Gemm g{(const pg8::bf16_t*)(ws + W_HBF), (const pg8::bf16_t*)(ws + W_W1), TOK, 4096, 1024};
        pg8::StaticOrder S; S.init(TOK, 4096, (int)gridDim.x, (int)blockIdx.x);
        pg8::EpiAct<1> E{(pg8::bf16_t*)(ws + W_HID), 4096, nullptr};
        pg8::gemm_phase<pg8::EpiAct<1>, pg8::StaticOrder, false>((PG8_LAS unsigned char*)smem, g, S, E, nullptr);
      }
      break;
    case 10: if (!PHEN(10)) break;
      {
        pg8::Gemm g{(const pg8::bf16_t*)(ws + W_HID), (const pg8::bf16_t*)(ws + W_W2), TOK, 1024, 4096};
        pg8::StaticOrder S; S.init(TOK, 1024, (int)gridDim.x, (int)blockIdx.x);
        pg8::EpiAct<0> E{(pg8::bf16_t*)(ws + W_FO), 1024, nullptr};
        pg8::gemm_phase<pg8::EpiAct<0>, pg8::StaticOrder, false>((PG8_LAS unsigned char*)smem, g, S, E, nullptr);
      }
      break;
  }
}

__global__ void __launch_bounds__(NT) k_main(Params p, int ph_lo, int ph_hi) {
  extern __shared__ __attribute__((aligned(16))) char smem[];
#if COOP
  cg::grid_group grid = cg::this_grid();
  volatile LAS unsigned* st = (volatile LAS unsigned*)(smem + SMEM_BYTES - 16);
  if (threadIdx.x == 0) { st[0] = 0u; st[1] = 0u; }
  if (blockIdx.x == 0) { for (int i = threadIdx.x; i < 4096; i += NT) ((unsigned*)(p.ws + W_BAR))[i] = 0u; }
  __syncthreads();
  XcdBarrier xb; xb.bar = (unsigned*)(p.ws + W_BAR); xb.x = 0; xb.st = st;
#endif
#if PROBE_PH >= 0
  long long t0 = 0, t1 = 0;
#endif
  for (int ph = ph_lo; ph < ph_hi; ph++) {
#if PROBE_PH >= 0
    if (ph == PROBE_PH) t0 = wall_clock64();
    if (ph == PROBE_PH + PROBE_N) t1 = wall_clock64();
#endif
    run_phase(p, ph, smem);
#if COOP
    if (ph + 1 < ph_hi) {
      if (ph == ph_lo) { grid.sync(); xb = xcd_barrier_post((unsigned*)(p.ws + W_BAR), st); }
      else xcd_barrier(xb);
    }
#endif
  }
#if PROBE_PH >= 0
  xcd_barrier(xb);
  if (blockIdx.x == 0 && threadIdx.x == 0) { float us = (float)(t1 - t0) * 0.01f; p.out[0] += 0.1f + us * (1.f / PROBE_SCALE); }
#endif
}

extern "C" void kernel_launch(void* const* d_in, const int* in_sizes, int n_in, void* d_out, int out_size, void* d_ws, size_t ws_size,
                              hipStream_t stream) {
  static int grid = 0;
  if (grid == 0) {
    if (n_in != 25 || ws_size < W_END) { fprintf(stderr, "kernel_launch: bad inputs n_in=%d ws=%zu need %zu\n", n_in, ws_size, (size_t)W_END); grid = -1; return; }
    if (hipFuncSetAttribute((const void*)k_main, hipFuncAttributeMaxDynamicSharedMemorySize, SMEM_BYTES) != hipSuccess) { fprintf(stderr, "hipFuncSetAttribute failed\n"); grid = -1; return; }
    int dev = 0, cus = 0, per_cu = 0;
    hipGetDevice(&dev);
    hipDeviceGetAttribute(&cus, hipDeviceAttributeMultiprocessorCount, dev);
    hipOccupancyMaxActiveBlocksPerMultiprocessor(&per_cu, (const void*)k_main, NT, SMEM_BYTES);
    if (per_cu < 1) { fprintf(stderr, "occupancy query says 0 blocks/CU\n"); grid = -1; return; }
    grid = cus;
  }
  if (grid < 0) return;
  Params p{};
  for (int i = 0; i < 25; i++) p.in[i] = (const float*)d_in[i];
  p.out = (float*)d_out;
  p.ws = (char*)d_ws;
#if COOP
  int lo = 0, hi = NPH;
  void* args[] = {&p, &lo, &hi};
  hipError_t e = hipLaunchCooperativeKernel((const void*)k_main, dim3(grid), dim3(NT), args, SMEM_BYTES, stream);
  if (e != hipSuccess) fprintf(stderr, "cooperative launch failed: %s\n", hipGetErrorString(e));
#else
  for (int ph = 0; ph < NPH; ph++) hipLaunchKernelGGL(k_main, dim3(grid), dim3(NT), SMEM_BYTES, stream, p, ph, ph + 1);
#endif
}
```

```cpp
#include <hip/hip_runtime.h>
#include <hip/hip_cooperative_groups.h>
#include <stdint.h>
#include <stdio.h>
#include <math.h>
namespace cg = cooperative_groups;

#ifndef REP_MASK
#define REP_MASK 0
#endif
#ifndef PROBE_PH
#define PROBE_PH -1
#endif
#ifndef PROBE_N
#define PROBE_N 1
#endif
#ifndef PROBE_SCALE
#define PROBE_SCALE 1000.f
#endif
#ifndef COOP
#define COOP 1
#endif

typedef unsigned short bf16_t;
typedef __attribute__((ext_vector_type(8))) short bf16x8;
typedef __attribute__((ext_vector_type(4))) float f32x4;

#define NT 512
constexpr int SEQ = 8192, TOK = 16384, DM = 1024, NIN = 5648, ZS = 2560, DFF = 4096;
constexpr int OFF_K = 512, OFF_V = 1024, OFF_O = 1536, OFF_IG = 2048  , OFF_F = 2048, OFF_S = 2304  , OFF_GATE = 2576  ;
constexpr float EPS = 1e-6f;

enum { I_X = 0, I_GMPRE, I_GMPOST, I_GFPRE, I_GFPOST, I_WIN, I_BIN, I_CW, I_CB, I_MNG, I_WUPM, I_WUPF, I_LRE, I_LIM, I_LDT,
       I_BRE, I_BIM, I_CRE, I_CIM, I_SD, I_WGLU, I_BGLU, I_WOUT, I_W1, I_W2 };

constexpr size_t W_WIN = 0;
constexpr size_t W_WUPM = W_WIN + (size_t)NIN * 1024 * 2;
constexpr size_t W_WUPF = W_WUPM + 1024 * 512 * 2;
constexpr size_t W_WGLU = W_WUPF + 1024 * 256 * 2;
constexpr size_t W_WOUT = W_WGLU + 2048 * 256 * 2;
constexpr size_t W_W1 = W_WOUT + 1024 * 1024 * 2;
constexpr size_t W_W2 = W_W1 + 4096 * 1024 * 2;
constexpr size_t W_ET = W_W2 + 4096 * 1024 * 2;
constexpr size_t W_TG = W_ET + 16 * 256 * 512 * 2;
constexpr size_t W_F1T = W_TG + 16 * 512 * 768 * 2;
constexpr size_t W_F2T = W_F1T + 128 * 64 * 2;
constexpr size_t W_F3T = W_F2T + 256 * 256 * 2;
constexpr size_t W_TW = W_F3T + 64 * 128 * 2;
constexpr size_t W_LPOW = W_TW + 64 * 128 * 2 * 4;
constexpr size_t W_ZERO = W_LPOW + 2 * 16 * 64 * 2 * 4;
constexpr size_t W_AMAX = W_ZERO + 256;
constexpr size_t W_G = W_AMAX + 4096;
constexpr size_t W_MPREV = W_G + 4096;
constexpr size_t W_NST = W_MPREV + 4096;
constexpr size_t W_ZG = W_NST + 16 * 64 * 128 * 4;
constexpr size_t W_HBF = W_ZG + (size_t)TOK * 16 * 4;
constexpr size_t W_Z = W_HBF + (size_t)TOK * 1024 * 2;
constexpr size_t W_CST = W_Z + (size_t)TOK * ZS * 2;
constexpr size_t W_U1T = W_CST + (size_t)16 * 64 * 16384 * 2;
constexpr size_t W_A2T = W_U1T + (size_t)TOK * 512 * 2;
constexpr size_t W_YF = W_A2T + (size_t)TOK * 512 * 2;
constexpr size_t W_YS = W_YF + (size_t)TOK * 256 * 2;
constexpr size_t W_XEND = W_YS + (size_t)TOK * 256 * 2;
constexpr size_t W_XCAR = W_XEND + (size_t)512 * 16 * 256 * 2;
constexpr size_t W_BAR = W_XCAR + (size_t)512 * 16 * 256 * 2;
constexpr size_t W_KTG = W_BAR + 16384;
constexpr size_t W_END = W_KTG + (size_t)2 * 16 * 16384 * 4;
constexpr size_t W_HM = W_U1T;
constexpr size_t W_MIX = W_HBF;
constexpr size_t W_GATE = W_Z;
constexpr size_t W_O = W_Z + (size_t)TOK * 1024 * 2;
constexpr size_t W_HID = W_Z;
constexpr size_t W_FO = W_A2T;
static_assert(W_U1T + (size_t)TOK * 512 * 2 - W_Z >= (size_t)TOK * 4096 * 2, "hid alias");
static_assert(W_U1T - W_Z >= (size_t)TOK * 3072 * 2, "gate alias");

constexpr int SMEM_BYTES = 153600 + 16;

struct Params { const float* in[25]; float* out; char* ws; };

__device__ __forceinline__ int tidx() { int t = threadIdx.x; asm volatile("" : "+v"(t)); return t; }
__device__ __forceinline__ bf16_t f2bf(float f) {
  uint32_t u = __float_as_uint(f);
  u += 0x7fffu + ((u >> 16) & 1u);
  return (bf16_t)(u >> 16);
}
__device__ __forceinline__ float bf2f(bf16_t h) { return __uint_as_float(((uint32_t)h) << 16); }
__device__ __forceinline__ uint32_t pack2(float a, float b) { return (uint32_t)f2bf(a) | ((uint32_t)f2bf(b) << 16); }
__device__ __forceinline__ uint2 pack4(float a, float b, float c, float d) { uint2 r; r.x = pack2(a, b); r.y = pack2(c, d); return r; }
__device__ __forceinline__ float lo16(uint32_t u) { return __uint_as_float(u << 16); }
__device__ __forceinline__ float hi16(uint32_t u) { return __uint_as_float(u & 0xffff0000u); }
__device__ __forceinline__ float sigm(float x) { return __frcp_rn(1.f + __expf(-x)); }
__device__ __forceinline__ float logsig(float x) { return fminf(x, 0.f) - log1pf(expf(-fabsf(x))); }
__device__ __forceinline__ float gelu_tanh(float x) { float u = 0.7978845608028654f * (x + 0.044715f * x * x * x); return 0.5f * x * (1.f + tanhf(u)); }
__device__ __forceinline__ float wave_sum(float v) {
#pragma unroll
  for (int o = 32; o >= 1; o >>= 1) v += __shfl_xor(v, o);
  return v;
}
__device__ __forceinline__ float wave_max(float v) {
#pragma unroll
  for (int o = 32; o >= 1; o >>= 1) v = fmaxf(v, __shfl_xor(v, o));
  return v;
}
__device__ __forceinline__ float wave_incl_sum(float v, int lane) {
#pragma unroll
  for (int o = 1; o < 64; o <<= 1) { float t = __shfl_up(v, o); if (lane >= o) v += t; }
  return v;
}
__device__ __forceinline__ float wave_incl_max(float v, int lane) {
#pragma unroll
  for (int o = 1; o < 64; o <<= 1) { float t = __shfl_up(v, o); if (lane >= o) v = fmaxf(v, t); }
  return v;
}
typedef unsigned u32x2_t __attribute__((ext_vector_type(2)));
__device__ __forceinline__ float4 ld_nt_f4(const float* p) { f32x4 v = __builtin_nontemporal_load((const f32x4*)p); return make_float4(v[0], v[1], v[2], v[3]); }
__device__ __forceinline__ uint2 ld_nt_u2(const bf16_t* p) { u32x2_t v = __builtin_nontemporal_load((const u32x2_t*)p); return make_uint2(v[0], v[1]); }
__device__ __forceinline__ void st_nt_f4(float* p, float a, float b, float c, float d) { f32x4 v = {a, b, c, d}; __builtin_nontemporal_store(v, (f32x4*)p); }
__device__ __forceinline__ f32x4 mfma16(bf16x8 a, bf16x8 b, f32x4 c) { return __builtin_amdgcn_mfma_f32_16x16x32_bf16(a, b, c, 0, 0, 0); }

constexpr int BK = 64, LDK = 64;
template <int BM, int BN, int WM, int WN, bool SWAP, class AF, class BF>
__device__ __forceinline__ void gemm_acc(int K, AF aptr, BF bptr, char* smem, f32x4 (&acc)[BM / WM / 16][BN / WN / 16]) {
  constexpr int TM = BM / WM / 16, TN = BN / WN / 16;
  constexpr int CA = BM * 8 / NT, CB = BN * 8 / NT;
  static_assert(CA >= 1 && CB >= 1, "tile too small");
  bf16_t* As = (bf16_t*)smem;
  bf16_t* Bs = As + 2 * BM * LDK;
  const int tid = tidx(), lane = tid & 63, w = tid >> 6;
  const int mb = (w / WN) * (BM / WM), nb = (w % WN) * (BN / WN);
  const int r16 = lane & 15, fx = (r16 >> 1) & 7;
  uint4 ra0, ra1, ra2, ra3, rb0, rb1, rb2, rb3;
  ra0 = ra1 = ra2 = ra3 = rb0 = rb1 = rb2 = rb3 = make_uint4(0, 0, 0, 0);
  static_assert(CA <= 4 && CB <= 4, "chunks");
#define GLOAD(K0)                                                                                         \
  {                                                                                                       \
    { int c = tid; ra0 = *(const uint4*)aptr(c >> 3, (K0) + (c & 7) * 8); }                               \
    if (CA > 1) { int c = tid + NT; ra1 = *(const uint4*)aptr(c >> 3, (K0) + (c & 7) * 8); }              \
    if (CA > 2) { int c = tid + 2 * NT; ra2 = *(const uint4*)aptr(c >> 3, (K0) + (c & 7) * 8); }          \
    if (CA > 3) { int c = tid + 3 * NT; ra3 = *(const uint4*)aptr(c >> 3, (K0) + (c & 7) * 8); }          \
    { int c = tid; rb0 = *(const uint4*)bptr(c >> 3, (K0) + (c & 7) * 8); }                               \
    if (CB > 1) { int c = tid + NT; rb1 = *(const uint4*)bptr(c >> 3, (K0) + (c & 7) * 8); }              \
    if (CB > 2) { int c = tid + 2 * NT; rb2 = *(const uint4*)bptr(c >> 3, (K0) + (c & 7) * 8); }          \
    if (CB > 3) { int c = tid + 3 * NT; rb3 = *(const uint4*)bptr(c >> 3, (K0) + (c & 7) * 8); }          \
  }
#define SSTORE(AP, BP)                                                                                    \
  {                                                                                                       \
    { int c = tid; *(uint4*)&(AP)[(c >> 3) * LDK + (((c & 7) ^ ((c >> 4) & 7)) << 3)] = ra0; }                                  \
    if (CA > 1) { int c = tid + NT; *(uint4*)&(AP)[(c >> 3) * LDK + (((c & 7) ^ ((c >> 4) & 7)) << 3)] = ra1; }                 \
    if (CA > 2) { int c = tid + 2 * NT; *(uint4*)&(AP)[(c >> 3) * LDK + (((c & 7) ^ ((c >> 4) & 7)) << 3)] = ra2; }             \
    if (CA > 3) { int c = tid + 3 * NT; *(uint4*)&(AP)[(c >> 3) * LDK + (((c & 7) ^ ((c >> 4) & 7)) << 3)] = ra3; }             \
    { int c = tid; *(uint4*)&(BP)[(c >> 3) * LDK + (((c & 7) ^ ((c >> 4) & 7)) << 3)] = rb0; }                                  \
    if (CB > 1) { int c = tid + NT; *(uint4*)&(BP)[(c >> 3) * LDK + (((c & 7) ^ ((c >> 4) & 7)) << 3)] = rb1; }                 \
    if (CB > 2) { int c = tid + 2 * NT; *(uint4*)&(BP)[(c >> 3) * LDK + (((c & 7) ^ ((c >> 4) & 7)) << 3)] = rb2; }             \
    if (CB > 3) { int c = tid + 3 * NT; *(uint4*)&(BP)[(c >> 3) * LDK + (((c & 7) ^ ((c >> 4) & 7)) << 3)] = rb3; }             \
  }
  GLOAD(0);
  SSTORE(As, Bs);
  const int nk = K / BK;
  if (nk > 1) { GLOAD(BK); }
  __syncthreads();
#pragma unroll 1
  for (int kt = 0; kt < nk; kt++) {
    const int buf = kt & 1;
    if (kt + 1 < nk) {
      bf16_t* An = As + (buf ^ 1) * BM * LDK;
      bf16_t* Bn = Bs + (buf ^ 1) * BN * LDK;
      SSTORE(An, Bn);
      if (kt + 2 < nk) { GLOAD((kt + 2) * BK); }
    }
    const bf16_t* Ab = As + buf * BM * LDK;
    const bf16_t* Bb = Bs + buf * BN * LDK;
#pragma unroll
    for (int kk = 0; kk < 2; kk++) {
      bf16x8 af[TM], bfr[TN];
#pragma unroll
      for (int i = 0; i < TM; i++) af[i] = *(const bf16x8*)&Ab[(mb + i * 16 + r16) * LDK + (((kk * 4 + (lane >> 4)) ^ fx) << 3)];
#pragma unroll
      for (int j = 0; j < TN; j++) bfr[j] = *(const bf16x8*)&Bb[(nb + j * 16 + r16) * LDK + (((kk * 4 + (lane >> 4)) ^ fx) << 3)];
      __builtin_amdgcn_s_setprio(1);
#pragma unroll
      for (int i = 0; i < TM; i++)
#pragma unroll
        for (int j = 0; j < TN; j++) acc[i][j] = SWAP ? mfma16(bfr[j], af[i], acc[i][j]) : mfma16(af[i], bfr[j], acc[i][j]);
      __builtin_amdgcn_s_setprio(0);
    }
    __syncthreads();
  }
#undef GLOAD
#undef SSTORE
}

struct Stage { uint4 a0, a1, a2, a3, b0, b1, b2, b3; };
template <int BM, int BN, int WM, int WN, bool SWAP, class AF, class BF, class NAF, class NBF>
__device__ __forceinline__ void gemm_chain(int K, AF aptr, BF bptr, bool preloaded, bool has_next, NAF naptr, NBF nbptr, Stage& st, char* smem,
                                           f32x4 (&acc)[BM / WM / 16][BN / WN / 16]) {
  constexpr int TM = BM / WM / 16, TN = BN / WN / 16;
  constexpr int CA = BM * 8 / NT, CB = BN * 8 / NT;
  static_assert(CA >= 1 && CB >= 1 && CA <= 4 && CB <= 4, "chunks");
  bf16_t* As = (bf16_t*)smem;
  bf16_t* Bs = As + 2 * BM * LDK;
  const int tid = tidx(), lane = tid & 63, w = tid >> 6;
  const int mb = (w / WN) * (BM / WM), nb = (w % WN) * (BN / WN);
  const int r16 = lane & 15, fx = (r16 >> 1) & 7;
#define GLOADF(AP_, BP_, K0)                                                                              \
  {                                                                                                       \
    { int c = tid; st.a0 = *(const uint4*)AP_(c >> 3, (K0) + (c & 7) * 8); }                              \
    if (CA > 1) { int c = tid + NT; st.a1 = *(const uint4*)AP_(c >> 3, (K0) + (c & 7) * 8); }             \
    if (CA > 2) { int c = tid + 2 * NT; st.a2 = *(const uint4*)AP_(c >> 3, (K0) + (c & 7) * 8); }         \
    if (CA > 3) { int c = tid + 3 * NT; st.a3 = *(const uint4*)AP_(c >> 3, (K0) + (c & 7) * 8); }         \
    { int c = tid; st.b0 = *(const uint4*)BP_(c >> 3, (K0) + (c & 7) * 8); }                              \
    if (CB > 1) { int c = tid + NT; st.b1 = *(const uint4*)BP_(c >> 3, (K0) + (c & 7) * 8); }             \
    if (CB > 2) { int c = tid + 2 * NT; st.b2 = *(const uint4*)BP_(c >> 3, (K0) + (c & 7) * 8); }         \
    if (CB > 3) { int c = tid + 3 * NT; st.b3 = *(const uint4*)BP_(c >> 3, (K0) + (c & 7) * 8); }         \
  }
#define SOFFC(c) (((c) >> 3) * LDK + ((((c) & 7) ^ (((c) >> 4) & 7)) << 3))
#define SSTOREC(AP, BP)                                                                                   \
  {                                                                                                       \
    *(uint4*)&(AP)[SOFFC(tid)] = st.a0;                                                                   \
    if (CA > 1) *(uint4*)&(AP)[SOFFC(tid + NT)] = st.a1;                                                  \
    if (CA > 2) *(uint4*)&(AP)[SOFFC(tid + 2 * NT)] = st.a2;                                              \
    if (CA > 3) *(uint4*)&(AP)[SOFFC(tid + 3 * NT)] = st.a3;                                              \
    *(uint4*)&(BP)[SOFFC(tid)] = st.b0;                                                                   \
    if (CB > 1) *(uint4*)&(BP)[SOFFC(tid + NT)] = st.b1;                                                  \
    if (CB > 2) *(uint4*)&(BP)[SOFFC(tid + 2 * NT)] = st.b2;                                              \
    if (CB > 3) *(uint4*)&(BP)[SOFFC(tid + 3 * NT)] = st.b3;                                              \
  }
  const int nk = K / BK;
  if (!preloaded) { GLOADF(aptr, bptr, 0); }
  SSTOREC(As, Bs);
  GLOADF(aptr, bptr, BK);
  __syncthreads();
#pragma unroll 1
  for (int kt = 0; kt < nk; kt++) {
    const int buf = kt & 1;
    if (kt + 1 < nk) {
      bf16_t* An = As + (buf ^ 1) * BM * LDK;
      bf16_t* Bn = Bs + (buf ^ 1) * BN * LDK;
      SSTOREC(An, Bn);
      if (kt + 2 < nk) { GLOADF(aptr, bptr, (kt + 2) * BK); }
      else if (has_next) { GLOADF(naptr, nbptr, 0); }
    }
    const bf16_t* Ab = As + buf * BM * LDK;
    const bf16_t* Bb = Bs + buf * BN * LDK;
#pragma unroll
    for (int kk = 0; kk < 2; kk++) {
      bf16x8 af[TM], bfr[TN];
#pragma unroll
      for (int i = 0; i < TM; i++) af[i] = *(const bf16x8*)&Ab[(mb + i * 16 + r16) * LDK + (((kk * 4 + (lane >> 4)) ^ fx) << 3)];
#pragma unroll
      for (int j = 0; j < TN; j++) bfr[j] = *(const bf16x8*)&Bb[(nb + j * 16 + r16) * LDK + (((kk * 4 + (lane >> 4)) ^ fx) << 3)];
      __builtin_amdgcn_s_setprio(1);
#pragma unroll
      for (int i = 0; i < TM; i++)
#pragma unroll
        for (int j = 0; j < TN; j++) acc[i][j] = SWAP ? mfma16(bfr[j], af[i], acc[i][j]) : mfma16(af[i], bfr[j], acc[i][j]);
      __builtin_amdgcn_s_setprio(0);
    }
    __syncthreads();
  }
#undef GLOADF
#undef SOFFC
#undef SSTOREC
}

__device__ __forceinline__ int perm32(int r) { return (r & ~31) + 8 * ((r & 15) >> 2) + 4 * ((r >> 4) & 1) + (r & 3); }

template <int TM, int TN>
__device__ __forceinline__ void zero_acc(f32x4 (&acc)[TM][TN]) {
#pragma unroll
  for (int i = 0; i < TM; i++)
#pragma unroll
    for (int j = 0; j < TN; j++) acc[i][j] = f32x4{0.f, 0.f, 0.f, 0.f};
}

constexpr int LDT = 144;
template <int TM, int TN, bool SWAP>
__device__ __forceinline__ void mma_lds(const bf16_t* A, const bf16_t* B, int K, int mb, int nb, f32x4 (&acc)[TM][TN]) {
  const int lane = tidx() & 63, r16 = lane & 15, kq = (lane >> 4) * 8;
  for (int k0 = 0; k0 < K; k0 += 32) {
    bf16x8 af[TM], bfr[TN];
#pragma unroll
    for (int i = 0; i < TM; i++) af[i] = *(const bf16x8*)&A[(mb + i * 16 + r16) * LDT + k0 + kq];
#pragma unroll
    for (int j = 0; j < TN; j++) bfr[j] = *(const bf16x8*)&B[(nb + j * 16 + r16) * LDT + k0 + kq];
    __builtin_amdgcn_s_setprio(1);
#pragma unroll
    for (int i = 0; i < TM; i++)
#pragma unroll
      for (int j = 0; j < TN; j++) acc[i][j] = SWAP ? mfma16(bfr[j], af[i], acc[i][j]) : mfma16(af[i], bfr[j], acc[i][j]);
    __builtin_amdgcn_s_setprio(0);
  }
}

__device__ __forceinline__ void transpose_tile(const float* __restrict__ src, bf16_t* __restrict__ dst, int K, int N, int tile, char* smem) {
  float* sm = (float*)smem;
  const int ntn = (N + 255) >> 8;
  const int k0 = (tile / ntn) * 64, n0 = (tile % ntn) * 256;
  const int tid = tidx();
  {
    float4 v[8];
#pragma unroll
    for (int t = 0; t < 8; t++) {
      int idx = tid + t * NT, r = idx >> 6, c = (idx & 63) * 4;
      v[t] = (n0 + c < N) ? ld_nt_f4(src + (size_t)(k0 + r) * N + n0 + c) : make_float4(0.f, 0.f, 0.f, 0.f);
    }
#pragma unroll
    for (int t = 0; t < 8; t++) {
      int idx = tid + t * NT, r = idx >> 6, c = (idx & 63) * 4;
      sm[r * 257 + c] = v[t].x; sm[r * 257 + c + 1] = v[t].y; sm[r * 257 + c + 2] = v[t].z; sm[r * 257 + c + 3] = v[t].w;
    }
  }
  __syncthreads();
#pragma unroll 8
  for (int t = 0; t < 16; t++) {
    int idx = tid + t * NT, r = idx >> 5, c = (idx & 31) * 2;
    if (n0 + r < N) *(uint32_t*)(dst + (size_t)(n0 + r) * K + k0 + c) = pack2(sm[c * 257 + r], sm[(c + 1) * 257 + r]);
  }
  __syncthreads();
}

__device__ __forceinline__ void transpose_item(const Params& p, int l, int i, char* smem) {
  char* ws = p.ws;
  if (i < 368) { transpose_tile(p.in[I_WIN] + (size_t)l * 1024 * NIN, (bf16_t*)(ws + W_WIN), 1024, NIN, i, smem); return; }
  i -= 368;
  if (i < 32) { transpose_tile(p.in[I_WUPM] + (size_t)l * 512 * 1024, (bf16_t*)(ws + W_WUPM), 512, 1024, i, smem); return; }
  i -= 32;
  if (i < 16) { transpose_tile(p.in[I_WUPF] + (size_t)l * 256 * 1024, (bf16_t*)(ws + W_WUPF), 256, 1024, i, smem); return; }
  i -= 16;
  if (i < 32) { transpose_tile(p.in[I_WGLU] + (size_t)l * 256 * 2048, (bf16_t*)(ws + W_WGLU), 256, 2048, i, smem); return; }
  i -= 32;
  if (i < 64) { transpose_tile(p.in[I_WOUT] + (size_t)l * 1024 * 1024, (bf16_t*)(ws + W_WOUT), 1024, 1024, i, smem); return; }
  i -= 64;
  if (i < 256) { transpose_tile(p.in[I_W1] + (size_t)l * 1024 * 4096, (bf16_t*)(ws + W_W1), 1024, 4096, i, smem); return; }
  i -= 256;
  transpose_tile(p.in[I_W2] + (size_t)l * 4096 * 1024, (bf16_t*)(ws + W_W2), 4096, 1024, i, smem);
}
constexpr int N_TR = 368 + 32 + 16 + 32 + 64 + 256 + 256;

__device__ __forceinline__ void gen_tables(const Params& p, int item) {
  char* ws = p.ws;
  bf16_t* F1T = (bf16_t*)(ws + W_F1T);
  bf16_t* F2T = (bf16_t*)(ws + W_F2T);
  bf16_t* F3T = (bf16_t*)(ws + W_F3T);
  float* TW = (float*)(ws + W_TW);
  uint32_t* ZR = (uint32_t*)(ws + W_ZERO);
  constexpr int E1 = 8192, E2 = 65536, E3 = 8192, E4 = 8192, E5 = 64;
  for (int e = item * NT + tidx(); e < E1 + E2 + E3 + E4 + E5; e += 32 * NT) {
    int i = e;
    if (i < E1) {
      int n = i >> 6, d = i & 63, c = n >> 6, j = n & 63;
      float s, co; sincospif((float)((j * d) & 63) / 32.f, &s, &co);
      F1T[i] = f2bf(c == 0 ? co : -s);
      continue;
    }
    i -= E1;
    if (i < E2) {
      int n = i >> 8, k = i & 255;
      int k1 = (n >> 5) * 16 + (n & 15), cp = (n >> 4) & 1, c = k >> 7, s1 = k & 127;
      float s, co; sincospif((float)((s1 * k1) & 127) / 64.f, &s, &co);
      float v = (cp == 0) ? (c == 0 ? co : s) : (c == 0 ? -s : co);
      F2T[i] = f2bf(v);
      continue;
    }
    i -= E2;
    if (i < E3) {
      int k2 = i >> 7, k = i & 127, cp = k >> 6, s2 = k & 63;
      float s, co; sincospif((float)((s2 * k2) & 63) / 32.f, &s, &co);
      const float scale = 0.0013810679320049757f;
      F3T[i] = f2bf((cp == 0 ? co : s) * scale);
      continue;
    }
    i -= E3;
    if (i < E4) {
      int s2 = i >> 7, k1 = i & 127;
      float s, co; sincospif((float)(s2 * k1) / 4096.f, &s, &co);
      TW[2 * i] = co; TW[2 * i + 1] = s;
      continue;
    }
    i -= E4;
    ZR[i] = 0u;
  }
}

__device__ __forceinline__ void s5_setup(const Params& p, int l, int g, float* POW, float* BB, float* CC) {
  const int tid = tidx();
  for (int e = tid; e < 2 * 64 * 33; e += NT) {
    int d = e / (64 * 33), r = e - d * 64 * 33, tau = r >> 6, pp = r & 63;
    int gi = ((l * 2 + d) * 16 + g);
    float dt = expf(p.in[I_LDT][gi]);
    float lr = p.in[I_LRE][gi * 64 + pp], li = p.in[I_LIM][gi * 64 + pp];
    float m2 = expf(lr * dt * (float)tau);
    float s2, c2; sincosf(li * dt * (float)tau, &s2, &c2);
    POW[((d * 33 + tau) * 64 + pp) * 2] = m2 * c2;
    POW[((d * 33 + tau) * 64 + pp) * 2 + 1] = m2 * s2;
  }
  for (int e = tid; e < 2048; e += NT) {
    int d = e >> 10, pp = (e >> 4) & 63, ci = e & 15;
    int gi = ((l * 2 + d) * 16 + g);
    float dt = expf(p.in[I_LDT][gi]);
    float lr = p.in[I_LRE][gi * 64 + pp], li = p.in[I_LIM][gi * 64 + pp];
    float mag = expf(lr * dt);
    float sn, cs; sincosf(li * dt, &sn, &cs);
    float lbr = mag * cs, lbi = mag * sn;
    float den = lr * lr + li * li;
    float fr = ((lbr - 1.f) * lr + lbi * li) / den;
    float fi = (lbi * lr - (lbr - 1.f) * li) / den;
    float br = p.in[I_BRE][(gi * 64 + pp) * 16 + ci], bi = p.in[I_BIM][(gi * 64 + pp) * 16 + ci];
    BB[e * 2] = fr * br - fi * bi;
    BB[e * 2 + 1] = fr * bi + fi * br;
  }
  for (int e = tid; e < 2048; e += NT) {
    int d = e >> 10, r = e & 1023;
    int gi = ((l * 2 + d) * 16 + g);
    CC[e * 2] = p.in[I_CRE][gi * 1024 + r];
    CC[e * 2 + 1] = p.in[I_CIM][gi * 1024 + r];
  }
  __syncthreads();
}
__device__ __forceinline__ void s5_kt(const Params& p, int item, char* smem) {
  float* POW = (float*)smem;
  float* BB = POW + 2 * 33 * 64 * 2;
  float* CC = BB + 2 * 64 * 16 * 2;
  const int part = item & 7, g = (item >> 3) & 15, l = item >> 7;
  s5_setup(p, l, g, POW, BB, CC);
  float* KTG = (float*)(p.ws + W_KTG) + (size_t)(l * 16 + g) * 16384;
  const int tid = tidx();
  for (int e = part * 2048 + tid; e < part * 2048 + 2048; e += NT) {
    int d = e >> 13, tau = (e >> 8) & 31, co = (e >> 4) & 15, ci = e & 15;
    float s = 0.f;
    for (int pp = 0; pp < 64; pp++) {
      float cr = CC[((d * 16 + co) * 64 + pp) * 2], cim = CC[((d * 16 + co) * 64 + pp) * 2 + 1];
      float pr = POW[((d * 33 + tau) * 64 + pp) * 2], pi = POW[((d * 33 + tau) * 64 + pp) * 2 + 1];
      float xr = cr * pr - cim * pi, xi = cr * pi + cim * pr;
      float br = BB[((d * 64 + pp) * 16 + ci) * 2], bi = BB[((d * 64 + pp) * 16 + ci) * 2 + 1];
      s += xr * br - xi * bi;
    }
    KTG[e] = s;
  }
  __syncthreads();
}
__device__ __forceinline__ void s5_fill(const Params& p, int l, int item, char* smem) {
  float* POW = (float*)smem;
  float* BB = POW + 2 * 33 * 64 * 2;
  float* CC = BB + 2 * 64 * 16 * 2;
  float* KT = CC + 2 * 16 * 64 * 2;
  const int part = item & 7, g = item >> 3;
  const int tid = tidx();
  char* ws = p.ws;
  const float* KTG = (const float*)(ws + W_KTG) + (size_t)(l * 16 + g) * 16384;
  for (int e = tid; e < 4096; e += NT) ((float4*)KT)[e] = ((const float4*)KTG)[e];
  s5_setup(p, l, g, POW, BB, CC);
  if (part == 0 && tid < 128) {
    int d = tid >> 6, pp = tid & 63;
    float* LP = (float*)(ws + W_LPOW);
    LP[((d * 16 + g) * 64 + pp) * 2] = POW[((d * 33 + 32) * 64 + pp) * 2];
    LP[((d * 16 + g) * 64 + pp) * 2 + 1] = POW[((d * 33 + 32) * 64 + pp) * 2 + 1];
  }
  bf16_t* TG = (bf16_t*)(ws + W_TG) + (size_t)g * 512 * 768;
  const float* dsk = p.in[I_SD] + (l * 16 + g) * 16;
  for (int e = part * 64 * 768 + tid; e < (part + 1) * 64 * 768; e += NT) {
    int n = e / 768, k = e - n * 768;
    int t = n >> 4, co = n & 15;
    float v;
    if (k < 512) {
      int s = k >> 4, ci = k & 15;
      if (t > s) v = KT[((0 * 32 + (t - s)) * 16 + co) * 16 + ci];
      else if (t < s) v = KT[((1 * 32 + (s - t)) * 16 + co) * 16 + ci];
      else v = KT[(co)*16 + ci] + KT[((32) * 16 + co) * 16 + ci] + (co == ci ? dsk[co] : 0.f);
    } else {
      int kk = k - 512, d = kk >> 7, pp = (kk & 127) >> 1, c = kk & 1;
      int tau = d == 0 ? t + 1 : 32 - t;
      float cr = CC[((d * 16 + co) * 64 + pp) * 2], cim = CC[((d * 16 + co) * 64 + pp) * 2 + 1];
      float pr = POW[((d * 33 + tau) * 64 + pp) * 2], pi = POW[((d * 33 + tau) * 64 + pp) * 2 + 1];
      float xr = cr * pr - cim * pi, xi = cr * pi + cim * pr;
      v = c == 0 ? xr : -xi;
    }
    TG[e] = f2bf(v);
  }
  bf16_t* ET = (bf16_t*)(ws + W_ET) + (size_t)g * 256 * 512;
  for (int e = part * 32 * 512 + tid; e < (part + 1) * 32 * 512; e += NT) {
    int n = e >> 9, k = e & 511;
    int d = n >> 7, pp = (n & 127) >> 1, c = n & 1, s = k >> 4, ci = k & 15;
    int tau = d == 0 ? 31 - s : s;
    float pr = POW[((d * 33 + tau) * 64 + pp) * 2], pi = POW[((d * 33 + tau) * 64 + pp) * 2 + 1];
    float br = BB[((d * 64 + pp) * 16 + ci) * 2], bi = BB[((d * 64 + pp) * 16 + ci) * 2 + 1];
    float v = c == 0 ? (pr * br - pi * bi) : (pr * bi + pi * br);
    ET[e] = f2bf(v);
  }
  __syncthreads();
}

__device__ __forceinline__ void rms_item(const Params& p, int mode, int l, int item) {
  const int lane = tidx() & 63, w = tidx() >> 6;
  const int row = item * 8 + w;
  char* ws = p.ws;
  const float* xin = (mode == 2 || l > 0) ? p.out : p.in[I_X];
  float xv[16];
#pragma unroll
  for (int t = 0; t < 4; t++) {
    float4 v = *(const float4*)(xin + (size_t)row * 1024 + t * 256 + lane * 4);
    xv[t * 4] = v.x; xv[t * 4 + 1] = v.y; xv[t * 4 + 2] = v.z; xv[t * 4 + 3] = v.w;
  }
  if (mode >= 1) {
    const bf16_t* y = (const bf16_t*)(ws + (mode == 1 ? W_O : W_FO)) + (size_t)row * 1024;
    const float* gp = (mode == 1 ? p.in[I_GMPOST] : p.in[I_GFPOST]) + l * 1024;
    float yv[16];
    float ss = 0.f;
#pragma unroll
    for (int t = 0; t < 4; t++) {
      uint2 u = *(const uint2*)(y + t * 256 + lane * 4);
      yv[t * 4] = lo16(u.x); yv[t * 4 + 1] = hi16(u.x); yv[t * 4 + 2] = lo16(u.y); yv[t * 4 + 3] = hi16(u.y);
    }
#pragma unroll
    for (int e = 0; e < 16; e++) ss += yv[e] * yv[e];
    ss = wave_sum(ss);
    float r = rsqrtf(ss * (1.f / 1024.f) + EPS);
#pragma unroll
    for (int t = 0; t < 4; t++) {
      float4 gv = *(const float4*)(gp + t * 256 + lane * 4);
      xv[t * 4] += yv[t * 4] * r * gv.x; xv[t * 4 + 1] += yv[t * 4 + 1] * r * gv.y;
      xv[t * 4 + 2] += yv[t * 4 + 2] * r * gv.z; xv[t * 4 + 3] += yv[t * 4 + 3] * r * gv.w;
      *(float4*)(p.out + (size_t)row * 1024 + t * 256 + lane * 4) = make_float4(xv[t * 4], xv[t * 4 + 1], xv[t * 4 + 2], xv[t * 4 + 3]);
    }
  }
  const bool wh = (mode != 2) || (l + 1 < 2);
  if (wh) {
    const float* gh = (mode == 0 ? p.in[I_GMPRE] + l * 1024 : (mode == 1 ? p.in[I_GFPRE] + l * 1024 : p.in[I_GMPRE] + (l + 1) * 1024));
    float ss = 0.f;
#pragma unroll
    for (int e = 0; e < 16; e++) ss += xv[e] * xv[e];
    ss = wave_sum(ss);
    float r = rsqrtf(ss * (1.f / 1024.f) + EPS);
    bf16_t* h = (bf16_t*)(ws + W_HBF) + (size_t)row * 1024;
#pragma unroll
    for (int t = 0; t < 4; t++) {
      float4 gv = *(const float4*)(gh + t * 256 + lane * 4);
      *(uint2*)(h + t * 256 + lane * 4) = pack4(xv[t * 4] * r * gv.x, xv[t * 4 + 1] * r * gv.y, xv[t * 4 + 2] * r * gv.z, xv[t * 4 + 3] * r * gv.w);
    }
  }
}

__device__ __forceinline__ void rms_loop(const Params& p, int mode, int l) {
  const int lane = tidx() & 63, w = tidx() >> 6;
  const int nb = gridDim.x;
  char* ws = p.ws;
  const float* xin = (mode == 2 || l > 0) ? p.out : p.in[I_X];
  const bf16_t* y = (const bf16_t*)(ws + (mode == 1 ? W_O : W_FO));
  const float* gp = (mode == 1 ? p.in[I_GMPOST] : p.in[I_GFPOST]) + l * 1024;
  const bool wh = (mode != 2) || (l + 1 < 2);
  const float* gh = (mode == 0 ? p.in[I_GMPRE] + l * 1024 : (mode == 1 ? p.in[I_GFPRE] + l * 1024 : p.in[I_GMPRE] + (l + 1 < 2 ? l + 1 : l) * 1024));
  float4 xc[4], xn[4];
  uint2 yc[4], yn[4];
  int it = blockIdx.x;
#pragma unroll
  for (int t = 0; t < 4; t++) { xc[t] = make_float4(0.f, 0.f, 0.f, 0.f); xn[t] = xc[t]; yc[t] = make_uint2(0u, 0u); yn[t] = yc[t]; }
  if (it < 2048) {
    const size_t row = (size_t)it * 8 + w;
#pragma unroll
    for (int t = 0; t < 4; t++) {
      xc[t] = ld_nt_f4(xin + row * 1024 + t * 256 + lane * 4);
      if (mode >= 1) yc[t] = ld_nt_u2(y + row * 1024 + t * 256 + lane * 4);
    }
  }
#pragma unroll 1
  while (it < 2048) {
    const int nx = it + nb;
    if (nx < 2048) {
      const size_t rown = (size_t)nx * 8 + w;
#pragma unroll
      for (int t = 0; t < 4; t++) {
        xn[t] = ld_nt_f4(xin + rown * 1024 + t * 256 + lane * 4);
        if (mode >= 1) yn[t] = ld_nt_u2(y + rown * 1024 + t * 256 + lane * 4);
      }
    }
    const size_t row = (size_t)it * 8 + w;
    float xv[16];
#pragma unroll
    for (int t = 0; t < 4; t++) { xv[t * 4] = xc[t].x; xv[t * 4 + 1] = xc[t].y; xv[t * 4 + 2] = xc[t].z; xv[t * 4 + 3] = xc[t].w; }
    if (mode >= 1) {
      float yv[16];
      float ss = 0.f;
#pragma unroll
      for (int t = 0; t < 4; t++) { yv[t * 4] = lo16(yc[t].x); yv[t * 4 + 1] = hi16(yc[t].x); yv[t * 4 + 2] = lo16(yc[t].y); yv[t * 4 + 3] = hi16(yc[t].y); }
#pragma unroll
      for (int e = 0; e < 16; e++) ss += yv[e] * yv[e];
      ss = wave_sum(ss);
      const float r = rsqrtf(ss * (1.f / 1024.f) + EPS);
#pragma unroll
      for (int t = 0; t < 4; t++) {
        float4 gv = *(const float4*)(gp + t * 256 + lane * 4);
        xv[t * 4] += yv[t * 4] * r * gv.x; xv[t * 4 + 1] += yv[t * 4 + 1] * r * gv.y;
        xv[t * 4 + 2] += yv[t * 4 + 2] * r * gv.z; xv[t * 4 + 3] += yv[t * 4 + 3] * r * gv.w;
        st_nt_f4(p.out + row * 1024 + t * 256 + lane * 4, xv[t * 4], xv[t * 4 + 1], xv[t * 4 + 2], xv[t * 4 + 3]);
      }
    }
    if (wh) {
      float ss = 0.f;
#pragma unroll
      for (int e = 0; e < 16; e++) ss += xv[e] * xv[e];
      ss = wave_sum(ss);
      const float r = rsqrtf(ss * (1.f / 1024.f) + EPS);
      bf16_t* h = (bf16_t*)(ws + W_HBF) + row * 1024;
#pragma unroll
      for (int t = 0; t < 4; t++) {
        float4 gv = *(const float4*)(gh + t * 256 + lane * 4);
        *(uint2*)(h + t * 256 + lane * 4) = pack4(xv[t * 4] * r * gv.x, xv[t * 4 + 1] * r * gv.y, xv[t * 4 + 2] * r * gv.z, xv[t * 4 + 3] * r * gv.w);
      }
    }
#pragma unroll
    for (int t = 0; t < 4; t++) { xc[t] = xn[t]; yc[t] = yn[t]; }
    it = nx;
  }
}

template <int NTL, int PN>
__device__ __forceinline__ void tile_map(int it, int& mt, int& nt) {
  constexpr int PM = 32 / PN, NPN = NTL / PN;
  constexpr int total = 64 * NTL, full = (total / 256) * 256;
  int gp, within;
  if (it < full) { int xcd = it & 7, loc = it >> 3; gp = (loc >> 5) * 8 + xcd; within = loc & 31; }
  else { int rem = it - full; gp = full / 32 + (rem >> 5); within = rem & 31; }
  const int mp = gp / NPN, np = gp - mp * NPN;
  mt = mp * PM + within / PN;
  nt = np * PN + within % PN;
}

__device__ __forceinline__ void inproj_item(const Params& p, int l, int item, char* smem) {
  int mt, nt;
  tile_map<10, 2>(item, mt, nt);
  const int m0 = mt * 256, n0 = nt * 256;
  const int nsh = n0 >= 2048 ? 16 : 0;
  char* ws = p.ws;
  const bf16_t* A = (const bf16_t*)(ws + W_HBF) + (size_t)m0 * 1024;
  const bf16_t* B = (const bf16_t*)(ws + W_WIN) + (size_t)(n0 + nsh) * 1024;
  f32x4 acc[8][4];
  zero_acc(acc);
  gemm_acc<256, 256, 2, 4, true>(1024, [&](int r, int k) { return A + (size_t)r * 1024 + k; }, [&](int r, int k) { return B + (size_t)perm32(r) * 1024 + k; }, smem, acc);
  const int lane = tidx() & 63, w = tidx() >> 6;
  const int mb = (w / 4) * 128, nb = (w % 4) * 64;
  bf16_t* Z = (bf16_t*)(ws + W_Z);
  const float* bin = p.in[I_BIN] + l * NIN;
#pragma unroll
  for (int jj = 0; jj < 2; jj++) {
    const int n = n0 + nsh + nb + jj * 32 + (lane >> 4) * 8;
    float4 b0 = *(const float4*)(bin + n), b1 = *(const float4*)(bin + n + 4);
#pragma unroll
    for (int i = 0; i < 8; i++) {
      const int m = m0 + mb + i * 16 + (lane & 15);
      uint4 o;
      o.x = pack2(acc[i][2 * jj][0] + b0.x, acc[i][2 * jj][1] + b0.y); o.y = pack2(acc[i][2 * jj][2] + b0.z, acc[i][2 * jj][3] + b0.w);
      o.z = pack2(acc[i][2 * jj + 1][0] + b1.x, acc[i][2 * jj + 1][1] + b1.y); o.w = pack2(acc[i][2 * jj + 1][2] + b1.z, acc[i][2 * jj + 1][3] + b1.w);
      *(uint4*)(Z + (size_t)m * ZS + (n - nsh)) = o;
    }
  }
}
__device__ __forceinline__ void inproj_half_item(const Params& p, int l, int item, char* smem) {
  const int big = 512 + (item >> 1), half = item & 1;
  int mt, nt;
  tile_map<10, 2>(big, mt, nt);
  const int m0 = mt * 256, n0 = nt * 256 + half * 128;
  const int nsh = n0 >= 2048 ? 16 : 0;
  char* ws = p.ws;
  const bf16_t* A = (const bf16_t*)(ws + W_HBF) + (size_t)m0 * 1024;
  const bf16_t* B = (const bf16_t*)(ws + W_WIN) + (size_t)(n0 + nsh) * 1024;
  f32x4 acc[4][4];
  zero_acc(acc);
  gemm_acc<256, 128, 4, 2, true>(1024, [&](int r, int k) { return A + (size_t)r * 1024 + k; }, [&](int r, int k) { return B + (size_t)perm32(r) * 1024 + k; }, smem, acc);
  const int lane = tidx() & 63, w = tidx() >> 6;
  const int mb = (w / 2) * 64, nb = (w % 2) * 64;
  bf16_t* Z = (bf16_t*)(ws + W_Z);
  const float* bin = p.in[I_BIN] + l * NIN;
#pragma unroll
  for (int jj = 0; jj < 2; jj++) {
    const int n = n0 + nsh + nb + jj * 32 + (lane >> 4) * 8;
    float4 b0 = *(const float4*)(bin + n), b1 = *(const float4*)(bin + n + 4);
#pragma unroll
    for (int i = 0; i < 4; i++) {
      const int m = m0 + mb + i * 16 + (lane & 15);
      uint4 o;
      o.x = pack2(acc[i][2 * jj][0] + b0.x, acc[i][2 * jj][1] + b0.y); o.y = pack2(acc[i][2 * jj][2] + b0.z, acc[i][2 * jj][3] + b0.w);
      o.z = pack2(acc[i][2 * jj + 1][0] + b1.x, acc[i][2 * jj + 1][1] + b1.y); o.w = pack2(acc[i][2 * jj + 1][2] + b1.z, acc[i][2 * jj + 1][3] + b1.w);
      *(uint4*)(Z + (size_t)m * ZS + (n - nsh)) = o;
    }
  }
}
__device__ __forceinline__ void ingate_item(const Params& p, int l, int item, char* smem) {
  const int m0 = item * 256;
  char* ws = p.ws;
  const bf16_t* A = (const bf16_t*)(ws + W_HBF) + (size_t)m0 * 1024;
  const bf16_t* B = (const bf16_t*)(ws + W_WIN) + (size_t)OFF_IG * 1024;
  f32x4 acc[4][2];
  zero_acc(acc);
  gemm_acc<256, 64, 4, 2, true>(1024, [&](int r, int k) { return A + (size_t)r * 1024 + k; }, [&](int r, int k) { int rr = r < 16 ? r : 15; return B + (size_t)rr * 1024 + k; }, smem, acc);
  const int lane = tidx() & 63, w = tidx() >> 6;
  const int mb = (w / 2) * 64;
  float* ZG = (float*)(ws + W_ZG);
  const float* bin = p.in[I_BIN] + l * NIN + OFF_IG;
  if ((w & 1) == 0) {
    const int n = (lane >> 4) * 4;
    float4 bv = *(const float4*)(bin + n);
#pragma unroll
    for (int i = 0; i < 4; i++) {
      const int m = m0 + mb + i * 16 + (lane & 15);
      *(float4*)(ZG + (size_t)m * 16 + n) = make_float4(acc[i][0][0] + bv.x, acc[i][0][1] + bv.y, acc[i][0][2] + bv.z, acc[i][0][3] + bv.w);
    }
  }
}

template <int MODE, int NTL, int PN>
__device__ __forceinline__ void plain_gemm_item(const bf16_t* A, const bf16_t* Bt, bf16_t* C, int K, int item, char* smem) {
  constexpr int N = NTL * 256;
  int mt, nt;
  tile_map<NTL, PN>(item, mt, nt);
  const int m0 = mt * 256, n0 = nt * 256;
  const bf16_t* Ab = A + (size_t)m0 * K;
  const bf16_t* Bb = Bt + (size_t)n0 * K;
  f32x4 acc[8][4];
  zero_acc(acc);
  gemm_acc<256, 256, 2, 4, true>(K, [&](int r, int k) { return Ab + (size_t)r * K + k; }, [&](int r, int k) { return Bb + (size_t)perm32(r) * K + k; }, smem, acc);
  const int lane = tidx() & 63, w = tidx() >> 6;
  const int mb = (w / 4) * 128, nb = (w % 4) * 64;
#pragma unroll
  for (int jj = 0; jj < 2; jj++) {
    const int n = n0 + nb + jj * 32 + (lane >> 4) * 8;
#pragma unroll
    for (int i = 0; i < 8; i++) {
      const int m = m0 + mb + i * 16 + (lane & 15);
      float v[8];
#pragma unroll
      for (int r = 0; r < 4; r++) { v[r] = acc[i][2 * jj][r]; v[4 + r] = acc[i][2 * jj + 1][r]; }
      if (MODE == 1) {
#pragma unroll
        for (int r = 0; r < 8; r++) { v[r] = fmaxf(v[r], 0.f); v[r] *= v[r]; }
      }
      uint4 o;
      o.x = pack2(v[0], v[1]); o.y = pack2(v[2], v[3]); o.z = pack2(v[4], v[5]); o.w = pack2(v[6], v[7]);
      *(uint4*)(C + (size_t)m * N + n) = o;
    }
  }
}

template <int MODE, int NTL, int PN>
__device__ __forceinline__ void plain_gemm_chain(const bf16_t* A, const bf16_t* Bt, bf16_t* C, int K, int item, int next, bool has_next, bool preloaded, Stage& st, char* smem) {
  constexpr int N = NTL * 256;
  int mt, nt, mt2 = 0, nt2 = 0;
  tile_map<NTL, PN>(item, mt, nt);
  if (has_next) tile_map<NTL, PN>(next, mt2, nt2);
  const int m0 = mt * 256, n0 = nt * 256;
  const bf16_t* Ab = A + (size_t)m0 * K;
  const bf16_t* Bb = Bt + (size_t)n0 * K;
  const bf16_t* Ab2 = A + (size_t)mt2 * 256 * K;
  const bf16_t* Bb2 = Bt + (size_t)nt2 * 256 * K;
  f32x4 acc[8][4];
  zero_acc(acc);
  gemm_chain<256, 256, 2, 4, true>(K, [&](int r, int k) { return Ab + (size_t)r * K + k; }, [&](int r, int k) { return Bb + (size_t)perm32(r) * K + k; },
                                   preloaded, has_next, [&](int r, int k) { return Ab2 + (size_t)r * K + k; }, [&](int r, int k) { return Bb2 + (size_t)perm32(r) * K + k; }, st, smem, acc);
  const int lane = tidx() & 63, w = tidx() >> 6;
  const int mb = (w / 4) * 128, nb = (w % 4) * 64;
#pragma unroll
  for (int jj = 0; jj < 2; jj++) {
    const int n = n0 + nb + jj * 32 + (lane >> 4) * 8;
#pragma unroll
    for (int i = 0; i < 8; i++) {
      const int m = m0 + mb + i * 16 + (lane & 15);
      float v[8];
#pragma unroll
      for (int r = 0; r < 4; r++) { v[r] = acc[i][2 * jj][r]; v[4 + r] = acc[i][2 * jj + 1][r]; }
      if (MODE == 1) {
#pragma unroll
        for (int r = 0; r < 8; r++) { v[r] = fmaxf(v[r], 0.f); v[r] *= v[r]; }
      }
      uint4 o;
      o.x = pack2(v[0], v[1]); o.y = pack2(v[2], v[3]); o.z = pack2(v[4], v[5]); o.w = pack2(v[6], v[7]);
      *(uint4*)(C + (size_t)m * N + n) = o;
    }
  }
}

__device__ __forceinline__ void merge_item(const Params& p, int l, int item, char* smem) {
  int mt, nt;
  tile_map<8, 4>(item, mt, nt);
  const int m0 = mt * 256, n0 = nt * 128;
  char* ws = p.ws;
  const bf16_t* HB = (const bf16_t*)(ws + W_HBF) + (size_t)m0 * 1024;
  const bf16_t* HM = (const bf16_t*)(ws + W_HM) + (size_t)m0 * 512;
  const bf16_t* YF = (const bf16_t*)(ws + W_YF) + (size_t)m0 * 256;
  const bf16_t* YS = (const bf16_t*)(ws + W_YS) + (size_t)m0 * 256;
  const bf16_t* WG = (const bf16_t*)(ws + W_WIN) + (size_t)(OFF_GATE + n0) * 1024;
  const bf16_t* WUM = (const bf16_t*)(ws + W_WUPM) + (size_t)n0 * 512;
  const bf16_t* WUF = (const bf16_t*)(ws + W_WUPF) + (size_t)n0 * 256;
  const bf16_t* WGL = (const bf16_t*)(ws + W_WGLU) + (size_t)n0 * 256;
  const float* bin = p.in[I_BIN] + l * NIN + OFF_GATE;
  const float* bgl = p.in[I_BGLU] + l * 2048;
  uint2 mixp[4][4];
#pragma unroll
  for (int i = 0; i < 4; i++)
#pragma unroll
    for (int j = 0; j < 4; j++) mixp[i][j] = make_uint2(0u, 0u);
  bf16_t* MIX = (bf16_t*)(ws + W_MIX);
#pragma unroll 1
  for (int br = 0; br < 3; br++) {
    uint2 gp[4][4];
    {
      f32x4 acc[4][4];
      zero_acc(acc);
      const bf16_t* WGb = WG + (size_t)br * 1024 * 1024;
      gemm_acc<256, 128, 4, 2, true>(1024, [&](int r, int k) { return HB + (size_t)r * 1024 + k; }, [&](int r, int k) { return WGb + (size_t)r * 1024 + k; }, smem, acc);
#pragma unroll
      for (int j = 0; j < 4; j++) {
        const int n = n0 + ((tidx() >> 6) & 1) * 64 + j * 16 + ((tidx() >> 4) & 3) * 4;
        float4 bv = *(const float4*)(bin + br * 1024 + n);
#pragma unroll
        for (int i = 0; i < 4; i++)
          gp[i][j] = pack4(sigm(acc[i][j][0] + bv.x), sigm(acc[i][j][1] + bv.y), sigm(acc[i][j][2] + bv.z), sigm(acc[i][j][3] + bv.w));
      }
    }
    if (br == 2) {
      f32x4 a2[4][4];
      zero_acc(a2);
      gemm_acc<256, 128, 4, 2, true>(256, [&](int r, int k) { return YS + (size_t)r * 256 + k; }, [&](int r, int k) { return WGL + (size_t)(1024 + r) * 256 + k; }, smem, a2);
#pragma unroll
      for (int j = 0; j < 4; j++) {
        const int n = n0 + ((tidx() >> 6) & 1) * 64 + j * 16 + ((tidx() >> 4) & 3) * 4;
        float4 b2 = *(const float4*)(bgl + 1024 + n);
#pragma unroll
        for (int i = 0; i < 4; i++)
          gp[i][j] = pack4(lo16(gp[i][j].x) * sigm(a2[i][j][0] + b2.x), hi16(gp[i][j].x) * sigm(a2[i][j][1] + b2.y),
                           lo16(gp[i][j].y) * sigm(a2[i][j][2] + b2.z), hi16(gp[i][j].y) * sigm(a2[i][j][3] + b2.w));
      }
    }
    const bf16_t* A = br == 0 ? HM : (br == 1 ? YF : YS);
    const bf16_t* W = br == 0 ? WUM : (br == 1 ? WUF : WGL);
    const int KA = br == 0 ? 512 : 256;
    f32x4 acc[4][4];
    zero_acc(acc);
    gemm_acc<256, 128, 4, 2, true>(KA, [&](int r, int k) { return A + (size_t)r * KA + k; }, [&](int r, int k) { return W + (size_t)r * KA + k; }, smem, acc);
#pragma unroll
    for (int j = 0; j < 4; j++) {
      const int n = n0 + ((tidx() >> 6) & 1) * 64 + j * 16 + ((tidx() >> 4) & 3) * 4;
      float4 b1 = make_float4(0.f, 0.f, 0.f, 0.f);
      if (br == 2) b1 = *(const float4*)(bgl + n);
#pragma unroll
      for (int i = 0; i < 4; i++) {
        mixp[i][j] = pack4(lo16(mixp[i][j].x) + (acc[i][j][0] + b1.x) * lo16(gp[i][j].x), hi16(mixp[i][j].x) + (acc[i][j][1] + b1.y) * hi16(gp[i][j].x),
                           lo16(mixp[i][j].y) + (acc[i][j][2] + b1.z) * lo16(gp[i][j].y), hi16(mixp[i][j].y) + (acc[i][j][3] + b1.w) * hi16(gp[i][j].y));
      }
    }
  }
#pragma unroll
  for (int j = 0; j < 4; j++) {
    const int n = n0 + ((tidx() >> 6) & 1) * 64 + j * 16 + ((tidx() >> 4) & 3) * 4;
#pragma unroll
    for (int i = 0; i < 4; i++) {
      const int m = m0 + (tidx() >> 7) * 64 + i * 16 + (tidx() & 15);
      *(uint2*)(MIX + (size_t)m * 1024 + n) = mixp[i][j];
    }
  }
}

__device__ __forceinline__ void mergelite_item(const Params& p, int l, int item, char* smem) {
  int mt, nt;
  tile_map<8, 4>(item, mt, nt);
  const int m0 = mt * 256, n0 = nt * 128;
  char* ws = p.ws;
  const bf16_t* HM = (const bf16_t*)(ws + W_HM) + (size_t)m0 * 512;
  const bf16_t* YF = (const bf16_t*)(ws + W_YF) + (size_t)m0 * 256;
  const bf16_t* YS = (const bf16_t*)(ws + W_YS) + (size_t)m0 * 256;
  const bf16_t* WUM = (const bf16_t*)(ws + W_WUPM) + (size_t)n0 * 512;
  const bf16_t* WUF = (const bf16_t*)(ws + W_WUPF) + (size_t)n0 * 256;
  const bf16_t* WGL = (const bf16_t*)(ws + W_WGLU) + (size_t)n0 * 256;
  const bf16_t* WGL2 = WGL + (size_t)1024 * 256;
  const float* bgl = p.in[I_BGLU] + l * 2048;
  const bf16_t* G = (const bf16_t*)(ws + W_GATE);
  bf16_t* MIX = (bf16_t*)(ws + W_MIX);
#define MROW(i) (m0 + (tidx() >> 7) * 64 + (i) * 16 + (tidx() & 15))
#define NCOL8(jj) (n0 + ((tidx() >> 6) & 1) * 64 + (jj) * 32 + ((tidx() >> 4) & 3) * 8)
  Stage st; st.a0 = st.a1 = st.a2 = st.a3 = st.b0 = st.b1 = st.b2 = st.b3 = make_uint4(0, 0, 0, 0);
  uint2 mixp[4][4], tmpp[4][4];
#pragma unroll
  for (int i = 0; i < 4; i++)
#pragma unroll
    for (int j = 0; j < 4; j++) { mixp[i][j] = make_uint2(0u, 0u); tmpp[i][j] = make_uint2(0u, 0u); }
#pragma unroll 1
  for (int sg = 0; sg < 4; sg++) {
    const bf16_t* A = sg == 0 ? HM : (sg == 1 ? YF : YS);
    const bf16_t* W = sg == 0 ? WUM : (sg == 1 ? WUF : (sg == 2 ? WGL : WGL2));
    const int KA = sg == 0 ? 512 : 256;
    const bf16_t* A2 = sg == 0 ? YF : YS;
    const bf16_t* W2 = sg == 0 ? WUF : (sg == 1 ? WGL : WGL2);
    f32x4 acc[4][4];
    zero_acc(acc);
    gemm_chain<256, 128, 4, 2, true>(KA, [&](int r, int k) { return A + (size_t)r * KA + k; }, [&](int r, int k) { return W + (size_t)perm32(r) * KA + k; },
                                     sg > 0, sg < 3, [&](int r, int k) { return A2 + (size_t)r * 256 + k; }, [&](int r, int k) { return W2 + (size_t)perm32(r) * 256 + k; }, st, smem, acc);
    if (sg < 2) {
#pragma unroll
      for (int jj = 0; jj < 2; jj++)
#pragma unroll
        for (int i = 0; i < 4; i++) {
          const uint4 g = *(const uint4*)(G + (size_t)MROW(i) * 3072 + sg * 1024 + NCOL8(jj));
          const uint2 o0 = mixp[i][2 * jj], o1 = mixp[i][2 * jj + 1];
          mixp[i][2 * jj].x = pack2(lo16(o0.x) + acc[i][2 * jj][0] * lo16(g.x), hi16(o0.x) + acc[i][2 * jj][1] * hi16(g.x));
          mixp[i][2 * jj].y = pack2(lo16(o0.y) + acc[i][2 * jj][2] * lo16(g.y), hi16(o0.y) + acc[i][2 * jj][3] * hi16(g.y));
          mixp[i][2 * jj + 1].x = pack2(lo16(o1.x) + acc[i][2 * jj + 1][0] * lo16(g.z), hi16(o1.x) + acc[i][2 * jj + 1][1] * hi16(g.z));
          mixp[i][2 * jj + 1].y = pack2(lo16(o1.y) + acc[i][2 * jj + 1][2] * lo16(g.w), hi16(o1.y) + acc[i][2 * jj + 1][3] * hi16(g.w));
        }
    } else if (sg == 2) {
#pragma unroll
      for (int jj = 0; jj < 2; jj++) {
        const float4 b0 = *(const float4*)(bgl + NCOL8(jj)), b1 = *(const float4*)(bgl + NCOL8(jj) + 4);
#pragma unroll
        for (int i = 0; i < 4; i++) {
          tmpp[i][2 * jj].x = pack2(acc[i][2 * jj][0] + b0.x, acc[i][2 * jj][1] + b0.y);
          tmpp[i][2 * jj].y = pack2(acc[i][2 * jj][2] + b0.z, acc[i][2 * jj][3] + b0.w);
          tmpp[i][2 * jj + 1].x = pack2(acc[i][2 * jj + 1][0] + b1.x, acc[i][2 * jj + 1][1] + b1.y);
          tmpp[i][2 * jj + 1].y = pack2(acc[i][2 * jj + 1][2] + b1.z, acc[i][2 * jj + 1][3] + b1.w);
        }
      }
    } else {
#pragma unroll
      for (int jj = 0; jj < 2; jj++) {
        const float4 b0 = *(const float4*)(bgl + 1024 + NCOL8(jj)), b1 = *(const float4*)(bgl + 1024 + NCOL8(jj) + 4);
#pragma unroll
        for (int i = 0; i < 4; i++) {
          const uint4 g = *(const uint4*)(G + (size_t)MROW(i) * 3072 + 2048 + NCOL8(jj));
          const uint2 t0 = tmpp[i][2 * jj], t1 = tmpp[i][2 * jj + 1], o0 = mixp[i][2 * jj], o1 = mixp[i][2 * jj + 1];
          uint4 o;
          o.x = pack2(lo16(o0.x) + lo16(t0.x) * sigm(acc[i][2 * jj][0] + b0.x) * lo16(g.x), hi16(o0.x) + hi16(t0.x) * sigm(acc[i][2 * jj][1] + b0.y) * hi16(g.x));
          o.y = pack2(lo16(o0.y) + lo16(t0.y) * sigm(acc[i][2 * jj][2] + b0.z) * lo16(g.y), hi16(o0.y) + hi16(t0.y) * sigm(acc[i][2 * jj][3] + b0.w) * hi16(g.y));
          o.z = pack2(lo16(o1.x) + lo16(t1.x) * sigm(acc[i][2 * jj + 1][0] + b1.x) * lo16(g.z), hi16(o1.x) + hi16(t1.x) * sigm(acc[i][2 * jj + 1][1] + b1.y) * hi16(g.z));
          o.w = pack2(lo16(o1.y) + lo16(t1.y) * sigm(acc[i][2 * jj + 1][2] + b1.z) * lo16(g.w), hi16(o1.y) + hi16(t1.y) * sigm(acc[i][2 * jj + 1][3] + b1.w) * hi16(g.w));
          *(uint4*)(MIX + (size_t)MROW(i) * 1024 + NCOL8(jj)) = o;
        }
      }
    }
  }
#undef MROW
#undef NCOL8
}

__device__ __forceinline__ void four_g1(const Params& p, int item, char* smem) {
  const int g = item & 3, s2 = (item >> 2) & 63, b = item >> 8;
  char* ws = p.ws;
  const bf16_t* Z = (const bf16_t*)(ws + W_Z) + ((size_t)b * SEQ + s2) * ZS + OFF_F + g * 64;
  const bf16_t* F1T = (const bf16_t*)(ws + W_F1T);
  f32x4 acc[2][4];
  zero_acc(acc);
  gemm_acc<128, 128, 4, 2, false>(64, [&](int r, int k) { return Z + (size_t)r * 64 * ZS + k; }, [&](int r, int k) { return F1T + r * 64 + k; }, smem, acc);
  const int lane = tidx() & 63, w = tidx() >> 6;
  const int mb = (w / 2) * 32, nb = (w % 2) * 64;
  bf16_t* U1T = (bf16_t*)(ws + W_U1T);
#pragma unroll
  for (int i = 0; i < 2; i++) {
    const int s1 = mb + i * 16 + (lane >> 4) * 4;
#pragma unroll
    for (int j = 0; j < 4; j++) {
      const int n = nb + j * 16 + (lane & 15), c = n >> 6, jj = n & 63;
      size_t off = ((((size_t)(b * 256 + g * 64 + jj) * 64 + s2) * 2 + c) * 128) + s1;
      *(uint2*)(U1T + off) = pack4(acc[i][j][0], acc[i][j][1], acc[i][j][2], acc[i][j][3]);
    }
  }
}
__device__ __forceinline__ void four_g2(const Params& p, int item, char* smem) {
  const int mt = item >> 1, nt = item & 1;
  const int m0 = mt * 128, n0 = nt * 128;
  char* ws = p.ws;
  const bf16_t* A = (const bf16_t*)(ws + W_U1T) + (size_t)m0 * 256;
  const bf16_t* B = (const bf16_t*)(ws + W_F2T) + (size_t)n0 * 256;
  f32x4 acc[2][4];
  zero_acc(acc);
  gemm_acc<128, 128, 4, 2, false>(256, [&](int r, int k) { return A + (size_t)r * 256 + k; }, [&](int r, int k) { return B + (size_t)r * 256 + k; }, smem, acc);
  const int lane = tidx() & 63, w = tidx() >> 6;
  const int mb = (w / 2) * 32, nb = (w % 2) * 64;
  const float* TW = (const float*)(ws + W_TW);
  bf16_t* A2T = (bf16_t*)(ws + W_A2T);
#pragma unroll
  for (int i = 0; i < 2; i++) {
    const int m = m0 + mb + i * 16 + (lane >> 4) * 4;
    const int s2 = m & 63, col = (m >> 6) & 255, b = m >> 14;
#pragma unroll
    for (int jp = 0; jp < 2; jp++) {
      const int nn = n0 + nb + jp * 32;
      const int k1 = (nn >> 5) * 16 + (lane & 15);
      float re[4], im[4];
#pragma unroll
      for (int r = 0; r < 4; r++) {
        float c = TW[((s2 + r) * 128 + k1) * 2], s = TW[((s2 + r) * 128 + k1) * 2 + 1];
        float ar = acc[i][jp * 2][r], ai = acc[i][jp * 2 + 1][r];
        re[r] = ar * c + ai * s;
        im[r] = ai * c - ar * s;
      }
      size_t off = ((size_t)(b * 128 + k1) * 256 + col) * 128 + s2;
      *(uint2*)(A2T + off) = pack4(re[0], re[1], re[2], re[3]);
      *(uint2*)(A2T + off + 64) = pack4(im[0], im[1], im[2], im[3]);
    }
  }
}
__device__ __forceinline__ void four_g3(const Params& p, int item, char* smem) {
  const int m0 = item * 128;
  char* ws = p.ws;
  const bf16_t* A = (const bf16_t*)(ws + W_A2T) + (size_t)m0 * 128;
  const bf16_t* B = (const bf16_t*)(ws + W_F3T);
  f32x4 acc[2][2];
  zero_acc(acc);
  gemm_acc<128, 64, 4, 2, false>(128, [&](int r, int k) { return A + (size_t)r * 128 + k; }, [&](int r, int k) { return B + r * 128 + k; }, smem, acc);
  const int lane = tidx() & 63, w = tidx() >> 6;
  const int mb = (w / 2) * 32, nb = (w % 2) * 32;
  bf16_t* YF = (bf16_t*)(ws + W_YF);
#pragma unroll
  for (int i = 0; i < 2; i++) {
    const int m = m0 + mb + i * 16 + (lane >> 4) * 4;
    const int col = m & 255, k1 = (m >> 8) & 127, b = m >> 15;
#pragma unroll
    for (int j = 0; j < 2; j++) {
      const int k2 = nb + j * 16 + (lane & 15);
      size_t off = ((size_t)b * SEQ + k1 + 128 * k2) * 256 + col;
      *(uint2*)(YF + off) = pack4(acc[i][j][0], acc[i][j][1], acc[i][j][2], acc[i][j][3]);
    }
  }
}

__device__ __forceinline__ void s5_e(const Params& p, int item, char* smem) {
  const int g = item >> 3, mt = (item >> 1) & 3, nt = item & 1;
  const int m0 = mt * 128, n0 = nt * 128;
  char* ws = p.ws;
  const bf16_t* Z = (const bf16_t*)(ws + W_Z) + OFF_S + g * 16;
  const bf16_t* B = (const bf16_t*)(ws + W_ET) + ((size_t)g * 256 + n0) * 512;
  f32x4 acc[2][4];
  zero_acc(acc);
  gemm_acc<128, 128, 4, 2, true>(512,
      [&](int r, int k) { int m = m0 + r; int tok = (m >> 8) * SEQ + (m & 255) * 32 + (k >> 4); return Z + (size_t)tok * ZS + (k & 15); },
      [&](int r, int k) { return B + (size_t)r * 512 + k; }, smem, acc);
  const int lane = tidx() & 63, w = tidx() >> 6;
  const int mb = (w / 2) * 32, nb = (w % 2) * 64;
  bf16_t* XE = (bf16_t*)(ws + W_XEND);
#pragma unroll
  for (int i = 0; i < 2; i++) {
    const int m = m0 + mb + i * 16 + (lane & 15);
#pragma unroll
    for (int j = 0; j < 4; j++) {
      const int n = n0 + nb + j * 16 + (lane >> 4) * 4;
      *(uint2*)(XE + ((size_t)m * 16 + g) * 256 + n) = pack4(acc[i][j][0], acc[i][j][1], acc[i][j][2], acc[i][j][3]);
    }
  }
}
__device__ __forceinline__ void s5_carry(const Params& p, int blk) {
  const int gt = blk * NT + tidx();
  const int b = gt >> 11, g = (gt >> 7) & 15, d = (gt >> 6) & 1, pp = gt & 63;
  char* ws = p.ws;
  const float* LP = (const float*)(ws + W_LPOW) + ((d * 16 + g) * 64 + pp) * 2;
  const float lr = LP[0], li = LP[1];
  const uint32_t* XE = (const uint32_t*)(ws + W_XEND);
  uint32_t* XC = (uint32_t*)(ws + W_XCAR);
  float xr = 0.f, xi = 0.f;
  for (int c0 = 0; c0 < 256; c0 += 32) {
    uint32_t v[32];
#pragma unroll
    for (int u = 0; u < 32; u++) {
      int c = d == 0 ? c0 + u : 255 - (c0 + u);
      v[u] = XE[(((size_t)(b * 256 + c) * 16 + g) * 256 + d * 128 + pp * 2) >> 1];
    }
#pragma unroll
    for (int u = 0; u < 32; u++) {
      int c = d == 0 ? c0 + u : 255 - (c0 + u);
      float nr = lr * xr - li * xi + lo16(v[u]);
      float ni = lr * xi + li * xr + hi16(v[u]);
      xr = nr; xi = ni;
      XC[(((size_t)(b * 256 + c) * 16 + g) * 256 + d * 128 + pp * 2) >> 1] = pack2(xr, xi);
    }
  }
}
__device__ __forceinline__ void s5_tg(const Params& p, int item, char* smem) {
  const int g = item >> 4, mt = (item >> 2) & 3, nt = item & 3;
  const int m0 = mt * 128, n0 = nt * 128;
  char* ws = p.ws;
  const bf16_t* Z = (const bf16_t*)(ws + W_Z) + OFF_S + g * 16;
  const bf16_t* XC = (const bf16_t*)(ws + W_XCAR);
  const bf16_t* ZR = (const bf16_t*)(ws + W_ZERO);
  const bf16_t* B = (const bf16_t*)(ws + W_TG) + ((size_t)g * 512 + n0) * 768;
  f32x4 acc[2][4];
  zero_acc(acc);
  gemm_acc<128, 128, 4, 2, true>(768,
      [&](int r, int k) -> const bf16_t* {
        int m = m0 + r; int b = m >> 8, c = m & 255;
        if (k < 512) { int tok = b * SEQ + c * 32 + (k >> 4); return Z + (size_t)tok * ZS + (k & 15); }
        int kk = k - 512; int d = kk >> 7; int cc = d == 0 ? c - 1 : c + 1;
        if (cc < 0 || cc > 255) return ZR;
        return XC + ((size_t)(b * 256 + cc) * 16 + g) * 256 + kk;
      },
      [&](int r, int k) { return B + (size_t)r * 768 + k; }, smem, acc);
  const int lane = tidx() & 63, w = tidx() >> 6;
  const int mb = (w / 2) * 32, nb = (w % 2) * 64;
  bf16_t* YS = (bf16_t*)(ws + W_YS);
#pragma unroll
  for (int i = 0; i < 2; i++) {
    const int m = m0 + mb + i * 16 + (lane & 15);
    const int b = m >> 8, c = m & 255;
#pragma unroll
    for (int j = 0; j < 4; j++) {
      const int n = n0 + nb + j * 16 + (lane >> 4) * 4;
      const int t = n >> 4, co = n & 15;
      size_t off = ((size_t)b * SEQ + c * 32 + t) * 256 + g * 16 + co;
      *(uint2*)(YS + off) = pack4(gelu_tanh(acc[i][j][0]), gelu_tanh(acc[i][j][1]), gelu_tanh(acc[i][j][2]), gelu_tanh(acc[i][j][3]));
    }
  }
}

__device__ __forceinline__ void conv8(const bf16_t* __restrict__ Z, const float* __restrict__ cw, const float* __restrict__ cb,
                                      int b, int s, int zcol, int ch, float (&o)[8]) {
  float4 b0 = *(const float4*)(cb + ch), b1 = *(const float4*)(cb + ch + 4);
  o[0] = b0.x; o[1] = b0.y; o[2] = b0.z; o[3] = b0.w; o[4] = b1.x; o[5] = b1.y; o[6] = b1.z; o[7] = b1.w;
#pragma unroll
  for (int wq = 0; wq < 5; wq++) {
    int ss = s + wq - 2;
    if (ss >= 0 && ss < SEQ) {
      uint4 v = *(const uint4*)(Z + ((size_t)b * SEQ + ss) * ZS + zcol);
      float4 w0 = *(const float4*)(cw + wq * 1024 + ch), w1 = *(const float4*)(cw + wq * 1024 + ch + 4);
      o[0] += w0.x * lo16(v.x); o[1] += w0.y * hi16(v.x); o[2] += w0.z * lo16(v.y); o[3] += w0.w * hi16(v.y);
      o[4] += w1.x * lo16(v.z); o[5] += w1.y * hi16(v.z); o[6] += w1.z * lo16(v.w); o[7] += w1.w * hi16(v.w);
    }
  }
#pragma unroll
  for (int e = 0; e < 8; e++) o[e] = o[e] * sigm(o[e]);
}

template <class OUT>
__device__ __forceinline__ void conv4x8(const bf16_t* __restrict__ Z, const float* __restrict__ cw, const float* __restrict__ cb,
                                        int b, int s0, int i0, int zcol, int ch, OUT out) {
  float wt[5][8], o[4][8];
  {
    float4 b0 = *(const float4*)(cb + ch), b1 = *(const float4*)(cb + ch + 4);
#pragma unroll
    for (int t = 0; t < 4; t++) { o[t][0] = b0.x; o[t][1] = b0.y; o[t][2] = b0.z; o[t][3] = b0.w; o[t][4] = b1.x; o[t][5] = b1.y; o[t][6] = b1.z; o[t][7] = b1.w; }
  }
#pragma unroll
  for (int wq = 0; wq < 5; wq++) {
    float4 w0 = *(const float4*)(cw + wq * 1024 + ch), w1 = *(const float4*)(cw + wq * 1024 + ch + 4);
    wt[wq][0] = w0.x; wt[wq][1] = w0.y; wt[wq][2] = w0.z; wt[wq][3] = w0.w; wt[wq][4] = w1.x; wt[wq][5] = w1.y; wt[wq][6] = w1.z; wt[wq][7] = w1.w;
  }
#pragma unroll
  for (int r = 0; r < 8; r++) {
    const int ss = s0 + i0 - 2 + r;
    uint4 v = make_uint4(0u, 0u, 0u, 0u);
    if (ss >= 0 && ss < SEQ) v = *(const uint4*)(Z + ((size_t)b * SEQ + ss) * ZS + zcol);
    float rf[8];
    rf[0] = lo16(v.x); rf[1] = hi16(v.x); rf[2] = lo16(v.y); rf[3] = hi16(v.y); rf[4] = lo16(v.z); rf[5] = hi16(v.z); rf[6] = lo16(v.w); rf[7] = hi16(v.w);
#pragma unroll
    for (int t = 0; t < 4; t++) {
      const int wq = r - t;
      if (wq >= 0 && wq < 5) {
#pragma unroll
        for (int e = 0; e < 8; e++) o[t][e] += wt[wq][e] * rf[e];
      }
    }
  }
#pragma unroll
  for (int t = 0; t < 4; t++) {
#pragma unroll
    for (int e = 0; e < 8; e++) o[t][e] = o[t][e] * sigm(o[t][e]);
    out(t, o[t]);
  }
}

__device__ __forceinline__ void mlstm_local(const Params& p, int l, int item, char* smem) {
  const int co = item & 63, h = (item >> 6) & 3, b = item >> 8;
  char* ws = p.ws;
  bf16_t* KTs = (bf16_t*)smem;
  bf16_t* VTs = KTs + 128 * LDT;
  float* WV = (float*)(VTs + 128 * LDT);
  const int tid = tidx(), lane = tid & 63, w = tid >> 6;
  const int tok0 = b * SEQ + co * 128;
  const bf16_t* Z = (const bf16_t*)(ws + W_Z);
  const float* ZG = (const float*)(ws + W_ZG);
  if (w < 2) {
    const int d = w, dbh = d * 8 + b * 4 + h, cp = d ? 63 - co : co;
    const int l0 = 2 * lane, l1 = l0 + 1;
    const int i0 = d ? 127 - l0 : l0, i1 = d ? 127 - l1 : l1;
    float ig0 = ZG[(size_t)(tok0 + i0) * 16 + d * 4 + h], ig1 = ZG[(size_t)(tok0 + i1) * 16 + d * 4 + h];
    float f0 = logsig(ZG[(size_t)(tok0 + i0) * 16 + 8 + d * 4 + h]), f1 = logsig(ZG[(size_t)(tok0 + i1) * 16 + 8 + d * 4 + h]);
    float s1 = f0 + f1;
    float incl = wave_incl_sum(s1, lane);
    float excl = incl - s1;
    float b0 = excl + f0, b1 = incl;
    float gtot = __shfl(incl, 63);
    float a0 = gtot - b0 + ig0, a1 = gtot - b1 + ig1;
    float am = wave_max(fmaxf(a0, a1));
    WV[d * 128 + i0] = expf(a0 - am);
    WV[d * 128 + i1] = expf(a1 - am);
    if (lane == 0) {
      ((float*)(ws + W_AMAX))[dbh * 64 + cp] = am;
      ((float*)(ws + W_G))[dbh * 64 + cp] = gtot;
    }
  }
  const float* cw = p.in[I_CW] + l * 5 * 1024;
  const float* cb = p.in[I_CB] + l * 1024;
  {
    const int i0 = (tid & 31) * 4, d8 = (tid >> 5) * 8;
    conv4x8(Z, cw, cb, b, co * 128, i0, OFF_K + h * 128 + d8, 512 + h * 128 + d8, [&](int t, const float (&o)[8]) {
#pragma unroll
      for (int e = 0; e < 8; e++) KTs[(d8 + e) * LDT + i0 + t] = f2bf(o[e]);
    });
  }
  __syncthreads();
  if (tid < 256) {
    const int d = tid >> 7, k = tid & 127;
    const int dbh = d * 8 + b * 4 + h, cp = d ? 63 - co : co;
    float s = 0.f;
    for (int i = 0; i < 128; i++) s += WV[d * 128 + i] * bf2f(KTs[k * LDT + i]);
    ((float*)(ws + W_NST))[(size_t)(dbh * 64 + cp) * 128 + k] = s;
  }
  bf16_t* CST = (bf16_t*)(ws + W_CST);
  const int mb = (w / 2) * 32, nb = (w % 2) * 64;
#pragma unroll 1
  for (int d = 0; d < 2; d++) {
    const int dbh = d * 8 + b * 4 + h, cp = d ? 63 - co : co;
#pragma unroll 1
    for (int t = 0; t < 4; t++) {
      int c = tid + t * NT, i = c & 127, e8 = (c >> 7) * 8;
      uint4 v = *(const uint4*)(Z + (size_t)(tok0 + i) * ZS + OFF_V + h * 128 + e8);
      float wv = WV[d * 128 + i];
      VTs[(e8 + 0) * LDT + i] = f2bf(lo16(v.x) * wv); VTs[(e8 + 1) * LDT + i] = f2bf(hi16(v.x) * wv);
      VTs[(e8 + 2) * LDT + i] = f2bf(lo16(v.y) * wv); VTs[(e8 + 3) * LDT + i] = f2bf(hi16(v.y) * wv);
      VTs[(e8 + 4) * LDT + i] = f2bf(lo16(v.z) * wv); VTs[(e8 + 5) * LDT + i] = f2bf(hi16(v.z) * wv);
      VTs[(e8 + 6) * LDT + i] = f2bf(lo16(v.w) * wv); VTs[(e8 + 7) * LDT + i] = f2bf(hi16(v.w) * wv);
    }
    __syncthreads();
    f32x4 acc[2][4];
    zero_acc(acc);
    mma_lds<2, 4, false>(KTs, VTs, 128, mb, nb, acc);
    bf16_t* C = CST + (size_t)(dbh * 64 + cp) * 16384;
#pragma unroll
    for (int i = 0; i < 2; i++) {
      const int k = mb + i * 16 + (lane >> 4) * 4;
#pragma unroll
      for (int j = 0; j < 4; j++) {
        const int e = nb + j * 16 + (lane & 15);
        *(uint2*)(C + e * 128 + k) = pack4(acc[i][j][0], acc[i][j][1], acc[i][j][2], acc[i][j][3]);
      }
    }
    __syncthreads();
  }
}

__device__ __forceinline__ void mlstm_scan(const Params& p, int blk) {
  char* ws = p.ws;
  const float* AM = (const float*)(ws + W_AMAX);
  const float* G = (const float*)(ws + W_G);
  if (blk < 128) {
    const int gt = blk * NT + tidx(), dbh = gt >> 12, e4 = gt & 4095;
    uint2* C = (uint2*)(ws + W_CST) + (size_t)dbh * 64 * 4096 + e4;
    float m = 0.f, c0 = 0.f, c1 = 0.f, c2 = 0.f, c3 = 0.f;
    for (int cc0 = 0; cc0 < 64; cc0 += 16) {
      uint2 v[16];
      float gg[16], aa[16];
#pragma unroll
      for (int u = 0; u < 16; u++) { v[u] = C[(size_t)(cc0 + u) * 4096]; gg[u] = G[dbh * 64 + cc0 + u]; aa[u] = AM[dbh * 64 + cc0 + u]; }
#pragma unroll
      for (int u = 0; u < 16; u++) {
        const int cc = cc0 + u;
        float g = gg[u], am = aa[u];
        float mn = fmaxf(g + m, am);
        float so = __expf(g + m - mn), sn = __expf(am - mn);
        C[(size_t)cc * 4096] = pack4(c0, c1, c2, c3);
        if (e4 == 0) ((float*)(ws + W_MPREV))[dbh * 64 + cc] = m;
        c0 = so * c0 + sn * lo16(v[u].x); c1 = so * c1 + sn * hi16(v[u].x);
        c2 = so * c2 + sn * lo16(v[u].y); c3 = so * c3 + sn * hi16(v[u].y);
        m = mn;
      }
    }
  } else {
    const int gt = (blk - 128) * NT + tidx(), dbh = gt >> 7, k = gt & 127;
    float* N = (float*)(ws + W_NST) + (size_t)dbh * 64 * 128 + k;
    float m = 0.f, n = 0.f;
    for (int cc = 0; cc < 64; cc++) {
      float g = G[dbh * 64 + cc], am = AM[dbh * 64 + cc];
      float mn = fmaxf(g + m, am);
      float so = expf(g + m - mn), sn = expf(am - mn);
      float v = N[cc * 128];
      N[cc * 128] = n;
      n = so * n + sn * v;
      m = mn;
    }
  }
}

__device__ __forceinline__ void mlstm_out(const Params& p, int l, int item, char* smem) {
  const int co = item & 63, h = (item >> 6) & 3, b = item >> 8;
  char* ws = p.ws;
  bf16_t* B0 = (bf16_t*)smem;
  bf16_t* B1 = B0 + 128 * LDT;
  bf16_t* B2 = B1 + 128 * LDT;
  bf16_t* B3 = B2 + 128 * LDT;
  float* FU = (float*)(B3 + 128 * LDT);
  float* FMM = FU + 256;
  float* FIW = FMM + 256;
  float* FEN = FIW + 256;
  float* FNP = FEN + 256;
  const int tid = tidx(), lane = tid & 63, w = tid >> 6;
  const int tok0 = b * SEQ + co * 128;
  const bf16_t* Z = (const bf16_t*)(ws + W_Z);
  const float* ZG = (const float*)(ws + W_ZG);
  const bf16_t* C0p = (const bf16_t*)(ws + W_CST) + (size_t)((0 * 8 + b * 4 + h) * 64 + co) * 16384;
  const bf16_t* C1p = (const bf16_t*)(ws + W_CST) + (size_t)((1 * 8 + b * 4 + h) * 64 + (63 - co)) * 16384;
#define PFV(t) (*(const uint4*)(Z + (size_t)(tok0 + ((tid + (t) * NT) & 127)) * ZS + OFF_V + h * 128 + ((tid + (t) * NT) >> 7) * 8))
#define PFC(P, t) (*(const uint4*)((P) + ((tid + (t) * NT) >> 4) * 128 + ((tid + (t) * NT) & 15) * 8))
  const uint4 vp0 = PFV(0), vp1 = PFV(1), vp2 = PFV(2), vp3 = PFV(3);
  const uint4 ca0 = PFC(C0p, 0), ca1 = PFC(C0p, 1), ca2 = PFC(C0p, 2), ca3 = PFC(C0p, 3);
  const uint4 cb0 = PFC(C1p, 0), cb1 = PFC(C1p, 1), cb2 = PFC(C1p, 2), cb3 = PFC(C1p, 3);
#undef PFV
#undef PFC
  if (w < 2) {
    const int d = w, dbh = d * 8 + b * 4 + h, cp = d ? 63 - co : co;
    const float mprev = ((const float*)(ws + W_MPREV))[dbh * 64 + cp];
    const int l0 = 2 * lane, l1 = l0 + 1;
    const int i0 = d ? 127 - l0 : l0, i1 = d ? 127 - l1 : l1;
    float ig0 = ZG[(size_t)(tok0 + i0) * 16 + d * 4 + h], ig1 = ZG[(size_t)(tok0 + i1) * 16 + d * 4 + h];
    float f0 = logsig(ZG[(size_t)(tok0 + i0) * 16 + 8 + d * 4 + h]), f1 = logsig(ZG[(size_t)(tok0 + i1) * 16 + 8 + d * 4 + h]);
    float s1 = f0 + f1;
    float incl = wave_incl_sum(s1, lane);
    float b0 = incl - s1 + f0, b1 = incl;
    float u0 = ig0 - b0, u1 = ig1 - b1;
    float pm1 = fmaxf(u0, u1);
    float inclm = wave_incl_max(pm1, lane);
    float exclm = __shfl_up(inclm, 1);
    if (lane == 0) exclm = -INFINITY;
    float r0 = fmaxf(exclm, u0), r1 = fmaxf(exclm, pm1);
    float mm0 = fmaxf(mprev, r0), mm1 = fmaxf(mprev, r1);
    FU[d * 128 + i0] = u0; FU[d * 128 + i1] = u1;
    FMM[d * 128 + i0] = mm0; FMM[d * 128 + i1] = mm1;
    FIW[d * 128 + i0] = expf(mprev - mm0); FIW[d * 128 + i1] = expf(mprev - mm1);
    FEN[d * 128 + i0] = expf(-(b0 + mm0)); FEN[d * 128 + i1] = expf(-(b1 + mm1));
  }
  if (tid < 256) {
    const int d = tid >> 7, k = tid & 127;
    const int dbh = d * 8 + b * 4 + h, cp = d ? 63 - co : co;
    FNP[tid] = ((const float*)(ws + W_NST))[(size_t)(dbh * 64 + cp) * 128 + k];
  }
  const float* cw = p.in[I_CW] + l * 5 * 1024;
  const float* cb = p.in[I_CB] + l * 1024;
  const float qscale = 0.08838834764831845f;
  const int mb = w * 16;
  const int irow = mb + (lane & 15);
  f32x4 hf[8];
  {
    const int d8 = (tid & 15) * 8, i0 = (tid >> 4) * 4;
    conv4x8(Z, cw, cb, b, co * 128, i0, h * 128 + d8, h * 128 + d8, [&](int t, const float (&o)[8]) {
      uint4 q;
      q.x = pack2(o[0] * qscale, o[1] * qscale); q.y = pack2(o[2] * qscale, o[3] * qscale);
      q.z = pack2(o[4] * qscale, o[5] * qscale); q.w = pack2(o[6] * qscale, o[7] * qscale);
      *(uint4*)&B0[(i0 + t) * LDT + d8] = q;
    });
    conv4x8(Z, cw, cb, b, co * 128, i0, OFF_K + h * 128 + d8, 512 + h * 128 + d8, [&](int t, const float (&o)[8]) {
      uint4 q;
      q.x = pack2(o[0], o[1]); q.y = pack2(o[2], o[3]); q.z = pack2(o[4], o[5]); q.w = pack2(o[6], o[7]);
      *(uint4*)&B1[(i0 + t) * LDT + d8] = q;
    });
  }
  __syncthreads();
  f32x4 accS[1][8];
  zero_acc(accS);
  mma_lds<1, 8, true>(B0, B1, 128, mb, 0, accS);
  float qn0 = 0.f, qn1 = 0.f;
  {
    const int kq0 = (lane >> 4) * 32;
#pragma unroll 8
    for (int k = 0; k < 32; k++) { float qv = bf2f(B0[irow * LDT + kq0 + k]); qn0 += qv * FNP[kq0 + k]; qn1 += qv * FNP[128 + kq0 + k]; }
  }
  qn0 += __shfl_xor(qn0, 16); qn0 += __shfl_xor(qn0, 32);
  qn1 += __shfl_xor(qn1, 16); qn1 += __shfl_xor(qn1, 32);
  __syncthreads();
#define VTS(t, v)                                                                                         \
  {                                                                                                       \
    const int c_ = tid + (t) * NT, j_ = c_ & 127, e8_ = (c_ >> 7) * 8;                                    \
    B1[(e8_ + 0) * LDT + j_] = (bf16_t)((v).x & 0xffff); B1[(e8_ + 1) * LDT + j_] = (bf16_t)((v).x >> 16); \
    B1[(e8_ + 2) * LDT + j_] = (bf16_t)((v).y & 0xffff); B1[(e8_ + 3) * LDT + j_] = (bf16_t)((v).y >> 16); \
    B1[(e8_ + 4) * LDT + j_] = (bf16_t)((v).z & 0xffff); B1[(e8_ + 5) * LDT + j_] = (bf16_t)((v).z >> 16); \
    B1[(e8_ + 6) * LDT + j_] = (bf16_t)((v).w & 0xffff); B1[(e8_ + 7) * LDT + j_] = (bf16_t)((v).w >> 16); \
  }
  VTS(0, vp0) VTS(1, vp1) VTS(2, vp2) VTS(3, vp3)
#undef VTS
#define CST_(t, v) { const int c_ = tid + (t) * NT; *(uint4*)&B3[(c_ >> 4) * LDT + (c_ & 15) * 8] = (v); }
#pragma unroll
  for (int d = 0; d < 2; d++) {
    if (d == 0) { CST_(0, ca0) CST_(1, ca1) CST_(2, ca2) CST_(3, ca3) }
    else { CST_(0, cb0) CST_(1, cb1) CST_(2, cb2) CST_(3, cb3) }
    const float mmi = FMM[d * 128 + irow];
    float rowsum = 0.f;
#pragma unroll
    for (int jt = 0; jt < 8; jt++) {
      const int j0 = jt * 16 + (lane >> 4) * 4;
      float pv[4];
#pragma unroll
      for (int r = 0; r < 4; r++) {
        const int j = j0 + r;
        const bool ok = d ? (j >= irow) : (j <= irow);
        float e = ok ? accS[0][jt][r] * __expf(FU[d * 128 + j] - mmi) : 0.f;
        pv[r] = e; rowsum += e;
      }
      *(uint2*)&B2[irow * LDT + j0] = pack4(pv[0], pv[1], pv[2], pv[3]);
    }
    rowsum += __shfl_xor(rowsum, 16); rowsum += __shfl_xor(rowsum, 32);
    const float iw = FIW[d * 128 + irow];
    const float den = rowsum + iw * (d ? qn1 : qn0);
    __syncthreads();
    f32x4 acc[1][8];
    zero_acc(acc);
    mma_lds<1, 8, true>(B0, B3, 128, mb, 0, acc);
#pragma unroll
    for (int jt = 0; jt < 8; jt++) { acc[0][jt][0] *= iw; acc[0][jt][1] *= iw; acc[0][jt][2] *= iw; acc[0][jt][3] *= iw; }
    mma_lds<1, 8, true>(B2, B1, 128, mb, 0, acc);
    const float dn = 1.f / fmaxf(fabsf(den), FEN[d * 128 + irow]);
    if (d == 0) {
#pragma unroll
      for (int jt = 0; jt < 8; jt++) hf[jt] = acc[0][jt] * dn;
      __syncthreads();
    } else {
#pragma unroll
      for (int jt = 0; jt < 8; jt++) hf[jt] += acc[0][jt] * dn;
    }
  }
#undef CST_
  float s = 0.f;
#pragma unroll
  for (int jt = 0; jt < 8; jt++) s += hf[jt][0] + hf[jt][1] + hf[jt][2] + hf[jt][3];
  s += __shfl_xor(s, 16); s += __shfl_xor(s, 32);
  const float mu = s * (1.f / 128.f);
  float v = 0.f;
#pragma unroll
  for (int jt = 0; jt < 8; jt++)
#pragma unroll
    for (int r = 0; r < 4; r++) { float dd = hf[jt][r] - mu; v += dd * dd; }
  v += __shfl_xor(v, 16); v += __shfl_xor(v, 32);
  const float rs = rsqrtf(v * (1.f / 128.f) + EPS);
  const float* ng = p.in[I_MNG] + l * 512 + h * 128;
  bf16_t* HM = (bf16_t*)(ws + W_HM);
  const size_t tok = (size_t)tok0 + irow;
#pragma unroll
  for (int jt = 0; jt < 8; jt++) {
    const int e = jt * 16 + (lane >> 4) * 4;
    float4 gv = *(const float4*)(ng + e);
    uint2 zo = *(const uint2*)(Z + tok * ZS + OFF_O + h * 128 + e);
    float o0 = (hf[jt][0] - mu) * rs * gv.x * sigm(lo16(zo.x));
    float o1 = (hf[jt][1] - mu) * rs * gv.y * sigm(hi16(zo.x));
    float o2 = (hf[jt][2] - mu) * rs * gv.z * sigm(lo16(zo.y));
    float o3 = (hf[jt][3] - mu) * rs * gv.w * sigm(hi16(zo.y));
    *(uint2*)(HM + tok * 512 + h * 128 + e) = pack4(o0, o1, o2, o3);
  }
  __syncthreads();
}

#define XB_TMO      128
#define XB_XCNT(j)  (256  + 64 * (j))
#define XB_XSUB(j)  (1280 + 64 * (j))
#define XB_XGEN(j)  (2304 + 64 * (j))
#define XB_TOP      3328
#define XB_TOPGEN   3392
#define XCD_BAR_WORDS 3456
#define XB_SPIN_CAP (1u << 22)
#define LAS __attribute__((address_space(3)))
__device__ __forceinline__ unsigned xb_ld(unsigned* p) { return __hip_atomic_load(p, __ATOMIC_RELAXED, __HIP_MEMORY_SCOPE_AGENT); }
__device__ __forceinline__ unsigned xb_add(unsigned* p, unsigned v) { return __hip_atomic_fetch_add(p, v, __ATOMIC_RELAXED, __HIP_MEMORY_SCOPE_AGENT); }
__device__ __forceinline__ unsigned xb_xcc_id() { return (unsigned)__builtin_amdgcn_s_getreg((3 << 11) | 20) & 0xFu; }
#define XB_SPIN(cond, bar) do { unsigned _sp = 0; while (cond) { __builtin_amdgcn_s_sleep(1); \
    if ((++_sp & 255u) == 0u) { if (xb_ld(&(bar)[XB_TMO])) break; if (_sp > XB_SPIN_CAP) { atomicAdd(&(bar)[XB_TMO], 1u); break; } } } } while (0)
struct XcdBarrier { unsigned* bar; unsigned x; volatile LAS unsigned* st; };
__device__ __forceinline__ XcdBarrier xcd_barrier_post(unsigned* bar, volatile LAS unsigned* st) {
  XcdBarrier b; b.bar = bar; b.x = xb_xcc_id(); b.st = st;
  if (threadIdx.x == 0) (void)xb_add(&bar[XB_XCNT(b.x)], 1u);
  return b;
}
__device__ __forceinline__ void xcd_barrier_complete(unsigned* bar, unsigned x, unsigned& nloc, unsigned& nx) {
  const unsigned G = gridDim.x * gridDim.y * gridDim.z;
  unsigned sum, cnt, mine, sp = 0u;
  for (;;) {
    sum = 0u; cnt = 0u; mine = 0u;
#pragma unroll
    for (unsigned j = 0; j < 16; ++j) { const unsigned c = xb_ld(&bar[XB_XCNT(j)]); sum += c; cnt += (c > 0u) ? 1u : 0u; mine = (j == x) ? c : mine; }
    if (sum == G) break;
    __builtin_amdgcn_s_sleep(1);
    if ((++sp & 255u) == 0u) { if (xb_ld(&bar[XB_TMO])) break; if (sp > XB_SPIN_CAP) { atomicAdd(&bar[XB_TMO], 1u); break; } }
  }
  nloc = mine > 0u ? mine : 1u; nx = cnt > 0u ? cnt : 1u;
}
__device__ __forceinline__ void xcd_barrier(const XcdBarrier& b) {
  asm volatile("s_waitcnt vmcnt(0)" ::: "memory");
  __syncthreads();
  if (threadIdx.x == 0) {
    unsigned* bar = b.bar;
    __builtin_amdgcn_s_waitcnt(0);
    unsigned nloc = b.st[0], nx = b.st[1];
    if (nloc == 0u) { xcd_barrier_complete(bar, b.x, nloc, nx); b.st[0] = nloc; b.st[1] = nx; }
    const unsigned old = xb_add(&bar[XB_XSUB(b.x)], 1u);
    const unsigned gen = old / nloc;
    if (old + 1u == (gen + 1u) * nloc) {
      __builtin_amdgcn_fence(__ATOMIC_RELEASE, "agent");
      asm volatile("s_waitcnt vmcnt(0)" ::: "memory");
      const unsigned og = xb_add(&bar[XB_TOP], 1u);
      const unsigned tg = og / nx;
      if (og + 1u == (tg + 1u) * nx) xb_add(&bar[XB_TOPGEN], 1u);
      else XB_SPIN(xb_ld(&bar[XB_TOPGEN]) == tg, bar);
      __builtin_amdgcn_fence(__ATOMIC_ACQUIRE, "agent");
      xb_add(&bar[XB_XGEN(b.x)], 1u);
      asm volatile("s_waitcnt vmcnt(0)" ::: "memory");
    } else {
      XB_SPIN(xb_ld(&bar[XB_XGEN(b.x)]) == gen, bar);
      __builtin_amdgcn_fence(__ATOMIC_ACQUIRE, "agent");
      asm volatile("s_waitcnt vmcnt(0)" ::: "memory");
    }
  }
  __syncthreads();
}

namespace pg8 {
#define PG8_LAS __attribute__((address_space(3)))
typedef unsigned short bf16_t;
typedef short bf16x8 __attribute__((ext_vector_type(8)));
typedef float f32x4 __attribute__((ext_vector_type(4)));
typedef unsigned u32x4 __attribute__((ext_vector_type(4)));
constexpr int BM = 256, BK = 64, HALF = 128, HTB = HALF * BK * 2  , STAGE_BYTES = 8 * HTB, NXCD = 8, WGM = 8;

__host__ __device__ __forceinline__ int lds_byte(int r, int c) { const int st = (r >> 4) * 2 + (c >> 5), rr = r & 15, cc = c & 31, ob = rr * 64 + cc * 2; return st * 1024 + (ob ^ (((ob >> 9) & 1) << 5)); }
__host__ __device__ __forceinline__ void stage_rc(int b, int& R, int& C) { const int st = b / 1024, sb = b % 1024, swz = sb ^ (((sb >> 9) & 1) << 5); R = (st >> 1) * 16 + swz / 64; C = (st & 1) * 32 + (swz % 64) / 2; }
__host__ __device__ __forceinline__ int perm32(int rho) { const int n = rho >> 4, i = rho & 15; return 8 * (i >> 2) + 4 * n + (i & 3); }

struct Unit { int pm, pn; };
struct Gemm { const bf16_t* A; const bf16_t* Bt; int M, N, K; };

struct StaticOrder {
    int nM, nN, nwg, G, c;
    __host__ __device__ void init(int M, int N, int G_, int c_) { nM = M / BM; nN = N / BM; nwg = nM * nN; G = G_; c = c_; }
    __host__ __device__ bool next(int i, Unit& u) const {
        const long L = (long)i * G + c; if (L >= nwg) return false;
        int wgid = (int)L; { const int q = nwg / NXCD, r = nwg % NXCD, xcd = wgid % NXCD, off = wgid / NXCD; wgid = (xcd < r ? xcd * (q + 1) : r * (q + 1) + (xcd - r) * q) + off; }
        const int nig = WGM * nN, gid = wgid / nig, fm = gid * WGM, gsz = (nM - fm) < WGM ? (nM - fm) : WGM;
        u.pm = fm + ((wgid % nig) % gsz); u.pn = (wgid % nig) / gsz; return true;
    }
    __device__ __forceinline__ void a_ready(const Unit&) const {}
    __device__ __forceinline__ void done(const Unit&) const {}
};

template <int MODE> struct EpiAct {
    static constexpr bool PERM = true, AFTER_DRAIN = false;
    bf16_t* O; int ldc; const float* bias;
    __device__ __forceinline__ unsigned pk(float lo, float hi) const {
        unsigned a = __float_as_uint(lo), b = __float_as_uint(hi);
        a += 0x7fffu + ((a >> 16) & 1u); b += 0x7fffu + ((b >> 16) & 1u);
        return (a >> 16) | (b & 0xffff0000u);
    }
    __device__ __forceinline__ float act(float v) const {
        if (MODE == 1) { v = fmaxf(v, 0.f); return v * v; }
        if (MODE == 2) return __frcp_rn(1.f + __expf(-v));
        return v;
    }
    __device__ __forceinline__ void operator()(const f32x4 (&acc)[2][2][4][2], const Unit& u, int wr, int wc, int fr, int fq) const {
        const int row0 = u.pm * BM + wr * 64 + fr, col0 = u.pn * BM + wc * 32 + 8 * fq;
        f32x4 bv[2][2];
#pragma unroll
        for (int bj = 0; bj < 2; ++bj)
#pragma unroll
            for (int n = 0; n < 2; ++n) bv[bj][n] = (MODE >= 2) ? *(const f32x4*)(bias + col0 + bj * HALF + 4 * n) : (f32x4){0.f, 0.f, 0.f, 0.f};
#pragma unroll
        for (int ai = 0; ai < 2; ++ai)
#pragma unroll
            for (int m = 0; m < 4; ++m) { bf16_t* rowp = O + (size_t)(row0 + ai * HALF + m * 16) * ldc + col0;
#pragma unroll
                for (int bj = 0; bj < 2; ++bj) { const f32x4 v0 = acc[ai][bj][m][0] + bv[bj][0], v1 = acc[ai][bj][m][1] + bv[bj][1];
                    u32x4 w; w.x = pk(act(v0[0]), act(v0[1])); w.y = pk(act(v0[2]), act(v0[3])); w.z = pk(act(v1[0]), act(v1[1])); w.w = pk(act(v1[2]), act(v1[3]));
                    *(u32x4*)(rowp + bj * HALF) = w; } }
    }
};

template <class Epi, class Sched, bool STAMP = false>
__device__ __forceinline__ void gemm_phase(PG8_LAS unsigned char* lds, const Gemm g, const Sched& S, const Epi& E, unsigned long long* stamps) {
    const int tid = tidx(), wid = __builtin_amdgcn_readfirstlane(tid >> 6), lane = tid & 63, wr = wid >> 2, wc = wid & 3, fr = lane & 15, fq = lane >> 4;
    const int K = g.K, nt = K / BK;
    int ts_lo = 0, ts_hi = 0, nts = 0; const unsigned long long rt_entry = STAMP ? (unsigned long long)wall_clock64() : 0ull;
#define PG8_STAMP() do { if (STAMP && wid == 0 && nts < 64) { const unsigned long long _c = (unsigned long long)clock64(); \
        ts_lo = (lane == nts) ? (int)(unsigned)_c : ts_lo; ts_hi = (lane == nts) ? (int)(unsigned)(_c >> 32) : ts_hi; ++nts; } } while (0)
    PG8_STAMP();
    unsigned voffA[2], voffB[2];
#pragma unroll
    for (int i = 0; i < 2; ++i) { int R, C; stage_rc(tid * 16 + i * 8192, R, C); const int Rb = Epi::PERM ? ((R & ~31) + perm32(R & 31)) : R;
        voffA[i] = (unsigned)(R * K + C) * 2u; voffB[i] = (unsigned)(Rb * K + C) * 2u; }
    const size_t kstep = (size_t)(BK * 2);
    const size_t hstep = (size_t)HALF * K * 2;
    const size_t tstep = 2 * hstep;
    const unsigned ldsw = (unsigned)wid * 1024u;
    const int aoff = lds_byte(wr * 64 + fr, fq * 8), boff = lds_byte(wc * 32 + fr, fq * 8);
#define PG8_SA(b, h) (((b) * 2 + (h)) * HTB)
#define PG8_SB(b, h) ((4 + (b) * 2 + (h)) * HTB)
#define PG8_STAGE(bufoff, gbase, voff) do { _Pragma("unroll") for (int _i = 0; _i < 2; ++_i) \
        __builtin_amdgcn_global_load_lds((const unsigned*)((const char*)(gbase) + (voff)[_i]), (PG8_LAS unsigned*)(lds + (bufoff) + ldsw + _i * 8192), 16, 0, 0); } while (0)
#define PG8_LDA(dst, b, h) do { _Pragma("unroll") for (int m = 0; m < 4; ++m) _Pragma("unroll") for (int k = 0; k < 2; ++k) dst[m][k] = *(const PG8_LAS bf16x8*)(lds + PG8_SA(b, h) + aoff + m * 2048 + k * 1024); } while (0)
#define PG8_LDB(dst, b, h) do { _Pragma("unroll") for (int n = 0; n < 2; ++n) _Pragma("unroll") for (int k = 0; k < 2; ++k) dst[n][k] = *(const PG8_LAS bf16x8*)(lds + PG8_SB(b, h) + boff + n * 2048 + k * 1024); } while (0)
#define PG8_MMA(ai, bj, At, Bt) do { __builtin_amdgcn_s_setprio(1); _Pragma("unroll") for (int m = 0; m < 4; ++m) _Pragma("unroll") for (int n = 0; n < 2; ++n) _Pragma("unroll") for (int k = 0; k < 2; ++k) \
        acc[ai][bj][m][n] = __builtin_amdgcn_mfma_f32_16x16x32_bf16(Bt[n][k], At[m][k], acc[ai][bj][m][n], 0, 0, 0); __builtin_amdgcn_s_setprio(0); } while (0)
#define PG8_WAIT_V(n) asm volatile("s_waitcnt vmcnt(" #n ")" ::: "memory")
#define PG8_WAIT_L(n) asm volatile("s_waitcnt lgkmcnt(" #n ")" ::: "memory")
#define PG8_BAR __builtin_amdgcn_s_barrier()
#define PG8_SCHED __builtin_amdgcn_sched_barrier(0)
    Unit cur, nxt; int ui = 0;
    if (!S.next(0, cur)) return;
    f32x4 acc[2][2][4][2];
#pragma unroll
    for (int a = 0; a < 2; ++a)
#pragma unroll
        for (int b = 0; b < 2; ++b)
#pragma unroll
            for (int m = 0; m < 4; ++m)
#pragma unroll
                for (int n = 0; n < 2; ++n) acc[a][b][m][n] = (f32x4){0.f, 0.f, 0.f, 0.f};
    bf16x8 At[4][2], B0[2][2], B1[2][2];
    const char* cA = (const char*)g.A + (size_t)cur.pm * tstep; const char* cB = (const char*)g.Bt + (size_t)cur.pn * tstep;
    S.a_ready(cur);
    PG8_STAGE(PG8_SB(0, 0), cB, voffB); PG8_STAGE(PG8_SA(0, 0), cA, voffA); PG8_STAGE(PG8_SB(0, 1), cB + hstep, voffB); PG8_STAGE(PG8_SA(0, 1), cA + hstep, voffA);
    if (wr == 1) PG8_BAR;
    PG8_WAIT_V(4); PG8_BAR;
    PG8_STAGE(PG8_SB(1, 0), cB + kstep, voffB); PG8_STAGE(PG8_SA(1, 0), cA + kstep, voffA); PG8_STAGE(PG8_SB(1, 1), cB + hstep + kstep, voffB);
    PG8_WAIT_V(6); PG8_BAR;
    PG8_STAMP();
    for (;;) {
        const bool has_next = S.next(ui + 1, nxt);
        const char* nA = has_next ? (const char*)g.A + (size_t)nxt.pm * tstep : cA; const char* nB = has_next ? (const char*)g.Bt + (size_t)nxt.pn * tstep : cB;
        for (int t = 0; t < nt; t += 2) {
            const bool last = (t == nt - 2);
            const char* a1 = cA + (size_t)(t + 1) * kstep;
            const char* a2 = last ? nA : cA + (size_t)(t + 2) * kstep; const char* b2 = last ? nB : cB + (size_t)(t + 2) * kstep;
            const char* a3 = a2 + kstep; const char* b3 = b2 + kstep;
            if (last && has_next) S.a_ready(nxt);
            PG8_LDB(B0, 0, 0); PG8_SCHED; PG8_LDA(At, 0, 0); PG8_STAGE(PG8_SA(1, 1), a1 + hstep, voffA);
            PG8_WAIT_L(8); PG8_BAR; PG8_WAIT_L(0); PG8_MMA(0, 0, At, B0); PG8_BAR; PG8_SCHED;
            PG8_LDB(B1, 0, 1); PG8_STAGE(PG8_SB(0, 0), b2, voffB);
            PG8_BAR; PG8_WAIT_L(0); PG8_MMA(0, 1, At, B1); PG8_BAR;
            PG8_LDA(At, 0, 1); PG8_STAGE(PG8_SA(0, 0), a2, voffA);
            PG8_BAR; PG8_WAIT_L(0); PG8_MMA(1, 0, At, B0); PG8_BAR; PG8_SCHED;
            PG8_STAGE(PG8_SB(0, 1), b2 + hstep, voffB);
            PG8_WAIT_V(6); PG8_BAR; PG8_MMA(1, 1, At, B1); PG8_BAR;
            PG8_LDB(B0, 1, 0); PG8_SCHED; PG8_LDA(At, 1, 0); PG8_STAGE(PG8_SA(0, 1), a2 + hstep, voffA);
            PG8_WAIT_L(8); PG8_BAR; PG8_WAIT_L(0); PG8_MMA(0, 0, At, B0); PG8_BAR; PG8_SCHED;
            PG8_LDB(B1, 1, 1); PG8_STAGE(PG8_SB(1, 0), b3, voffB);
            PG8_BAR; PG8_WAIT_L(0); PG8_MMA(0, 1, At, B1); PG8_BAR;
            PG8_LDA(At, 1, 1); PG8_STAGE(PG8_SA(1, 0), a3, voffA);
            PG8_BAR; PG8_WAIT_L(0); PG8_MMA(1, 0, At, B0); PG8_BAR; PG8_SCHED;
            PG8_STAGE(PG8_SB(1, 1), b3 + hstep, voffB);
            PG8_WAIT_V(6); PG8_BAR; PG8_MMA(1, 1, At, B1); PG8_BAR;
        }
        PG8_STAMP();
        if constexpr (!Epi::AFTER_DRAIN) { E(acc, cur, wr, wc, fr, fq); S.done(cur); }
        PG8_STAMP();
        if (!has_next) break;
#pragma unroll
        for (int a = 0; a < 2; ++a)
#pragma unroll
            for (int b = 0; b < 2; ++b)
#pragma unroll
                for (int m = 0; m < 4; ++m)
#pragma unroll
                    for (int n = 0; n < 2; ++n) acc[a][b][m][n] = (f32x4){0.f, 0.f, 0.f, 0.f};
        cur = nxt; cA = nA; cB = nB; ++ui;
    }
    PG8_WAIT_V(0);
    if (wr == 0) PG8_BAR;
    PG8_BAR;
    if constexpr (Epi::AFTER_DRAIN) { E.fused(acc, cur, wr, wc, fr, fq, lds, wid, lane); S.done(cur); }
    PG8_STAMP();
    if (STAMP && wid == 0) { stamps[lane] = lane < nts ? (((unsigned long long)(unsigned)ts_hi << 32) | (unsigned)ts_lo) : 0ull;
        if (lane == 62) stamps[62] = rt_entry; if (lane == 63) stamps[63] = (unsigned long long)wall_clock64(); }
#undef PG8_STAMP
#undef PG8_SA
#undef PG8_SB
#undef PG8_STAGE
#undef PG8_LDA
#undef PG8_LDB
#undef PG8_MMA
#undef PG8_WAIT_V
#undef PG8_WAIT_L
#undef PG8_BAR
#undef PG8_SCHED
}
}

#ifndef ONLY_PH
#define ONLY_PH -1
#endif
#define PHEN(x) (ONLY_PH < 0 || ONLY_PH == (x))
constexpr int NPL = 11;
constexpr int NPH = 2 * NPL + 1;

__device__ __forceinline__ void run_phase(const Params& p, int ph, char* smem) {
  const int l = ph / NPL, q = ph % NPL;
  const int bid = blockIdx.x, nb = gridDim.x;
  char* ws = p.ws;
  if (PHEN(11) && ph == NPH - 1) {
    rms_loop(p, 2, 1);
    return;
  }
  switch (q) {
    case 0: if (!PHEN(0)) break; {
      const int n_tab = (l == 0) ? 32 : 0;
      const int n_kt = (l == 0) ? 256 : 0;
      const int total = n_kt + n_tab + N_TR;
      for (int it = bid; it < total; it += nb) {
        int i = it;
        if (i < n_kt) { s5_kt(p, i, smem); continue; }
        i -= n_kt;
        if (i < n_tab) { gen_tables(p, i); continue; }
        i -= n_tab;
        transpose_item(p, l, i, smem);
      }
      if (l == 0) rms_loop(p, 0, 0); else rms_loop(p, 2, l - 1);
    } break;
    case 1: if (!PHEN(1)) break;
      {
        const float* bin = p.in[I_BIN] + l * NIN;
        {
          pg8::Gemm g{(const pg8::bf16_t*)(ws + W_HBF), (const pg8::bf16_t*)(ws + W_WIN), TOK, 2048, 1024};
          pg8::StaticOrder S; S.init(TOK, 2048, (int)gridDim.x, (int)blockIdx.x);
          pg8::EpiAct<3> E{(pg8::bf16_t*)(ws + W_Z), ZS, bin};
          pg8::gemm_phase<pg8::EpiAct<3>, pg8::StaticOrder, false>((PG8_LAS unsigned char*)smem, g, S, E, nullptr);
        }
        {
          pg8::Gemm g{(const pg8::bf16_t*)(ws + W_HBF), (const pg8::bf16_t*)(ws + W_WIN) + (size_t)2064 * 1024, TOK, 512, 1024};
          pg8::StaticOrder S; S.init(TOK, 512, (int)gridDim.x, (int)blockIdx.x);
          pg8::EpiAct<3> E{(pg8::bf16_t*)(ws + W_Z) + 2048, ZS, bin + 2064};
          pg8::gemm_phase<pg8::EpiAct<3>, pg8::StaticOrder, false>((PG8_LAS unsigned char*)smem, g, S, E, nullptr);
        }
        const int hb = nb / 2;
        if (bid >= hb) {
          for (int it = bid - hb; it < 64 + 128; it += nb - hb) {
            if (it < 64) ingate_item(p, l, it, smem);
            else s5_fill(p, l, it - 64, smem);
          }
        }
      }
      break;
    case 2: if (!PHEN(2)) break;
      for (int it = bid; it < 512 + 128 + 512; it += nb) {
        if (it < 512) mlstm_local(p, l, it, smem);
        else if (it < 640) s5_e(p, it - 512, smem);
        else four_g1(p, it - 640, smem);
      }
      break;
    case 3: if (!PHEN(3)) break;
      for (int it = bid; it < 8 + 132 + 512; it += nb) {
        if (it < 8) s5_carry(p, it);
        else if (it < 140) mlstm_scan(p, it - 8);
        else four_g2(p, it - 140, smem);
      }
      break;
    case 4: if (!PHEN(4)) break;
      for (int it = bid; it < 512 + 256 + 512; it += nb) {
        if (it < 512) mlstm_out(p, l, it, smem);
        else if (it < 768) s5_tg(p, it - 512, smem);
        else four_g3(p, it - 768, smem);
      }
      break;
    case 5: if (!PHEN(5)) break;
      {
        pg8::Gemm g{(const pg8::bf16_t*)(ws + W_HBF), (const pg8::bf16_t*)(ws + W_WIN) + (size_t)OFF_GATE * 1024, TOK, 3072, 1024};
        pg8::StaticOrder S; S.init(TOK, 3072, (int)gridDim.x, (int)blockIdx.x);
        pg8::EpiAct<2> E{(pg8::bf16_t*)(ws + W_GATE), 3072, p.in[I_BIN] + l * NIN + OFF_GATE};
        pg8::gemm_phase<pg8::EpiAct<2>, pg8::StaticOrder, false>((PG8_LAS unsigned char*)smem, g, S, E, nullptr);
      }
      break;
    case 6: if (!PHEN(6)) break;
      for (int it = bid; it < 512; it += nb) mergelite_item(p, l, it, smem);
      break;
    case 7: if (!PHEN(7)) break;
      {
        pg8::Gemm g{(const pg8::bf16_t*)(ws + W_MIX), (const pg8::bf16_t*)(ws + W_WOUT), TOK, 1024, 1024};
        pg8::StaticOrder S; S.init(TOK, 1024, (int)gridDim.x, (int)blockIdx.x);
        pg8::EpiAct<0> E{(pg8::bf16_t*)(ws + W_O), 1024, nullptr};
        pg8::gemm_phase<pg8::EpiAct<0>, pg8::StaticOrder, false>((PG8_LAS unsigned char*)smem, g, S, E, nullptr);
      }
      break;
    case 8: if (!PHEN(8)) break;
      rms_loop(p, 1, l);
      break;
    case 9: if (!PHEN(9)) break;
      {
        pg8::Gemm g{(const pg8::bf16_t*)(ws + W_HBF), (const pg8::bf16_t*)(ws + W_W1), TOK, 4096, 1024};
        pg8::StaticOrder S; S.init(TOK, 4096, (int)gridDim.x, (int)blockIdx.x);
        pg8::EpiAct<1> E{(pg8::bf16_t*)(ws + W_HID), 4096, nullptr};
        pg8::gemm_phase<pg8::EpiAct<1>, pg8::StaticOrder, false>((PG8_LAS unsigned char*)smem, g, S, E, nullptr);
      }
      break;
    case 10: if (!PHEN(10)) break;
      {
        pg8::Gemm g{(const pg8::bf16_t*)(ws + W_HID), (const pg8::bf16_t*)(ws + W_W2), TOK, 1024, 4096};
        pg8::StaticOrder S; S.init(TOK, 1024, (int)gridDim.x, (int)blockIdx.x);
        pg8::EpiAct<0> E{(pg8::bf16_t*)(ws + W_FO), 1024, nullptr};
        pg8::gemm_phase<pg8::EpiAct<0>, pg8::StaticOrder, false>((PG8_LAS unsigned char*)smem, g, S, E, nullptr);
      }
      break;
  }
}

__global__ void __launch_bounds__(NT) k_main(Params p, int ph_lo, int ph_hi) {
  extern __shared__ __attribute__((aligned(16))) char smem[];
#if COOP
  cg::grid_group grid = cg::this_grid();
  volatile LAS unsigned* st = (volatile LAS unsigned*)(smem + SMEM_BYTES - 16);
  if (threadIdx.x == 0) { st[0] = 0u; st[1] = 0u; }
  if (blockIdx.x == 0) { for (int i = threadIdx.x; i < 4096; i += NT) ((unsigned*)(p.ws + W_BAR))[i] = 0u; }
  __syncthreads();
  XcdBarrier xb; xb.bar = (unsigned*)(p.ws + W_BAR); xb.x = 0; xb.st = st;
#endif
#if PROBE_PH >= 0
  long long t0 = 0, t1 = 0;
#endif
  for (int ph = ph_lo; ph < ph_hi; ph++) {
#if PROBE_PH >= 0
    if (ph == PROBE_PH) t0 = wall_clock64();
    if (ph == PROBE_PH + PROBE_N) t1 = wall_clock64();
#endif
    run_phase(p, ph, smem);
#if COOP
    if (ph + 1 < ph_hi) {
      if (ph == ph_lo) { grid.sync(); xb = xcd_barrier_post((unsigned*)(p.ws + W_BAR), st); }
      else xcd_barrier(xb);
    }
#endif
  }
#if PROBE_PH >= 0
  xcd_barrier(xb);
  if (blockIdx.x == 0 && threadIdx.x == 0) { float us = (float)(t1 - t0) * 0.01f; p.out[0] += 0.1f + us * (1.f / PROBE_SCALE); }
#endif
}

extern "C" void kernel_launch(void* const* d_in, const int* in_sizes, int n_in, void* d_out, int out_size, void* d_ws, size_t ws_size,
                              hipStream_t stream) {
  static int grid = 0;
  if (grid == 0) {
    if (n_in != 25 || ws_size < W_END) { fprintf(stderr, "kernel_launch: bad inputs n_in=%d ws=%zu need %zu\n", n_in, ws_size, (size_t)W_END); grid = -1; return; }
    if (hipFuncSetAttribute((const void*)k_main, hipFuncAttributeMaxDynamicSharedMemorySize, SMEM_BYTES) != hipSuccess) { fprintf(stderr, "hipFuncSetAttribute failed\n"); grid = -1; return; }
    int dev = 0, cus = 0, per_cu = 0;
    hipGetDevice(&dev);
    hipDeviceGetAttribute(&cus, hipDeviceAttributeMultiprocessorCount, dev);
    hipOccupancyMaxActiveBlocksPerMultiprocessor(&per_cu, (const void*)k_main, NT, SMEM_BYTES);
    if (per_cu < 1) { fprintf(stderr, "occupancy query says 0 blocks/CU\n"); grid = -1; return; }
    grid = cus;
  }
  if (grid < 0) return;
  Params p{};
  for (int i = 0; i < 25; i++) p.in[i] = (const float*)d_in[i];
  p.out = (float*)d_out;
  p.ws = (char*)d_ws;
#if COOP
  int lo = 0, hi = NPH;
  void* args[] = {&p, &lo, &hi};
  hipError_t e = hipLaunchCooperativeKernel((const void*)k_main, dim3(grid), dim3(NT), args, SMEM_BYTES, stream);
  if (e != hipSuccess) fprintf(stderr, "cooperative launch failed: %s\n", hipGetErrorString(e));
#else
  for (int ph = 0; ph < NPH; ph++) hipLaunchKernelGGL(k_main, dim3(grid), dim3(NT), SMEM_BYTES, stream, p, ph, ph + 1);
#endif
}
```
